# Optimizing an MI355X kernel written in HIP

```python
import math
import jax, jax.numpy as jnp
from jax import lax
import numpy as np


D_MODEL = 1024
BATCH = 2
SEQ = 8192
DEPTH = 1

NORM_EPS = 1e-6
L2_EPS = 1e-6
ROPE_THETA = 500000.0
NEG_INF = -1e30

GDN_HEADS = 8
GDN_DK = 128
GDN_DV = 128
GDN_CONV = 4
GDN_CHUNK = 64

NSA_HEADS = 8
NSA_GROUPS = 2
NSA_REP = NSA_HEADS // NSA_GROUPS
NSA_DK = 128
NSA_DV = 128
ROT_DIM = NSA_DK // 4
CMP_LEN = 32
CMP_STRIDE = 16
SEL_LEN = 64
SEL_TOPK = 16
WINDOW = 512
Q_BLOCK = 128
SEL_FORCE = 1e4

MEM_LEN = 256
XATTN_HEADS = 4
XATTN_DH = 128

N_EXPERTS = 32
TOP_K = 4
D_EXPERT = D_MODEL
SWIGLU_LIMIT = 7.0
SWIGLU_ALPHA = 1.702
MOE_BLOCK = 256

IN_WIDTHS = (
    GDN_HEADS * GDN_DK,
    GDN_HEADS * GDN_DK,
    GDN_HEADS * GDN_DV,
    GDN_HEADS * GDN_DV,
    GDN_HEADS,
    GDN_HEADS,
    NSA_HEADS * NSA_DK,
    NSA_GROUPS * NSA_DK,
    NSA_GROUPS * NSA_DV,
    NSA_GROUPS * NSA_DK,
    NSA_GROUPS * NSA_DV,
    NSA_GROUPS * NSA_DK,
    NSA_GROUPS * NSA_DV,
    NSA_HEADS * 3,
    D_MODEL,
    D_MODEL,
)
D_IN = sum(IN_WIDTHS)

kernel_name = 'hybrid_gdn_nsa_moe_block'


def rms_norm(x, gain):
    xf = x.astype(jnp.float32)
    y = xf * lax.rsqrt(jnp.mean(xf * xf, axis=-1, keepdims=True) + NORM_EPS)
    return (y * gain.astype(jnp.float32)).astype(x.dtype)


def l2_normalize(x):
    xf = x.astype(jnp.float32)
    return xf * lax.rsqrt(jnp.sum(xf * xf, axis=-1, keepdims=True) + L2_EPS)


def partial_rope(x, pos):
    half = ROT_DIM // 2
    inv_freq = jnp.exp(-math.log(ROPE_THETA) * jnp.arange(half, dtype=jnp.float32) * (2.0 / ROT_DIM))
    ang = pos.astype(jnp.float32)[:, None] * inv_freq[None, :]
    cos = jnp.cos(ang)[None, :, None, :]
    sin = jnp.sin(ang)[None, :, None, :]
    xr = x[..., :ROT_DIM].astype(jnp.float32)
    x1, x2 = xr[..., :half], xr[..., half:]
    rot = jnp.concatenate([x1 * cos - x2 * sin, x2 * cos + x1 * sin], axis=-1)
    return jnp.concatenate([rot.astype(x.dtype), x[..., ROT_DIM:]], axis=-1)


def masked_softmax(s, mask):
    s = jnp.where(mask, s.astype(jnp.float32), NEG_INF)
    m = jnp.max(s, axis=-1, keepdims=True)
    p = jnp.where(mask, jnp.exp(s - m), 0.0)
    return p / jnp.maximum(jnp.sum(p, axis=-1, keepdims=True), 1e-30)


def causal_depthwise_conv_silu(x, w):
    c = x.shape[-1]
    y = lax.conv_general_dilated(
        x, w.astype(x.dtype)[:, None, :], window_strides=(1,),
        padding=[(w.shape[0] - 1, 0)], dimension_numbers=('NWC', 'WIO', 'NWC'),
        feature_group_count=c)
    return jax.nn.silu(y)


def gated_delta_rule(q, k, v, g, beta):
    bsz, seq, nh, dk = q.shape
    dv = v.shape[-1]
    c = GDN_CHUNK
    n = seq // c
    f32 = jnp.float32

    def chunks(a):
        a = jnp.moveaxis(a.astype(f32), 2, 1)
        return a.reshape((bsz, nh, n, c) + a.shape[3:])

    q = chunks(q) * (dk ** -0.5)
    k = chunks(k)
    v = chunks(v)
    beta = chunks(beta)
    g = jnp.cumsum(chunks(g), axis=-1)
    kb = k * beta[..., None]
    vb = v * beta[..., None]
    incl = jnp.tril(jnp.ones((c, c), dtype=bool))
    strict = jnp.tril(jnp.ones((c, c), dtype=bool), -1)
    diff = g[..., :, None] - g[..., None, :]
    decay = jnp.where(incl, jnp.exp(jnp.where(incl, diff, 0.0)), 0.0)
    a_mat = jnp.where(strict, jnp.einsum('bhnid,bhnjd->bhnij', kb, k) * decay, 0.0)
    eye = jnp.eye(c, dtype=f32)
    t_mat = lax.linalg.triangular_solve(a_mat + eye, jnp.broadcast_to(eye, a_mat.shape),
                                        left_side=True, lower=True, unit_diagonal=True)
    u = t_mat @ vb
    w = t_mat @ (kb * jnp.exp(g)[..., None])
    qk = jnp.einsum('bhnid,bhnjd->bhnij', q, k) * decay
    q_dec = q * jnp.exp(g)[..., None]
    k_dec = k * jnp.exp(g[..., -1:] - g)[..., None]
    g_last = jnp.exp(g[..., -1])

    def step(state, xs):
        u_n, w_n, qk_n, qd_n, kd_n, gl_n = xs
        v_new = u_n - jnp.einsum('bhck,bhkv->bhcv', w_n, state)
        o = jnp.einsum('bhck,bhkv->bhcv', qd_n, state) + jnp.einsum('bhij,bhjv->bhiv', qk_n, v_new)
        state = state * gl_n[..., None, None] + jnp.einsum('bhck,bhcv->bhkv', kd_n, v_new)
        return state, o

    xs = (jnp.moveaxis(u, 2, 0), jnp.moveaxis(w, 2, 0), jnp.moveaxis(qk, 2, 0),
          jnp.moveaxis(q_dec, 2, 0), jnp.moveaxis(k_dec, 2, 0), jnp.moveaxis(g_last, 2, 0))
    s0 = jnp.zeros((bsz, nh, dk, dv), f32)
    _, o = lax.scan(step, s0, xs)
    o = jnp.moveaxis(o, 0, 2).reshape(bsz, nh, seq, dv)
    return jnp.moveaxis(o, 1, 2)


def nsa_attention(q, k_cmp, v_cmp, k_slc, v_slc, k_win, v_win, branch_gates,
                  pe_k, w1_k, w2_k, pe_v, w1_v, w2_v):
    bsz, seq = q.shape[0], q.shape[1]
    f32 = jnp.float32
    pos = jnp.arange(seq)
    scale = NSA_DK ** -0.5
    q_rot = partial_rope(q, pos)
    k_slc = partial_rope(k_slc, pos)
    k_win = partial_rope(k_win, pos)

    n_cmp = (seq - CMP_LEN) // CMP_STRIDE + 1
    cmp_idx = jnp.arange(n_cmp)[:, None] * CMP_STRIDE + jnp.arange(CMP_LEN)[None, :]
    cmp_end = jnp.arange(n_cmp) * CMP_STRIDE + (CMP_LEN - 1)

    def compress(a, pe, w1, w2):
        blk = a[:, cmp_idx] + pe[:, None, :]
        blk = jnp.moveaxis(blk, 3, 2).reshape(bsz, n_cmp, NSA_GROUPS, -1)
        return jax.nn.silu(blk @ w1) @ w2

    kc = compress(k_cmp, pe_k, w1_k, w2_k)
    vc = compress(v_cmp, pe_v, w1_v, w2_v)

    n_sel = seq // SEL_LEN
    top_n = min(SEL_TOPK, n_sel)
    r_s = SEL_LEN // CMP_STRIDE
    r_c = CMP_LEN // CMP_STRIDE
    offs = np.array([m - nn for m in range(r_s) for nn in range(r_c)], dtype=np.int32)
    cidx = jnp.arange(n_sel)[:, None] * r_s + offs[None, :]
    ok = ((cidx >= 0) & (cidx < n_cmp)).astype(f32)
    wmap = jnp.sum(jax.nn.one_hot(jnp.clip(cidx, 0, n_cmp - 1), n_cmp, dtype=f32) * ok[..., None], axis=1).T
    sel_ids = jnp.arange(n_sel)
    sel_start = sel_ids * SEL_LEN

    qg = q.reshape(bsz, seq, NSA_GROUPS, NSA_REP, NSA_DK)
    qrg = q_rot.reshape(bsz, seq, NSA_GROUPS, NSA_REP, NSA_DK)
    ks_t = jnp.moveaxis(k_slc, 2, 1)
    vs_t = jnp.moveaxis(v_slc, 2, 1)
    kw_pad = jnp.pad(k_win, ((0, 0), (WINDOW, 0), (0, 0), (0, 0)))
    vw_pad = jnp.pad(v_win, ((0, 0), (WINDOW, 0), (0, 0), (0, 0)))
    b_idx = jnp.arange(bsz)[:, None, None]
    g_idx = jnp.arange(NSA_GROUPS)[None, :, None]
    sel_off = jnp.arange(SEL_LEN)
    win_off = jnp.arange(WINDOW + Q_BLOCK) - WINDOW
    n_keys_sel = top_n * SEL_LEN

    def query_block(i):
        q0 = i * Q_BLOCK
        tq = q0 + jnp.arange(Q_BLOCK)
        qb = lax.dynamic_slice_in_dim(qg, q0, Q_BLOCK, axis=1)
        qrb = lax.dynamic_slice_in_dim(qrg, q0, Q_BLOCK, axis=1)
        s_c = jnp.einsum('bqgrd,bngd->bgrqn', qb, kc) * scale
        p_c = masked_softmax(s_c, cmp_end[None, :] <= tq[:, None])
        o_c = jnp.einsum('bgrqn,bngd->bqgrd', p_c, vc)
        imp = jnp.einsum('bgrqn,ns->bgqs', p_c, wmap)
        cur = tq // SEL_LEN
        forced = (sel_ids[None, :] == 0) | (sel_ids[None, :] == cur[:, None]) | (sel_ids[None, :] == cur[:, None] - 1)
        causal_blk = sel_start[None, :] <= tq[:, None]
        score = jnp.where(causal_blk, imp + jnp.where(forced, SEL_FORCE, 0.0), -SEL_FORCE)
        _, sel = lax.top_k(score, top_n)
        tok = (sel[..., None] * SEL_LEN + sel_off).reshape(bsz, NSA_GROUPS, Q_BLOCK * n_keys_sel)
        ks = ks_t[b_idx, g_idx, tok].reshape(bsz, NSA_GROUPS, Q_BLOCK, n_keys_sel, NSA_DK)
        vs = vs_t[b_idx, g_idx, tok].reshape(bsz, NSA_GROUPS, Q_BLOCK, n_keys_sel, NSA_DV)
        s_s = jnp.einsum('bqgrd,bgqkd->bgrqk', qrb, ks) * scale
        m_s = tok.reshape(bsz, NSA_GROUPS, Q_BLOCK, n_keys_sel) <= tq[None, None, :, None]
        p_s = masked_softmax(s_s, m_s[:, :, None])
        o_s = jnp.einsum('bgrqk,bgqkd->bqgrd', p_s, vs)
        kw = lax.dynamic_slice_in_dim(kw_pad, q0, WINDOW + Q_BLOCK, axis=1)
        vw = lax.dynamic_slice_in_dim(vw_pad, q0, WINDOW + Q_BLOCK, axis=1)
        tk = q0 + win_off
        dlt = tq[:, None] - tk[None, :]
        m_w = (dlt >= 0) & (dlt < WINDOW) & (tk[None, :] >= 0)
        s_w = jnp.einsum('bqgrd,bkgd->bgrqk', qrb, kw) * scale
        p_w = masked_softmax(s_w, m_w)
        o_w = jnp.einsum('bgrqk,bkgd->bqgrd', p_w, vw)
        return o_c, o_s, o_w

    n_qb = seq // Q_BLOCK
    o_c, o_s, o_w = lax.map(query_block, jnp.arange(n_qb))

    def unblock(o):
        return jnp.moveaxis(o, 0, 1).reshape(bsz, seq, NSA_HEADS, NSA_DV)

    gts = jax.nn.sigmoid(branch_gates.astype(f32))
    return gts[..., 0:1] * unblock(o_c) + gts[..., 1:2] * unblock(o_s) + gts[..., 2:3] * unblock(o_w)


def memory_cross_attention(h, m, w_q, w_kv, w_o):
    bsz, seq, _ = h.shape
    q = (h @ w_q).reshape(bsz, seq, XATTN_HEADS, XATTN_DH)
    k, v = jnp.split(m @ w_kv, 2, axis=-1)
    k = k.reshape(bsz, -1, XATTN_HEADS, XATTN_DH)
    v = v.reshape(bsz, -1, XATTN_HEADS, XATTN_DH)
    s = jnp.einsum('bthd,bmhd->bhtm', q, k).astype(jnp.float32) * (XATTN_DH ** -0.5)
    p = jax.nn.softmax(s, axis=-1)
    o = jnp.einsum('bhtm,bmhd->bthd', p, v).reshape(bsz, seq, XATTN_HEADS * XATTN_DH)
    return (o.astype(h.dtype) @ w_o)


def clamped_swiglu(gu):
    gate, up = jnp.split(gu, 2, axis=-1)
    gate = jnp.minimum(gate, SWIGLU_LIMIT)
    up = jnp.clip(up, -SWIGLU_LIMIT, SWIGLU_LIMIT)
    return gate * jax.nn.sigmoid(gate * SWIGLU_ALPHA) * (up + 1.0)


def moe_ffn(h, router_w, router_b, w_gu, b_gu, w_dn, b_dn):
    bsz, seq, d = h.shape
    n_tok = bsz * seq
    hf = h.reshape(n_tok, d)
    logits = (hf @ router_w + router_b).astype(jnp.float32)
    top_v, top_e = lax.top_k(logits, TOP_K)
    gates = jax.nn.softmax(top_v, axis=-1)
    n_pairs = n_tok * TOP_K
    flat_e = top_e.reshape(-1)
    flat_tok = jnp.arange(n_pairs) // TOP_K
    flat_gate = gates.reshape(-1)
    order = jnp.argsort(flat_e)
    e_sorted = flat_e[order]
    counts = jnp.bincount(flat_e, length=N_EXPERTS)
    padded = ((counts + MOE_BLOCK - 1) // MOE_BLOCK) * MOE_BLOCK
    start = jnp.cumsum(counts) - counts
    pstart = jnp.cumsum(padded) - padded
    dest = pstart[e_sorted] + jnp.arange(n_pairs) - start[e_sorted]
    n_rows = n_pairs + N_EXPERTS * MOE_BLOCK
    n_blocks = n_rows // MOE_BLOCK
    row_tok = jnp.zeros((n_rows,), jnp.int32).at[dest].set(flat_tok[order])
    row_gate = jnp.zeros((n_rows,), jnp.float32).at[dest].set(flat_gate[order])
    block_exp = jnp.minimum(
        jnp.searchsorted(jnp.cumsum(padded), jnp.arange(n_blocks) * MOE_BLOCK, side='right'),
        N_EXPERTS - 1)
    xs = hf[row_tok].reshape(n_blocks, MOE_BLOCK, d)

    def expert_block(args):
        xb, e = args
        gu = xb @ w_gu[e] + b_gu[e]
        return clamped_swiglu(gu) @ w_dn[e] + b_dn[e]

    y = lax.map(expert_block, (xs, block_exp)).reshape(n_rows, d)
    out = jax.ops.segment_sum(y.astype(jnp.float32) * row_gate[:, None], row_tok, num_segments=n_tok)
    return out.reshape(bsz, seq, d).astype(h.dtype)


def setup_inputs(seed: int = 0) -> dict:
    key = jax.random.key(seed)
    ks = jax.random.split(key, 32)
    f32 = jnp.float32
    L = DEPTH

    def nrm(k, shape, scale):
        return jax.random.normal(k, shape, f32) * scale

    def gain(k, shape):
        return 1.0 + 0.05 * jax.random.normal(k, shape, f32)

    dt = jnp.exp(jax.random.uniform(ks[6], (L, GDN_HEADS), f32, math.log(1e-3), math.log(1e-1)))
    xd = XATTN_HEADS * XATTN_DH
    return {
        'x': nrm(ks[0], (BATCH, SEQ, D_MODEL), 1.0),
        'mem': nrm(ks[1], (BATCH, MEM_LEN, D_MODEL), 1.0),
        'attn_norm_g': gain(ks[2], (L, D_MODEL)),
        'w_in': nrm(ks[3], (L, D_MODEL, D_IN), D_MODEL ** -0.5),
        'gdn_conv_w': nrm(ks[4], (L, GDN_CONV, 2 * GDN_HEADS * GDN_DK + GDN_HEADS * GDN_DV), GDN_CONV ** -0.5),
        'gdn_a_log': jnp.log(jax.random.uniform(ks[5], (L, GDN_HEADS), f32, 1.0, 16.0)),
        'gdn_dt_bias': dt + jnp.log(-jnp.expm1(-dt)),
        'gdn_norm_g': gain(ks[7], (L, GDN_DV)),
        'cmp_pe_k': nrm(ks[8], (L, CMP_LEN, NSA_DK), 0.1),
        'cmp_w1_k': nrm(ks[9], (L, CMP_LEN * NSA_DK, NSA_DK), (CMP_LEN * NSA_DK) ** -0.5),
        'cmp_w2_k': nrm(ks[10], (L, NSA_DK, NSA_DK), NSA_DK ** -0.5),
        'cmp_pe_v': nrm(ks[11], (L, CMP_LEN, NSA_DV), 0.1),
        'cmp_w1_v': nrm(ks[12], (L, CMP_LEN * NSA_DV, NSA_DV), (CMP_LEN * NSA_DV) ** -0.5),
        'cmp_w2_v': nrm(ks[13], (L, NSA_DV, NSA_DV), NSA_DV ** -0.5),
        'w_branch_a': nrm(ks[14], (L, GDN_HEADS * GDN_DV, D_MODEL), (GDN_HEADS * GDN_DV) ** -0.5),
        'w_branch_b': nrm(ks[15], (L, NSA_HEADS * NSA_DV, D_MODEL), (NSA_HEADS * NSA_DV) ** -0.5),
        'w_mix_out': nrm(ks[16], (L, D_MODEL, D_MODEL), D_MODEL ** -0.5),
        'xattn_norm_g': gain(ks[17], (L, D_MODEL)),
        'mem_norm_g': gain(ks[18], (L, D_MODEL)),
        'xattn_w_q': nrm(ks[19], (L, D_MODEL, xd), D_MODEL ** -0.5),
        'xattn_w_kv': nrm(ks[20], (L, D_MODEL, 2 * xd), D_MODEL ** -0.5),
        'xattn_w_o': nrm(ks[21], (L, xd, D_MODEL), xd ** -0.5),
        'ffn_norm_g': gain(ks[22], (L, D_MODEL)),
        'router_w': nrm(ks[23], (L, D_MODEL, N_EXPERTS), D_MODEL ** -0.5),
        'router_b': nrm(ks[24], (L, N_EXPERTS), 0.01),
        'w_gate_up': nrm(ks[25], (L, N_EXPERTS, D_MODEL, 2 * D_EXPERT), D_MODEL ** -0.5),
        'b_gate_up': nrm(ks[26], (L, N_EXPERTS, 2 * D_EXPERT), 0.01),
        'w_down': nrm(ks[27], (L, N_EXPERTS, D_EXPERT, D_MODEL), D_EXPERT ** -0.5),
        'b_down': nrm(ks[28], (L, N_EXPERTS, D_MODEL), 0.01),
        'final_norm_g': gain(ks[29], (D_MODEL,)),
    }


def reference(x, mem, attn_norm_g, w_in, gdn_conv_w, gdn_a_log, gdn_dt_bias, gdn_norm_g,
              cmp_pe_k, cmp_w1_k, cmp_w2_k, cmp_pe_v, cmp_w1_v, cmp_w2_v,
              w_branch_a, w_branch_b, w_mix_out, xattn_norm_g, mem_norm_g,
              xattn_w_q, xattn_w_kv, xattn_w_o, ffn_norm_g, router_w, router_b,
              w_gate_up, b_gate_up, w_down, b_down, final_norm_g):
    f32 = jnp.float32
    bsz, seq, _ = x.shape
    cuts = [int(c) for c in np.cumsum(IN_WIDTHS)[:-1]]
    gdn_qk = GDN_HEADS * GDN_DK
    for l in range(DEPTH):
        h = rms_norm(x, attn_norm_g[l])
        (g_q, g_k, g_v, g_z, g_b, g_a, n_q, n_kc, n_vc, n_ks, n_vs, n_kw, n_vw,
         n_gate, m_a, m_b) = jnp.split(h @ w_in[l], cuts, axis=-1)

        qkv = causal_depthwise_conv_silu(jnp.concatenate([g_q, g_k, g_v], axis=-1), gdn_conv_w[l])
        c_q, c_k, c_v = jnp.split(qkv, [gdn_qk, 2 * gdn_qk], axis=-1)
        c_q = l2_normalize(c_q.reshape(bsz, seq, GDN_HEADS, GDN_DK))
        c_k = l2_normalize(c_k.reshape(bsz, seq, GDN_HEADS, GDN_DK))
        c_v = c_v.reshape(bsz, seq, GDN_HEADS, GDN_DV)
        beta = jax.nn.sigmoid(g_b.astype(f32))
        log_decay = -jnp.exp(gdn_a_log[l].astype(f32)) * jax.nn.softplus(g_a.astype(f32) + gdn_dt_bias[l].astype(f32))
        o_a = gated_delta_rule(c_q, c_k, c_v, log_decay, beta)
        o_a = rms_norm(o_a, gdn_norm_g[l]) * jax.nn.silu(g_z.reshape(bsz, seq, GDN_HEADS, GDN_DV).astype(f32))
        y_a = o_a.reshape(bsz, seq, -1).astype(x.dtype) @ w_branch_a[l]

        o_b = nsa_attention(
            n_q.reshape(bsz, seq, NSA_HEADS, NSA_DK),
            n_kc.reshape(bsz, seq, NSA_GROUPS, NSA_DK), n_vc.reshape(bsz, seq, NSA_GROUPS, NSA_DV),
            n_ks.reshape(bsz, seq, NSA_GROUPS, NSA_DK), n_vs.reshape(bsz, seq, NSA_GROUPS, NSA_DV),
            n_kw.reshape(bsz, seq, NSA_GROUPS, NSA_DK), n_vw.reshape(bsz, seq, NSA_GROUPS, NSA_DV),
            n_gate.reshape(bsz, seq, NSA_HEADS, 3),
            cmp_pe_k[l], cmp_w1_k[l], cmp_w2_k[l], cmp_pe_v[l], cmp_w1_v[l], cmp_w2_v[l])
        y_b = o_b.reshape(bsz, seq, -1).astype(x.dtype) @ w_branch_b[l]

        mixed = jax.nn.sigmoid(m_a) * y_a + jax.nn.sigmoid(m_b) * y_b
        x = x + mixed @ w_mix_out[l]

        x = x + memory_cross_attention(rms_norm(x, xattn_norm_g[l]), rms_norm(mem, mem_norm_g[l]),
                                       xattn_w_q[l], xattn_w_kv[l], xattn_w_o[l])

        x = x + moe_ffn(rms_norm(x, ffn_norm_g[l]), router_w[l], router_b[l],
                        w_gate_up[l], b_gate_up[l], w_down[l], b_down[l])
    return rms_norm(x, final_norm_g)
```

```cpp
#include <hip/hip_runtime.h>
#include <hip/hip_cooperative_groups.h>
#include <cstdio>
#include <cstdint>
namespace cg = cooperative_groups;

#ifndef SINGLE_LAUNCH
#define SINGLE_LAUNCH 1
#endif

#define LAS __attribute__((address_space(3)))
typedef unsigned short bf16_t;
typedef short bf16x8 __attribute__((ext_vector_type(8)));
typedef float f32x4 __attribute__((ext_vector_type(4)));
typedef unsigned u32x4 __attribute__((ext_vector_type(4)));
typedef unsigned u32x2 __attribute__((ext_vector_type(2)));

constexpr int BATCH = 2, T = 8192, NT = BATCH * T, D = 1024;
constexpr int DIN = 8744, DINP = 8960;
constexpr int C_GQ = 0, C_GK = 1024, C_GV = 2048, C_GZ = 3072, C_GB = 4096, C_GA = 4104, C_NQ = 4112, C_NKC = 5136, C_NVC = 5392,
              C_NKS = 5648, C_NVS = 5904, C_NKW = 6160, C_NVW = 6416, C_NG = 6672, C_MA = 6696, C_MB = 7720;
constexpr int NCMP = 511, NCMPP = 512, NSEL = 128, TOPN = 16, WIN = 512;
constexpr int MEM = 256, XD = 512;
constexpr int NE = 32, TOPK = 4, MOEB = 256, NROWS = NT * TOPK + NE * MOEB;
constexpr int NTHREADS = 512, NWAVES = 8;
constexpr int LDS_BYTES = 147456;

constexpr size_t MiB = 1u << 20;
constexpr size_t WS_CTL = 0, CTL_BYTES = 1 * MiB;
constexpr size_t WS_WIN_T = 1 * MiB, WS_WA_T = 19 * MiB, WS_WB_T = 21 * MiB, WS_WMIX_T = 23 * MiB, WS_WXQ_T = 25 * MiB, WS_WXKV_T = 26 * MiB,
                 WS_WXO_T = 28 * MiB, WS_WGU_T = 30 * MiB, WS_WDN_T = 158 * MiB;
constexpr size_t WS_H = 222 * MiB;
constexpr size_t WS_MEMN = 254 * MiB, WS_KVM = 255 * MiB;
constexpr size_t WS_PROJ = 256 * MiB;
constexpr size_t WS_CHK = 536 * MiB;
constexpr size_t WS_U = 648 * MiB;
constexpr size_t WS_GO = 712 * MiB;
constexpr size_t WS_XS = 256 * MiB, WS_ACT = 400 * MiB, WS_Y = 544 * MiB;
constexpr size_t WS_OA = 776 * MiB, WS_OB = 808 * MiB, WS_QR = 840 * MiB, WS_MIXED = 840 * MiB;
constexpr size_t WS_KSR = 872 * MiB, WS_KWR = 880 * MiB, WS_KC = 888 * MiB, WS_VC = 890 * MiB;
constexpr size_t WS_X1 = 892 * MiB;
constexpr size_t WS_QX = 956 * MiB, WS_OX = 972 * MiB;
constexpr size_t WS_GL = 988 * MiB;
constexpr size_t WS_TOPE = 989 * MiB, WS_TOPG = WS_TOPE + 256 * 1024, WS_POS = WS_TOPG + 256 * 1024, WS_ROWGATE = WS_POS + 256 * 1024;
constexpr size_t WS_ROWTOK = WS_ROWGATE + 512 * 1024;
constexpr size_t WS_VST = 991 * MiB, WS_VWT = 999 * MiB;
constexpr size_t WS_W1T = 1007 * MiB;
constexpr size_t WS_W2T = 1009 * MiB;
constexpr size_t WS_XVT = 1010 * MiB;
constexpr size_t WS_END = 1011 * MiB;
constexpr int CH_NEGW = 0, CH_QD = 16384, CH_KDT = 32768, CH_QK = 49152, CH_BYTES = 57344;
constexpr int CW_QUEUE = 0;
constexpr int CW_SCANDONE = 64;
constexpr int CW_P4Q = 65;
constexpr int CW_BLKCNT = 1024;
constexpr int CW_BAR = 16384;
constexpr int CW_SS1 = 32768;
constexpr size_t CTL_ZERO = 131072 + 65536;

struct Params {
    const float* in[30];
    float* out;
    unsigned char* ws;
    int ph_lo, ph_hi;
};

__device__ __forceinline__ unsigned f2bf(float f) { unsigned u = __builtin_bit_cast(unsigned, f); return (u + 0x7fffu + ((u >> 16) & 1u)) >> 16; }
typedef float f32x2_t __attribute__((ext_vector_type(2)));
typedef __bf16 bf16x2_t __attribute__((ext_vector_type(2)));
__device__ __forceinline__ unsigned pk2(float lo, float hi) { f32x2_t v = {lo, hi}; bf16x2_t b = __builtin_convertvector(v, bf16x2_t); return __builtin_bit_cast(unsigned, b); }
__device__ __forceinline__ float bf2f(unsigned short v) { return __builtin_bit_cast(float, (unsigned)v << 16); }
__device__ __forceinline__ float bflo(unsigned v) { return __builtin_bit_cast(float, v << 16); }
__device__ __forceinline__ float bfhi(unsigned v) { return __builtin_bit_cast(float, v & 0xffff0000u); }
__device__ __forceinline__ float wave_sum(float v) {
#pragma unroll
    for (int o = 1; o < 64; o <<= 1) v += __shfl_xor(v, o);
    return v;
}
__device__ __forceinline__ float wave_max(float v) {
#pragma unroll
    for (int o = 1; o < 64; o <<= 1) v = fmaxf(v, __shfl_xor(v, o));
    return v;
}
__device__ __forceinline__ float sigmoidf_(float x) { return __builtin_amdgcn_rcpf(1.f + __builtin_amdgcn_exp2f(x * -1.4426950408889634f)); }
__device__ __forceinline__ float siluf_(float x) { return x * __builtin_amdgcn_rcpf(1.f + __builtin_amdgcn_exp2f(x * -1.4426950408889634f)); }
#define LDS_FENCE() asm volatile("s_waitcnt lgkmcnt(0)" ::: "memory")

namespace pg8 {
constexpr int BM = 256, BK = 64, HALF = 128, HTB = HALF * BK * 2, NXCD = 8, WGM = 8;
__device__ __forceinline__ int lds_byte(int r, int c) { const int st = (r >> 4) * 2 + (c >> 5), rr = r & 15, cc = c & 31, ob = rr * 64 + cc * 2; return st * 1024 + (ob ^ (((ob >> 9) & 1) << 5)); }
__device__ __forceinline__ void stage_rc(int b, int& R, int& C) { const int st = b / 1024, sb = b % 1024, swz = sb ^ (((sb >> 9) & 1) << 5); R = (st >> 1) * 16 + swz / 64; C = (st & 1) * 32 + (swz % 64) / 2; }
__device__ __forceinline__ int perm32(int rho) { const int n = rho >> 4, i = rho & 15; return 8 * (i >> 2) + 4 * n + (i & 3); }

struct Unit { int pm, pn, aux; const char* a; const char* b; const int* rows; };
struct Gemm { int lda, ldb, K; };

template <class Epi, class Sched, bool GATHER = false>
__device__ __forceinline__ void gemm_phase(LAS unsigned char* lds, const Gemm g, const Sched& S, const Epi& E) {
    int tid_o = threadIdx.x; asm volatile("" : "+v"(tid_o));
    const int tid = tid_o, wid = __builtin_amdgcn_readfirstlane(tid >> 6), lane = tid & 63, wr = wid >> 2, wc = wid & 3, fr = lane & 15, fq = lane >> 4;
    const int K = g.K, nt = K / BK;
    unsigned voffA[2], voffB[2];
#pragma unroll
    for (int i = 0; i < 2; ++i) { int R, C; stage_rc(tid * 16 + i * 8192, R, C); const int Rb = (R & ~31) + perm32(R & 31);
        voffA[i] = (unsigned)(R * g.lda + C) * 2u; voffB[i] = (unsigned)(Rb * g.ldb + C) * 2u; }
    int gR[2], gC[2];
#pragma unroll
    for (int i = 0; i < 2; ++i) stage_rc(tid * 16 + i * 8192, gR[i], gC[i]);
    unsigned goff[2][2], gnoff[2][2];
    auto load_goff = [&](const Unit& u, unsigned (&o)[2][2]) {
#pragma unroll
        for (int h = 0; h < 2; ++h)
#pragma unroll
            for (int i = 0; i < 2; ++i) o[h][i] = ((unsigned)u.rows[h * HALF + gR[i]] * (unsigned)g.lda + (unsigned)gC[i]) * 2u; };
    const size_t kstep = (size_t)(BK * 2);
    const size_t hstepA = (size_t)HALF * g.lda * 2, hstepB = (size_t)HALF * g.ldb * 2;
    const unsigned ldsw = (unsigned)wid * 1024u;
    const int aoff = lds_byte(wr * 64 + fr, fq * 8), boff = lds_byte(wc * 32 + fr, fq * 8);
#define PG8_SA(b, h) (((b) * 2 + (h)) * HTB)
#define PG8_SB(b, h) ((4 + (b) * 2 + (h)) * HTB)
#define PG8_STAGE(bufoff, gbase, voff) do { _Pragma("unroll") for (int _i = 0; _i < 2; ++_i) \
        __builtin_amdgcn_global_load_lds((const unsigned*)((const char*)(gbase) + (voff)[_i]), (LAS unsigned*)(lds + (bufoff) + ldsw + _i * 8192), 16, 0, 0); } while (0)
#define PG8_STAGEG(bufoff, gbase, o0, o1) do { \
        __builtin_amdgcn_global_load_lds((const unsigned*)((const char*)(gbase) + (o0)), (LAS unsigned*)(lds + (bufoff) + ldsw), 16, 0, 0); \
        __builtin_amdgcn_global_load_lds((const unsigned*)((const char*)(gbase) + (o1)), (LAS unsigned*)(lds + (bufoff) + ldsw + 8192), 16, 0, 0); } while (0)
#define PG8_STAGEA(bufoff, ptr, h, nx) do { if constexpr (GATHER) { PG8_STAGEG(bufoff, ptr, (nx) ? gnoff[h][0] : goff[h][0], (nx) ? gnoff[h][1] : goff[h][1]); } else { PG8_STAGE(bufoff, (ptr) + (h) * hstepA, voffA); } } while (0)
#define PG8_LDA(dst, b, h) do { _Pragma("unroll") for (int m = 0; m < 4; ++m) _Pragma("unroll") for (int k = 0; k < 2; ++k) dst[m][k] = *(const LAS bf16x8*)(lds + PG8_SA(b, h) + aoff + m * 2048 + k * 1024); } while (0)
#define PG8_LDB(dst, b, h) do { _Pragma("unroll") for (int n = 0; n < 2; ++n) _Pragma("unroll") for (int k = 0; k < 2; ++k) dst[n][k] = *(const LAS bf16x8*)(lds + PG8_SB(b, h) + boff + n * 2048 + k * 1024); } while (0)
#define PG8_MMA(ai, bj, At, Bt) do { __builtin_amdgcn_s_setprio(1); _Pragma("unroll") for (int m = 0; m < 4; ++m) _Pragma("unroll") for (int n = 0; n < 2; ++n) _Pragma("unroll") for (int k = 0; k < 2; ++k) \
        acc[ai][bj][m][n] = __builtin_amdgcn_mfma_f32_16x16x32_bf16(Bt[n][k], At[m][k], acc[ai][bj][m][n], 0, 0, 0); __builtin_amdgcn_s_setprio(0); } while (0)
#define PG8_WAIT_V(n) asm volatile("s_waitcnt vmcnt(" #n ")" ::: "memory")
#define PG8_WAIT_L(n) asm volatile("s_waitcnt lgkmcnt(" #n ")" ::: "memory")
#define PG8_BAR __builtin_amdgcn_s_barrier()
#define PG8_SCHED __builtin_amdgcn_sched_barrier(0)
    Unit cur, nxt; int ui = 0;
    if (!S.next(0, cur)) return;
    f32x4 acc[2][2][4][2];
#pragma unroll
    for (int a = 0; a < 2; ++a)
#pragma unroll
        for (int b = 0; b < 2; ++b)
#pragma unroll
            for (int m = 0; m < 4; ++m)
#pragma unroll
                for (int n = 0; n < 2; ++n) acc[a][b][m][n] = (f32x4){0.f, 0.f, 0.f, 0.f};
    bf16x8 At[4][2], B0[2][2], B1[2][2];
    const char* cA = cur.a; const char* cB = cur.b;
    if constexpr (GATHER) load_goff(cur, goff);
    PG8_STAGE(PG8_SB(0, 0), cB, voffB); PG8_STAGE(PG8_SB(0, 1), cB + hstepB, voffB); PG8_STAGEA(PG8_SA(0, 0), cA, 0, false); PG8_STAGEA(PG8_SA(0, 1), cA, 1, false);
    if (wr == 1) PG8_BAR;
    PG8_WAIT_V(2); PG8_BAR;
    PG8_STAGE(PG8_SB(1, 0), cB + kstep, voffB); PG8_STAGEA(PG8_SA(1, 0), cA + kstep, 0, false); PG8_STAGE(PG8_SB(1, 1), cB + hstepB + kstep, voffB);
    PG8_WAIT_V(6); PG8_BAR;
    for (;;) {
        const bool has_next = S.next(ui + 1, nxt);
        const char* nA = has_next ? nxt.a : cA; const char* nB = has_next ? nxt.b : cB;
        if constexpr (GATHER) { if (has_next) load_goff(nxt, gnoff); else { _Pragma("unroll") for (int h = 0; h < 2; ++h) { gnoff[h][0] = goff[h][0]; gnoff[h][1] = goff[h][1]; } } }
        for (int t = 0; t < nt; t += 2) {
            const bool last = (t == nt - 2);
            const char* a1 = cA + (size_t)(t + 1) * kstep;
            const char* a2 = last ? nA : cA + (size_t)(t + 2) * kstep; const char* b2 = last ? nB : cB + (size_t)(t + 2) * kstep;
            const char* a3 = a2 + kstep; const char* b3 = b2 + kstep;
            PG8_LDB(B0, 0, 0); PG8_LDB(B1, 0, 1); PG8_SCHED; PG8_LDA(At, 0, 0); PG8_STAGEA(PG8_SA(1, 1), a1, 1, false);
            PG8_WAIT_V(8); PG8_WAIT_L(0); PG8_BAR; PG8_MMA(0, 0, At, B0); PG8_MMA(0, 1, At, B1); PG8_BAR; PG8_SCHED;
            PG8_LDA(At, 0, 1); PG8_STAGE(PG8_SB(0, 0), b2, voffB); PG8_STAGE(PG8_SB(0, 1), b2 + hstepB, voffB); PG8_STAGEA(PG8_SA(0, 0), a2, 0, last);
            PG8_WAIT_V(8); PG8_WAIT_L(0); PG8_BAR; PG8_MMA(1, 0, At, B0); PG8_MMA(1, 1, At, B1); PG8_BAR; PG8_SCHED;
            PG8_LDB(B0, 1, 0); PG8_LDB(B1, 1, 1); PG8_SCHED; PG8_LDA(At, 1, 0); PG8_STAGEA(PG8_SA(0, 1), a2, 1, last);
            PG8_WAIT_V(8); PG8_WAIT_L(0); PG8_BAR; PG8_MMA(0, 0, At, B0); PG8_MMA(0, 1, At, B1); PG8_BAR; PG8_SCHED;
            PG8_LDA(At, 1, 1); PG8_STAGE(PG8_SB(1, 0), b3, voffB); PG8_STAGE(PG8_SB(1, 1), b3 + hstepB, voffB); PG8_STAGEA(PG8_SA(1, 0), a3, 0, last);
            PG8_WAIT_V(8); PG8_WAIT_L(0); PG8_BAR; PG8_MMA(1, 0, At, B0); PG8_MMA(1, 1, At, B1); PG8_BAR; PG8_SCHED;
        }
        if (wr == 0) PG8_BAR;
        E(acc, cur, wr, wc, fr, fq);
        if (!has_next) break;
#pragma unroll
        for (int a = 0; a < 2; ++a)
#pragma unroll
            for (int b = 0; b < 2; ++b)
#pragma unroll
                for (int m = 0; m < 4; ++m)
#pragma unroll
                    for (int n = 0; n < 2; ++n) acc[a][b][m][n] = (f32x4){0.f, 0.f, 0.f, 0.f};
        cur = nxt; cA = nA; cB = nB; ++ui;
        if constexpr (GATHER) { _Pragma("unroll") for (int h = 0; h < 2; ++h) { goff[h][0] = gnoff[h][0]; goff[h][1] = gnoff[h][1]; } }
        if (wr == 1) PG8_BAR;
    }
    PG8_WAIT_V(0);
    PG8_BAR;
#undef PG8_SA
#undef PG8_SB
#undef PG8_STAGE
#undef PG8_STAGEG
#undef PG8_STAGEA
#undef PG8_LDA
#undef PG8_LDB
#undef PG8_MMA
#undef PG8_WAIT_V
#undef PG8_WAIT_L
#undef PG8_BAR
#undef PG8_SCHED
}

struct DenseOrder {
    int nM, nN, nwg, G, c; const char* A; const char* Bt; size_t tstepA, tstepB;
    __device__ void init(int M, int N, int G_, int c_, const void* A_, int lda, const void* Bt_, int ldb) {
        nM = M / BM; nN = N / BM; nwg = nM * nN; G = G_; c = c_; A = (const char*)A_; Bt = (const char*)Bt_; tstepA = (size_t)BM * lda * 2; tstepB = (size_t)BM * ldb * 2; }
    __device__ bool next(int i, Unit& u) const {
        const long L = (long)i * G + c; if (L >= nwg) return false;
        int wgid = (int)L; { const int q = nwg / NXCD, r = nwg % NXCD, xcd = wgid % NXCD, off = wgid / NXCD; wgid = (xcd < r ? xcd * (q + 1) : r * (q + 1) + (xcd - r) * q) + off; }
        const int nig = WGM * nN, gid = wgid / nig, fm = gid * WGM, gsz = (nM - fm) < WGM ? (nM - fm) : WGM;
        u.pm = fm + ((wgid % nig) % gsz); u.pn = (wgid % nig) / gsz; u.aux = 0; u.rows = nullptr;
        u.a = A + (size_t)u.pm * tstepA; u.b = Bt + (size_t)u.pn * tstepB; return true;
    }
};
}

#define EPI_LOOP _Pragma("unroll") for (int ai = 0; ai < 2; ++ai) _Pragma("unroll") for (int m = 0; m < 4; ++m) _Pragma("unroll") for (int bj = 0; bj < 2; ++bj)
#define EPI_ROW(u) ((u).pm * 256 + ai * 128 + wr * 64 + m * 16 + fr)
#define EPI_COL(u) ((u).pn * 256 + bj * 128 + wc * 32 + fq * 8)

struct EpiStoreBf16 {
    bf16_t* O; int ldc;
    __device__ __forceinline__ void operator()(const f32x4 (&acc)[2][2][4][2], const pg8::Unit& u, int wr, int wc, int fr, int fq) const {
        EPI_LOOP { const f32x4 v0 = acc[ai][bj][m][0], v1 = acc[ai][bj][m][1];
            u32x4 w; w.x = pk2(v0[0], v0[1]); w.y = pk2(v0[2], v0[3]); w.z = pk2(v1[0], v1[1]); w.w = pk2(v1[2], v1[3]);
            *(u32x4*)(O + (size_t)EPI_ROW(u) * ldc + EPI_COL(u)) = w; }
    }
};
struct EpiGate {
    bf16_t* O; const bf16_t* proj; int gcol; int add;
    __device__ __forceinline__ void operator()(const f32x4 (&acc)[2][2][4][2], const pg8::Unit& u, int wr, int wc, int fr, int fq) const {
#pragma unroll
        for (int ai = 0; ai < 2; ++ai) {
            u32x4 gv[4][2], pv[4][2];
#pragma unroll
            for (int m = 0; m < 4; ++m)
#pragma unroll
                for (int bj = 0; bj < 2; ++bj) { const int row = EPI_ROW(u), col = EPI_COL(u);
                    gv[m][bj] = *(const u32x4*)(proj + (size_t)row * DINP + gcol + col);
                    pv[m][bj] = add ? *(const u32x4*)(O + (size_t)row * D + col) : (u32x4){0u, 0u, 0u, 0u}; }
            asm volatile("" ::: "memory");
#pragma unroll
            for (int m = 0; m < 4; ++m)
#pragma unroll
                for (int bj = 0; bj < 2; ++bj) { const int row = EPI_ROW(u), col = EPI_COL(u); const u32x4 g = gv[m][bj], q = pv[m][bj];
                    float r[8]; const f32x4 v0 = acc[ai][bj][m][0], v1 = acc[ai][bj][m][1];
                    r[0] = v0[0] * sigmoidf_(bflo(g.x)); r[1] = v0[1] * sigmoidf_(bfhi(g.x)); r[2] = v0[2] * sigmoidf_(bflo(g.y)); r[3] = v0[3] * sigmoidf_(bfhi(g.y));
                    r[4] = v1[0] * sigmoidf_(bflo(g.z)); r[5] = v1[1] * sigmoidf_(bfhi(g.z)); r[6] = v1[2] * sigmoidf_(bflo(g.w)); r[7] = v1[3] * sigmoidf_(bfhi(g.w));
                    if (add) { r[0] += bflo(q.x); r[1] += bfhi(q.x); r[2] += bflo(q.y); r[3] += bfhi(q.y); r[4] += bflo(q.z); r[5] += bfhi(q.z); r[6] += bflo(q.w); r[7] += bfhi(q.w); }
                    u32x4 w; w.x = pk2(r[0], r[1]); w.y = pk2(r[2], r[3]); w.z = pk2(r[4], r[5]); w.w = pk2(r[6], r[7]); *(u32x4*)(O + (size_t)row * D + col) = w; }
        }
    }
};
struct EpiResidual {
    float* O; const float* R;
    __device__ __forceinline__ void operator()(const f32x4 (&acc)[2][2][4][2], const pg8::Unit& u, int wr, int wc, int fr, int fq) const {
#pragma unroll
        for (int ai = 0; ai < 2; ++ai) {
            f32x4 rv[4][2][2];
#pragma unroll
            for (int m = 0; m < 4; ++m)
#pragma unroll
                for (int bj = 0; bj < 2; ++bj) { const size_t o = (size_t)EPI_ROW(u) * D + EPI_COL(u); rv[m][bj][0] = *(const f32x4*)(R + o); rv[m][bj][1] = *(const f32x4*)(R + o + 4); }
            asm volatile("" ::: "memory");
#pragma unroll
            for (int m = 0; m < 4; ++m)
#pragma unroll
                for (int bj = 0; bj < 2; ++bj) { const size_t o = (size_t)EPI_ROW(u) * D + EPI_COL(u);
                    *(f32x4*)(O + o) = rv[m][bj][0] + acc[ai][bj][m][0]; *(f32x4*)(O + o + 4) = rv[m][bj][1] + acc[ai][bj][m][1]; }
        }
    }
};
struct EpiResidualNorm {
    float* O; const float* R; bf16_t* Hraw; const float* gain; float* ss;
    __device__ __forceinline__ void operator()(const f32x4 (&acc)[2][2][4][2], const pg8::Unit& u, int wr, int wc, int fr, int fq) const {
        f32x4 gn[2][2];
#pragma unroll
        for (int bj = 0; bj < 2; ++bj) { const int col = u.pn * 256 + bj * 128 + wc * 32 + fq * 8; gn[bj][0] = *(const f32x4*)(gain + col); gn[bj][1] = *(const f32x4*)(gain + col + 4); }
#pragma unroll
        for (int ai = 0; ai < 2; ++ai) {
            f32x4 rv[4][2][2];
#pragma unroll
            for (int m = 0; m < 4; ++m)
#pragma unroll
                for (int bj = 0; bj < 2; ++bj) { const size_t o = (size_t)EPI_ROW(u) * D + EPI_COL(u); rv[m][bj][0] = *(const f32x4*)(R + o); rv[m][bj][1] = *(const f32x4*)(R + o + 4); }
            asm volatile("" ::: "memory");
#pragma unroll
            for (int m = 0; m < 4; ++m) { const int row = u.pm * 256 + ai * 128 + wr * 64 + m * 16 + fr; float sq = 0.f;
#pragma unroll
                for (int bj = 0; bj < 2; ++bj) { const int col = u.pn * 256 + bj * 128 + wc * 32 + fq * 8; const size_t o = (size_t)row * D + col;
                    const f32x4 v0 = rv[m][bj][0] + acc[ai][bj][m][0], v1 = rv[m][bj][1] + acc[ai][bj][m][1];
                    *(f32x4*)(O + o) = v0; *(f32x4*)(O + o + 4) = v1;
                    sq += (v0[0] * v0[0] + v0[1] * v0[1]) + (v0[2] * v0[2] + v0[3] * v0[3]) + (v1[0] * v1[0] + v1[1] * v1[1]) + (v1[2] * v1[2] + v1[3] * v1[3]);
                    const f32x4 g0 = gn[bj][0], g1 = gn[bj][1];
                    u32x4 w; w.x = pk2(v0[0] * g0[0], v0[1] * g0[1]); w.y = pk2(v0[2] * g0[2], v0[3] * g0[3]); w.z = pk2(v1[0] * g1[0], v1[1] * g1[1]); w.w = pk2(v1[2] * g1[2], v1[3] * g1[3]);
                    *(u32x4*)(Hraw + o) = w; }
                sq += __shfl_xor(sq, 16); sq += __shfl_xor(sq, 32);
                if (fq == 0) atomicAdd(ss + row, sq); }
        }
    }
};
struct EpiScaleRowsBf16 {
    bf16_t* O; int ldc; const float* ss;
    __device__ __forceinline__ void operator()(const f32x4 (&acc)[2][2][4][2], const pg8::Unit& u, int wr, int wc, int fr, int fq) const {
        float rs[2][4];
#pragma unroll
        for (int ai = 0; ai < 2; ++ai)
#pragma unroll
            for (int m = 0; m < 4; ++m) rs[ai][m] = ss[u.pm * 256 + ai * 128 + wr * 64 + m * 16 + fr];
#pragma unroll
        for (int ai = 0; ai < 2; ++ai)
#pragma unroll
            for (int m = 0; m < 4; ++m) rs[ai][m] = __builtin_amdgcn_rsqf(rs[ai][m] * (1.f / D) + 1e-6f);
        EPI_LOOP { const int row = EPI_ROW(u); const f32x4 v0 = acc[ai][bj][m][0] * rs[ai][m], v1 = acc[ai][bj][m][1] * rs[ai][m];
            u32x4 w; w.x = pk2(v0[0], v0[1]); w.y = pk2(v0[2], v0[3]); w.z = pk2(v1[0], v1[1]); w.w = pk2(v1[2], v1[3]);
            *(u32x4*)(O + (size_t)row * ldc + EPI_COL(u)) = w; }
    }
};
struct EpiSwiglu {
    bf16_t* O; const float* bias;
    __device__ __forceinline__ void operator()(const f32x4 (&acc)[2][2][4][2], const pg8::Unit& u, int wr, int wc, int fr, int fq) const {
        const float* bg = bias + (size_t)u.aux * 2048 + u.pn * 128 + wc * 32 + fq * 8; const float* bu = bg + 1024;
        float bgv[8], buv[8];
#pragma unroll
        for (int j = 0; j < 8; ++j) { bgv[j] = bg[j]; buv[j] = bu[j]; }
#pragma unroll
        for (int ai = 0; ai < 2; ++ai)
#pragma unroll
            for (int m = 0; m < 4; ++m) {
                const int row = u.pm * 256 + ai * 128 + wr * 64 + m * 16 + fr;
                float r[8];
#pragma unroll
                for (int j = 0; j < 8; ++j) { float gt = acc[ai][0][m][j >> 2][j & 3] + bgv[j], up = acc[ai][1][m][j >> 2][j & 3] + buv[j];
                    gt = fminf(gt, 7.f); up = fminf(fmaxf(up, -7.f), 7.f); r[j] = gt * sigmoidf_(gt * 1.702f) * (up + 1.f); }
                u32x4 w; w.x = pk2(r[0], r[1]); w.y = pk2(r[2], r[3]); w.z = pk2(r[4], r[5]); w.w = pk2(r[6], r[7]);
                *(u32x4*)(O + (size_t)row * D + u.pn * 128 + wc * 32 + fq * 8) = w; }
    }
};
struct EpiDown {
    bf16_t* O; const float* bias; const float* rowgate;
    __device__ __forceinline__ void operator()(const f32x4 (&acc)[2][2][4][2], const pg8::Unit& u, int wr, int wc, int fr, int fq) const {
        float gt[2][4]; f32x4 bb[2][2];
#pragma unroll
        for (int ai = 0; ai < 2; ++ai)
#pragma unroll
            for (int m = 0; m < 4; ++m) gt[ai][m] = rowgate[u.pm * 256 + ai * 128 + wr * 64 + m * 16 + fr];
#pragma unroll
        for (int bj = 0; bj < 2; ++bj) { const float* bp = bias + (size_t)u.aux * D + u.pn * 256 + bj * 128 + wc * 32 + fq * 8; bb[bj][0] = *(const f32x4*)bp; bb[bj][1] = *(const f32x4*)(bp + 4); }
        EPI_LOOP { const int row = EPI_ROW(u), col = EPI_COL(u);
            const f32x4 v0 = (acc[ai][bj][m][0] + bb[bj][0]) * gt[ai][m], v1 = (acc[ai][bj][m][1] + bb[bj][1]) * gt[ai][m];
            u32x4 w; w.x = pk2(v0[0], v0[1]); w.y = pk2(v0[2], v0[3]); w.z = pk2(v1[0], v1[1]); w.w = pk2(v1[2], v1[3]);
            *(u32x4*)(O + (size_t)row * D + col) = w; }
    }
};
struct MoeOrder {
    int G, c, NPN; const LAS int* cum; const char* A; const char* Bt; size_t estepB; const int* rowtok;
    __device__ bool next(int i, pg8::Unit& u) const {
        const int nrb = cum[NE];
        int rb, pn;
        if ((G & 7) == 0 && (G / 8) % NPN == 0) { const int per = G / NPN, rpx = per / 8, xcd = c & 7, j = c >> 3; rb = i * per + xcd * rpx + j / NPN; pn = j % NPN; if (rb >= nrb) return false; }
        else { const int L = i * G + c; if (L >= nrb * NPN) return false; rb = L / NPN; pn = L % NPN; }
        int e = 0;
#pragma unroll 1
        for (int k = 1; k < NE; ++k) e += (rb >= cum[k]) ? 1 : 0;
        u.pm = rb; u.pn = pn; u.aux = e; u.rows = rowtok ? rowtok + rb * 256 : nullptr; u.a = rowtok ? A : A + (size_t)rb * 256 * D * 2; u.b = Bt + (size_t)e * estepB + (size_t)pn * 256 * D * 2; return true;
    }
};

struct TrItem { const float* W; bf16_t* WT; int K, N, ldw, dst_row0, k0, n0; };
__device__ __forceinline__ void tr_load(const TrItem& t, float (&v)[32], int lane) {
    const int n = t.n0 + (lane & 31); const bool ok = n < t.N; const float* src = t.W + (size_t)(t.k0 + (lane >> 5)) * t.ldw + (ok ? n : 0);
#pragma unroll
    for (int i = 0; i < 32; ++i) { const float x = src[(size_t)(2 * i) * t.ldw]; v[i] = ok ? x : 0.f; }
}
__device__ __forceinline__ void tr_lds_write(const float (&v)[32], LAS float* scr, int lane) {
#pragma unroll
    for (int i = 0; i < 32; ++i) scr[(2 * i + (lane >> 5)) * 33 + (lane & 31)] = v[i];
    LDS_FENCE();
}
__device__ __forceinline__ void tr_store(const TrItem& t, LAS float* scr, int lane) {
    const int c = lane & 7;
#pragma unroll
    for (int j = 0; j < 4; ++j) { const int nn = (lane >> 3) + 8 * j; const LAS float* sp = scr + (8 * c) * 33 + nn;
        u32x4 o; o.x = pk2(sp[0 * 33], sp[1 * 33]); o.y = pk2(sp[2 * 33], sp[3 * 33]); o.z = pk2(sp[4 * 33], sp[5 * 33]); o.w = pk2(sp[6 * 33], sp[7 * 33]);
        *(u32x4*)(t.WT + (size_t)(t.dst_row0 + nn) * t.K + t.k0 + 8 * c) = o; }
    LDS_FENCE();
}
__device__ __forceinline__ float rms_row_to_bf16(const float* xrow, const float* __restrict__ gain, bf16_t* orow, int lane) {
    const f32x4* xr = (const f32x4*)xrow + lane; const f32x4* gr = (const f32x4*)gain + lane;
    f32x4 v[4]; float s = 0.f;
#pragma unroll
    for (int j = 0; j < 4; ++j) { v[j] = xr[64 * j]; s += (v[j].x * v[j].x + v[j].y * v[j].y) + (v[j].z * v[j].z + v[j].w * v[j].w); }
    const float rstd = __builtin_amdgcn_rsqf(wave_sum(s) * (1.f / D) + 1e-6f);
    u32x2* o8 = (u32x2*)orow + lane;
#pragma unroll
    for (int j = 0; j < 4; ++j) { const f32x4 gg = gr[64 * j]; u32x2 w; w.x = pk2(v[j].x * rstd * gg.x, v[j].y * rstd * gg.y); w.y = pk2(v[j].z * rstd * gg.z, v[j].w * rstd * gg.w); o8[64 * j] = w; }
    return rstd;
}

__device__ __forceinline__ void rms_rows2_to_bf16(const float* xa, const float* xb, const float* __restrict__ gain, bf16_t* oa, bf16_t* ob, bool hasb, int lane) {
    const f32x4* ra = (const f32x4*)xa + lane; const f32x4* rb = (const f32x4*)xb + lane; const f32x4* gr = (const f32x4*)gain + lane;
    f32x4 va[4], vb[4], gg[4]; float sa = 0.f, sb = 0.f;
#pragma unroll
    for (int j = 0; j < 4; ++j) { va[j] = ra[64 * j]; vb[j] = rb[64 * j]; gg[j] = gr[64 * j]; }
    asm volatile("" ::: "memory");
#pragma unroll
    for (int j = 0; j < 4; ++j) { sa += (va[j].x * va[j].x + va[j].y * va[j].y) + (va[j].z * va[j].z + va[j].w * va[j].w); sb += (vb[j].x * vb[j].x + vb[j].y * vb[j].y) + (vb[j].z * vb[j].z + vb[j].w * vb[j].w); }
    const float rsa = __builtin_amdgcn_rsqf(wave_sum(sa) * (1.f / D) + 1e-6f), rsb = __builtin_amdgcn_rsqf(wave_sum(sb) * (1.f / D) + 1e-6f);
    u32x2* o8a = (u32x2*)oa + lane; u32x2* o8b = (u32x2*)ob + lane;
#pragma unroll
    for (int j = 0; j < 4; ++j) { u32x2 w; w.x = pk2(va[j].x * rsa * gg[j].x, va[j].y * rsa * gg[j].y); w.y = pk2(va[j].z * rsa * gg[j].z, va[j].w * rsa * gg[j].w); o8a[64 * j] = w;
        if (hasb) { u32x2 u; u.x = pk2(vb[j].x * rsb * gg[j].x, vb[j].y * rsb * gg[j].y); u.y = pk2(vb[j].z * rsb * gg[j].z, vb[j].w * rsb * gg[j].w); o8b[64 * j] = u; } }
}

template <int R> struct AttnState { float m[R], l[R], o[R][2]; };
template <int R> __device__ __forceinline__ void attn_init(AttnState<R>& st) {
#pragma unroll
    for (int h = 0; h < R; ++h) { st.m[h] = -1e30f; st.l[h] = 0.f; st.o[h][0] = 0.f; st.o[h][1] = 0.f; }
}
template <int R> __device__ __forceinline__ void attn_block(AttnState<R>& st, const LAS float* q, LAS float* pbuf, const bf16_t* krow, bool valid,
                                                           const bf16_t* vbase, int vstride, int jlo, int jhi, int lane, float scale, float* sraw) {
    float s[R];
#pragma unroll
    for (int h = 0; h < R; ++h) s[h] = 0.f;
    if (valid) {
        const u32x4* kp = (const u32x4*)krow;
#pragma unroll 4
        for (int c = 0; c < 16; ++c) {
            const u32x4 kv = kp[c];
            const float k0 = bflo(kv.x), k1 = bfhi(kv.x), k2 = bflo(kv.y), k3 = bfhi(kv.y), k4 = bflo(kv.z), k5 = bfhi(kv.z), k6 = bflo(kv.w), k7 = bfhi(kv.w);
#pragma unroll
            for (int h = 0; h < R; ++h) { const f32x4 qa = *(const LAS f32x4*)(q + h * 128 + c * 8), qb = *(const LAS f32x4*)(q + h * 128 + c * 8 + 4);
                s[h] += (k0 * qa.x + k1 * qa.y) + (k2 * qa.z + k3 * qa.w) + (k4 * qb.x + k5 * qb.y) + (k6 * qb.z + k7 * qb.w); }
        }
    }
    float alpha[R];
#pragma unroll
    for (int h = 0; h < R; ++h) {
        const float sv = valid ? s[h] * scale : -1e30f; if (sraw) sraw[h] = sv;
        const float bm = wave_max(sv), mn = fmaxf(st.m[h], bm); alpha[h] = __expf(st.m[h] - mn);
        const float p = valid ? __expf(sv - mn) : 0.f;
        st.l[h] = st.l[h] * alpha[h] + wave_sum(p); st.m[h] = mn; st.o[h][0] *= alpha[h]; st.o[h][1] *= alpha[h];
        pbuf[h * 64 + lane] = p;
    }
    LDS_FENCE();
    const bf16_t* vp = vbase + (size_t)jlo * vstride + 2 * lane;
#pragma unroll 4
    for (int j = jlo; j < jhi; ++j) {
        const unsigned vv = *(const unsigned*)vp; vp += vstride; const float v0 = bflo(vv), v1 = bfhi(vv);
#pragma unroll
        for (int h = 0; h < R; ++h) { const float p = pbuf[h * 64 + j]; st.o[h][0] += p * v0; st.o[h][1] += p * v1; }
    }
    LDS_FENCE();
}


#define MFMA16(a, b, c) __builtin_amdgcn_mfma_f32_16x16x32_bf16((a), (b), (c), 0, 0, 0)
#define FRAG(base, pitch, row, kcol) (*(const LAS bf16x8*)((base) + (row) * (pitch) + (kcol)))
__device__ __forceinline__ u32x2 pk4(const f32x4 v) { u32x2 w; w.x = pk2(v[0], v[1]); w.y = pk2(v[2], v[3]); return w; }
__device__ __forceinline__ u32x4 pk8(const f32x4 a, const f32x4 b) { u32x4 w; w.x = pk2(a[0], a[1]); w.y = pk2(a[2], a[3]); w.z = pk2(b[0], b[1]); w.w = pk2(b[2], b[3]); return w; }
constexpr int PK = 136, PC = 72;

__device__ __forceinline__ void gdn_chunk_item(const Params& p, unsigned char* ws, LAS unsigned char* lds, int item, int tid, int lane, int wave) {
    const int n = item & 127, bh = item >> 7, h = bh & 7, b = bh >> 3;
    const int tok0 = b * T + n * 64;
    const bf16_t* PROJ = (const bf16_t*)(ws + WS_PROJ);
    LAS bf16_t* K_RM = (LAS bf16_t*)(lds); LAS bf16_t* KB_RM = (LAS bf16_t*)(lds + 17408); LAS bf16_t* Q_RM = (LAS bf16_t*)(lds + 34816);
    LAS bf16_t* KT_RM = (LAS bf16_t*)(lds + 52224); LAS bf16_t* KBGT = (LAS bf16_t*)(lds + 70656); LAS bf16_t* VBT = (LAS bf16_t*)(lds + 89088);
    LAS float* sc = (LAS float*)(lds + 107520);
    unsigned char* chk = ws + WS_CHK + (size_t)item * CH_BYTES;
    const int fr = lane & 15, fq = lane >> 4, ksw = wave >> 2, ct = wave & 3;
    LAS float* cwl = (LAS float*)(lds + 108544);
    __syncthreads();
    for (int idx = tid; idx < 3 * 4 * 128; idx += NTHREADS) { const int w = idx >> 9, j = (idx >> 7) & 3, c = idx & 127; cwl[idx] = p.in[4][j * 3072 + w * 1024 + h * 128 + c]; }
    __syncthreads();
    {
        float kbv[16];
        const int r = tid >> 3, cg = tid & 7, t = n * 64 + r;
        const float gb = bf2f(PROJ[(size_t)(tok0 + r) * DINP + C_GB + h]), ga = bf2f(PROJ[(size_t)(tok0 + r) * DINP + C_GA + h]);
        const float beta = sigmoidf_(gb); const float xx = ga + p.in[6][h]; const float sp = xx > 20.f ? xx : log1pf(__expf(xx));
        if (cg == 0) sc[r] = -__expf(p.in[5][h]) * sp;
        u32x4 xr[3][4][2];
#define CONV_LOAD(w) do { _Pragma("unroll") for (int j = 0; j < 4; ++j) { const bool inb = (t - 3 + j >= 0); const u32x4* xp = (const u32x4*)(PROJ + (size_t)(inb ? tok0 + r - 3 + j : tok0) * DINP + (w) * 1024 + h * 128 + cg * 16); \
            xr[w][j][0] = xp[0]; xr[w][j][1] = xp[1]; } asm volatile("" ::: "memory"); } while (0)
        CONV_LOAD(0);
#pragma unroll
        for (int w = 0; w < 3; ++w) {
            if (w > 0) CONV_LOAD(w);
            const int ch0 = w * 1024 + h * 128 + cg * 16; (void)ch0;
            float a[16];
#pragma unroll
            for (int e = 0; e < 16; ++e) a[e] = 0.f;
#pragma unroll
            for (int j = 0; j < 4; ++j) {
                {
                    const bool inb = (t - 3 + j >= 0);
                    u32x4 x0 = xr[w][j][0], x1 = xr[w][j][1];
                    if (!inb) { x0 = (u32x4){0u, 0u, 0u, 0u}; x1 = x0; }
                    const LAS f32x4* wp = (const LAS f32x4*)(cwl + (w * 4 + j) * 128 + cg * 16); const f32x4 w0 = wp[0], w1 = wp[1], w2 = wp[2], w3 = wp[3];
                    a[0] += bflo(x0.x) * w0.x; a[1] += bfhi(x0.x) * w0.y; a[2] += bflo(x0.y) * w0.z; a[3] += bfhi(x0.y) * w0.w;
                    a[4] += bflo(x0.z) * w1.x; a[5] += bfhi(x0.z) * w1.y; a[6] += bflo(x0.w) * w1.z; a[7] += bfhi(x0.w) * w1.w;
                    a[8] += bflo(x1.x) * w2.x; a[9] += bfhi(x1.x) * w2.y; a[10] += bflo(x1.y) * w2.z; a[11] += bfhi(x1.y) * w2.w;
                    a[12] += bflo(x1.z) * w3.x; a[13] += bfhi(x1.z) * w3.y; a[14] += bflo(x1.w) * w3.z; a[15] += bfhi(x1.w) * w3.w;
                }
            }
            float ss = 0.f;
#pragma unroll
            for (int e = 0; e < 16; ++e) { a[e] = siluf_(a[e]); ss += a[e] * a[e]; }
            if (w < 2) { ss += __shfl_xor(ss, 1); ss += __shfl_xor(ss, 2); ss += __shfl_xor(ss, 4); const float rn = __builtin_amdgcn_rsqf(ss + 1e-6f) * (w == 0 ? 0.08838834764831845f : 1.f);
#pragma unroll
                for (int e = 0; e < 16; ++e) a[e] *= rn; }
            if (w == 0) { u32x4 o0, o1;
                o0.x = pk2(a[0], a[1]); o0.y = pk2(a[2], a[3]); o0.z = pk2(a[4], a[5]); o0.w = pk2(a[6], a[7]); o1.x = pk2(a[8], a[9]); o1.y = pk2(a[10], a[11]); o1.z = pk2(a[12], a[13]); o1.w = pk2(a[14], a[15]);
                *(LAS u32x4*)(Q_RM + r * PK + cg * 16) = o0; *(LAS u32x4*)(Q_RM + r * PK + cg * 16 + 8) = o1; }
            else if (w == 1) { u32x4 o0, o1;
                o0.x = pk2(a[0], a[1]); o0.y = pk2(a[2], a[3]); o0.z = pk2(a[4], a[5]); o0.w = pk2(a[6], a[7]); o1.x = pk2(a[8], a[9]); o1.y = pk2(a[10], a[11]); o1.z = pk2(a[12], a[13]); o1.w = pk2(a[14], a[15]);
                *(LAS u32x4*)(K_RM + r * PK + cg * 16) = o0; *(LAS u32x4*)(K_RM + r * PK + cg * 16 + 8) = o1;
#pragma unroll
                for (int e = 0; e < 16; ++e) { KT_RM[(cg * 16 + e) * PC + r] = (bf16_t)f2bf(a[e]); kbv[e] = a[e] * beta; }
                o0.x = pk2(kbv[0], kbv[1]); o0.y = pk2(kbv[2], kbv[3]); o0.z = pk2(kbv[4], kbv[5]); o0.w = pk2(kbv[6], kbv[7]); o1.x = pk2(kbv[8], kbv[9]); o1.y = pk2(kbv[10], kbv[11]); o1.z = pk2(kbv[12], kbv[13]); o1.w = pk2(kbv[14], kbv[15]);
                *(LAS u32x4*)(KB_RM + r * PK + cg * 16) = o0; *(LAS u32x4*)(KB_RM + r * PK + cg * 16 + 8) = o1; }
            else {
#pragma unroll
                for (int e = 0; e < 16; ++e) VBT[(cg * 16 + e) * PC + r] = (bf16_t)f2bf(a[e] * beta); }
        }
    }
    __syncthreads();
    if (wave == 0) { float v = sc[lane];
#pragma unroll
        for (int o = 1; o < 64; o <<= 1) { const float u = __shfl_up(v, o); if (lane >= o) v += u; }
        const float gl = __shfl(v, 63); sc[64 + lane] = v; sc[128 + lane] = __expf(v); sc[192 + lane] = __expf(gl - v);
        if (lane == 63) ((float*)(ws + WS_GL))[item] = __expf(v); }
    __syncthreads();
    { const int r = tid >> 3, cg = tid & 7; const float eg = sc[128 + r];
        const u32x4 k0 = *(const LAS u32x4*)(KB_RM + r * PK + cg * 16), k1 = *(const LAS u32x4*)(KB_RM + r * PK + cg * 16 + 8);
        const unsigned kw[8] = {k0.x, k0.y, k0.z, k0.w, k1.x, k1.y, k1.z, k1.w};
#pragma unroll
        for (int e = 0; e < 8; ++e) { KBGT[(cg * 16 + 2 * e) * PC + r] = (bf16_t)f2bf(bflo(kw[e]) * eg); KBGT[(cg * 16 + 2 * e + 1) * PC + r] = (bf16_t)f2bf(bfhi(kw[e]) * eg); } }
    f32x4 d1[2], d2[2], d3[2];
#pragma unroll
    for (int ti = 0; ti < 2; ++ti) { d1[ti] = (f32x4){0.f, 0.f, 0.f, 0.f}; d2[ti] = d1[ti]; d3[ti] = d1[ti]; }
#pragma unroll
    for (int kk = 0; kk < 4; ++kk) {
        const bf16x8 k_b = FRAG(K_RM, PK, 16 * ct + fr, 32 * kk + 8 * fq), kb_b = FRAG(KB_RM, PK, 16 * ct + fr, 32 * kk + 8 * fq), q_b = FRAG(Q_RM, PK, 16 * ct + fr, 32 * kk + 8 * fq);
#pragma unroll
        for (int ti = 0; ti < 2; ++ti) { const int row = 16 * (2 * ksw + ti) + fr;
            const bf16x8 kb_a = FRAG(KB_RM, PK, row, 32 * kk + 8 * fq), k_a = FRAG(K_RM, PK, row, 32 * kk + 8 * fq);
            d1[ti] = MFMA16(kb_a, k_b, d1[ti]); d2[ti] = MFMA16(k_a, kb_b, d2[ti]); d3[ti] = MFMA16(k_a, q_b, d3[ti]); }
    }
#pragma unroll
    for (int q = 0; q < 2; ++q) { const int idx = 2 * wave + q;
        { const int mt = idx >> 2, ks = idx & 3, c = 16 * mt + fr, i0 = 32 * ks + 4 * fq; const float eg = sc[128 + c];
            const u32x2 a = *(const LAS u32x2*)(Q_RM + c * PK + i0), bq = *(const LAS u32x2*)(Q_RM + c * PK + i0 + 16);
            u32x4 o; o.x = pk2(bflo(a.x) * eg, bfhi(a.x) * eg); o.y = pk2(bflo(a.y) * eg, bfhi(a.y) * eg); o.z = pk2(bflo(bq.x) * eg, bfhi(bq.x) * eg); o.w = pk2(bflo(bq.y) * eg, bfhi(bq.y) * eg);
            *(u32x4*)(chk + CH_QD + (idx * 64 + lane) * 16) = o; }
        { const int it = idx >> 1, ks = idx & 1, i = 16 * it + fr, c0 = 32 * ks + 4 * fq;
            const u32x2 a = *(const LAS u32x2*)(KT_RM + i * PC + c0), bq = *(const LAS u32x2*)(KT_RM + i * PC + c0 + 16);
            const f32x4 e0 = *(const LAS f32x4*)(sc + 192 + c0), e1 = *(const LAS f32x4*)(sc + 192 + c0 + 16);
            u32x4 o; o.x = pk2(bflo(a.x) * e0.x, bfhi(a.x) * e0.y); o.y = pk2(bflo(a.y) * e0.z, bfhi(a.y) * e0.w); o.z = pk2(bflo(bq.x) * e1.x, bfhi(bq.x) * e1.y); o.w = pk2(bflo(bq.y) * e1.z, bfhi(bq.y) * e1.w);
            *(u32x4*)(chk + CH_KDT + (idx * 64 + lane) * 16) = o; }
    }
    __syncthreads();
    LAS bf16_t* Xb0 = (LAS bf16_t*)(lds); LAS bf16_t* Xb1 = (LAS bf16_t*)(lds + 9216); LAS bf16_t* XTb0 = (LAS bf16_t*)(lds + 18432); LAS bf16_t* XTb1 = (LAS bf16_t*)(lds + 27648);
    LAS bf16_t* Pb0 = (LAS bf16_t*)(lds + 36864); LAS bf16_t* Pb1 = (LAS bf16_t*)(lds + 46080);
    f32x4 accP[2];
    {
        const int cidx = 16 * ct + fr; const float gc = sc[64 + cidx];
        f32x4 qk[2];
#pragma unroll
        for (int ti = 0; ti < 2; ++ti) { const int r0 = 16 * (2 * ksw + ti) + 4 * fq; const f32x4 gr = *(const LAS f32x4*)(sc + 64 + r0);
            f32x4 xt, xx;
#pragma unroll
            for (int r = 0; r < 4; ++r) { const int rr = r0 + r;
                xt[r] = (rr > cidx) ? -(d1[ti][r] * __expf(gr[r] - gc)) : 0.f;
                xx[r] = (cidx > rr) ? -(d2[ti][r] * __expf(gc - gr[r])) : 0.f;
                qk[ti][r] = (rr <= cidx) ? d3[ti][r] * __expf(gc - gr[r]) : 0.f;
                accP[ti][r] = xx[r] + (rr == cidx ? 1.f : 0.f); }
            *(LAS u32x2*)(XTb0 + cidx * PC + r0) = pk4(xt); *(LAS u32x2*)(Xb0 + cidx * PC + r0) = pk4(xx); *(LAS u32x2*)(Pb0 + cidx * PC + r0) = pk4(accP[ti]); }
        *(u32x4*)(chk + CH_QK + ((ct * 2 + ksw) * 64 + lane) * 16) = pk8(qk[0], qk[1]);
    }
    __syncthreads();
#pragma unroll
    for (int itn = 0; itn < 5; ++itn) {
        LAS bf16_t* Xc = (itn & 1) ? Xb1 : Xb0; LAS bf16_t* Xn = (itn & 1) ? Xb0 : Xb1; LAS bf16_t* XTc = (itn & 1) ? XTb1 : XTb0; LAS bf16_t* XTn = (itn & 1) ? XTb0 : XTb1;
        LAS bf16_t* Pc = (itn & 1) ? Pb1 : Pb0; LAS bf16_t* Pn = (itn & 1) ? Pb0 : Pb1;
        f32x4 e1[2], e2[2];
#pragma unroll
        for (int ti = 0; ti < 2; ++ti) { e1[ti] = (f32x4){0.f, 0.f, 0.f, 0.f}; e2[ti] = e1[ti]; }
#pragma unroll
        for (int kk = 0; kk < 2; ++kk) {
            const bf16x8 bxt = FRAG(XTc, PC, 16 * ct + fr, 32 * kk + 8 * fq), bx = FRAG(Xc, PC, 16 * ct + fr, 32 * kk + 8 * fq);
#pragma unroll
            for (int ti = 0; ti < 2; ++ti) { const int row = 16 * (2 * ksw + ti) + fr;
                e1[ti] = MFMA16(FRAG(Xc, PC, row, 32 * kk + 8 * fq), bxt, e1[ti]);
                if (itn < 4) e2[ti] = MFMA16(FRAG(XTc, PC, row, 32 * kk + 8 * fq), bx, e2[ti]); }
        }
#pragma unroll
        for (int ti = 0; ti < 2; ++ti) { const int r0 = 16 * (2 * ksw + ti) + 4 * fq;
            *(LAS u32x2*)(XTn + (16 * ct + fr) * PC + r0) = pk4(e1[ti]); if (itn < 4) *(LAS u32x2*)(Xn + (16 * ct + fr) * PC + r0) = pk4(e2[ti]); }
        __syncthreads();
#pragma unroll
        for (int kk = 0; kk < 2; ++kk) { const bf16x8 bp = FRAG(Pc, PC, 16 * ct + fr, 32 * kk + 8 * fq);
#pragma unroll
            for (int ti = 0; ti < 2; ++ti) accP[ti] = MFMA16(FRAG(XTn, PC, 16 * (2 * ksw + ti) + fr, 32 * kk + 8 * fq), bp, accP[ti]); }
#pragma unroll
        for (int ti = 0; ti < 2; ++ti) *(LAS u32x2*)(Pn + (16 * ct + fr) * PC + 16 * (2 * ksw + ti) + 4 * fq) = pk4(accP[ti]);
        __syncthreads();
    }
    LAS bf16_t* Tm = Pb1;
    {
        f32x4 u[4];
#pragma unroll
        for (int rt = 0; rt < 4; ++rt) u[rt] = (f32x4){0.f, 0.f, 0.f, 0.f};
#pragma unroll
        for (int kk = 0; kk < 2; ++kk) { const bf16x8 bv = FRAG(VBT, PC, 16 * wave + fr, 32 * kk + 8 * fq);
#pragma unroll
            for (int rt = 0; rt < 4; ++rt) u[rt] = MFMA16(FRAG(Tm, PC, 16 * rt + fr, 32 * kk + 8 * fq), bv, u[rt]); }
        f32x4* U = (f32x4*)(ws + WS_U) + ((size_t)(item * 8 + wave) * 4) * 64 + lane;
#pragma unroll
        for (int rt = 0; rt < 4; ++rt) U[rt * 64] = u[rt];
#pragma unroll
        for (int q = 0; q < 2; ++q) { const int ks2 = ksw + 2 * q;
            f32x4 w2[2] = {(f32x4){0.f, 0.f, 0.f, 0.f}, (f32x4){0.f, 0.f, 0.f, 0.f}};
#pragma unroll
            for (int kk = 0; kk < 2; ++kk) { const bf16x8 bt = FRAG(Tm, PC, 16 * ct + fr, 32 * kk + 8 * fq);
#pragma unroll
                for (int ti = 0; ti < 2; ++ti) w2[ti] = MFMA16(FRAG(KBGT, PC, 16 * (2 * ks2 + ti) + fr, 32 * kk + 8 * fq), bt, w2[ti]); }
            *(u32x4*)(chk + CH_NEGW + ((ct * 4 + ks2) * 64 + lane) * 16) = pk8(-w2[0], -w2[1]); }
    }
}

__device__ __forceinline__ void gdn_scan(unsigned char* ws, LAS unsigned char* lds, int sblk, int tid, int lane, int wave) {
    const int bh = sblk >> 1, half = sblk & 1, b = bh >> 3, h = bh & 7, sl = half * 4 + wave;
    const int fr = lane & 15, fq = lane >> 4;
    const unsigned char* chunks = ws + WS_CHK + (size_t)bh * 128 * CH_BYTES;
    const float* GL = (const float*)(ws + WS_GL) + bh * 128;
    float* GO = (float*)(ws + WS_GO);
#define GDN_STAGE(nn, buf) do { const unsigned char* _src = chunks + (size_t)(nn) * CH_BYTES; _Pragma("unroll") for (int _i = 0; _i < 7; ++_i) \
        __builtin_amdgcn_global_load_lds((const unsigned*)(_src + (_i * 512 + tid) * 16), (LAS unsigned*)(lds + (buf) * CH_BYTES + (_i * 512 + wave * 64) * 16), 16, 0, 0); } while (0)
    __syncthreads();
    GDN_STAGE(0, 0);
    f32x4 S[8]; bf16x8 Sb[4]; f32x4 ucur[4];
#pragma unroll
    for (int i = 0; i < 8; ++i) S[i] = (f32x4){0.f, 0.f, 0.f, 0.f};
#pragma unroll
    for (int i = 0; i < 4; ++i) Sb[i] = (bf16x8){0, 0, 0, 0, 0, 0, 0, 0};
    const f32x4* Ubase = (const f32x4*)(ws + WS_U) + ((size_t)(bh * 128) * 8 + sl) * 256 + lane;
    if (wave < 4) {
#pragma unroll
        for (int rt = 0; rt < 4; ++rt) ucur[rt] = Ubase[rt * 64];
    }
    asm volatile("s_waitcnt vmcnt(0)" ::: "memory");
    __syncthreads();
#pragma unroll 1
    for (int n = 0; n < 128; ++n) {
        const int buf = n & 1;
        if (n + 1 < 128) GDN_STAGE(n + 1, buf ^ 1);
        if (wave < 4) {
            const LAS unsigned char* L = lds + buf * CH_BYTES + lane * 16;
            f32x4 unext[4];
            if (n + 1 < 128) {
#pragma unroll
                for (int rt = 0; rt < 4; ++rt) unext[rt] = Ubase[(size_t)(n + 1) * 2048 + rt * 64];
            }
            const float gl = GL[n];
            f32x4 vn[4], o[4];
#pragma unroll
            for (int rt = 0; rt < 4; ++rt) { vn[rt] = ucur[rt]; o[rt] = (f32x4){0.f, 0.f, 0.f, 0.f}; }
#pragma unroll
            for (int ks = 0; ks < 4; ++ks)
#pragma unroll
                for (int rt = 0; rt < 4; ++rt) {
                    vn[rt] = MFMA16(*(const LAS bf16x8*)(L + CH_NEGW + (rt * 4 + ks) * 1024), Sb[ks], vn[rt]);
                    o[rt] = MFMA16(*(const LAS bf16x8*)(L + CH_QD + (rt * 4 + ks) * 1024), Sb[ks], o[rt]); }
            bf16x8 vb[2];
            vb[0] = __builtin_bit_cast(bf16x8, pk8(vn[0], vn[1])); vb[1] = __builtin_bit_cast(bf16x8, pk8(vn[2], vn[3]));
#pragma unroll
            for (int ks = 0; ks < 2; ++ks)
#pragma unroll
                for (int rt = 0; rt < 4; ++rt) o[rt] = MFMA16(*(const LAS bf16x8*)(L + CH_QK + (rt * 2 + ks) * 1024), vb[ks], o[rt]);
#pragma unroll
            for (int it = 0; it < 8; ++it) S[it] = S[it] * gl;
#pragma unroll
            for (int ks = 0; ks < 2; ++ks)
#pragma unroll
                for (int it = 0; it < 8; ++it) S[it] = MFMA16(*(const LAS bf16x8*)(L + CH_KDT + (it * 2 + ks) * 1024), vb[ks], S[it]);
#pragma unroll
            for (int ks = 0; ks < 4; ++ks) Sb[ks] = __builtin_bit_cast(bf16x8, pk8(S[2 * ks], S[2 * ks + 1]));
            float* go = GO + (size_t)(b * T + n * 64 + 4 * fq) * D + h * 128 + sl * 16 + fr;
#pragma unroll
            for (int rt = 0; rt < 4; ++rt)
#pragma unroll
                for (int r = 0; r < 4; ++r) go[(size_t)(16 * rt + r) * D] = o[rt][r];
            if (n + 1 < 128) {
#pragma unroll
                for (int rt = 0; rt < 4; ++rt) ucur[rt] = unext[rt];
            }
        }
        asm volatile("s_waitcnt vmcnt(0)" ::: "memory");
        __syncthreads();
    }
#undef GDN_STAGE
}


#define MFMA32(a, b, c) __builtin_amdgcn_mfma_f32_32x32x16_bf16((a), (b), (c), 0, 0, 0)
typedef float f32x16 __attribute__((ext_vector_type(16)));
typedef float f32x2v __attribute__((ext_vector_type(2)));
constexpr int NL_RING = 32768;
constexpr int NL_IMP = 65536, NL_Q = 98304, NL_QF = 65536, NL_SELM = 131072;
constexpr float NSA_C = 0.08838834764831845f * 1.4426950408889634f;
__device__ __forceinline__ int vperm16(int off) { return ((off >> 2) & 1) * 8 + (off >> 3) * 4 + (off & 3); }

__device__ __forceinline__ float xor32f(float x) { const unsigned u = __builtin_bit_cast(unsigned, x); auto r = __builtin_amdgcn_permlane32_swap(u, u, false, false);
    return __builtin_bit_cast(float, (threadIdx.x & 32) ? r[0] : r[1]); }
__device__ __forceinline__ float qxor1f(float x) { return __builtin_bit_cast(float, __builtin_amdgcn_update_dpp(0, __builtin_bit_cast(int, x), 0xB1, 0xF, 0xF, false)); }
__device__ __forceinline__ float qxor2f(float x) { return __builtin_bit_cast(float, __builtin_amdgcn_update_dpp(0, __builtin_bit_cast(int, x), 0x4E, 0xF, 0xF, false)); }
__device__ __forceinline__ int kimg_off(int key, int d) { return (((d >> 3) * 64 + key) << 3) + (d & 7); }
__device__ __forceinline__ int vimg_off(int dv, int kpos) { return (((kpos >> 3) * 128 + dv) << 3) + (kpos & 7); }
__device__ __forceinline__ void nsa_stage(LAS unsigned char* lds, int buf, const unsigned char* kimg, const unsigned char* vimg, bool withv, int tid, int wave) {
#pragma unroll
    for (int i = 0; i < 2; ++i) __builtin_amdgcn_global_load_lds((const unsigned*)(kimg + (i * 512 + tid) * 16), (LAS unsigned*)(lds + buf * NL_RING + (i * 512 + wave * 64) * 16), 16, 0, 0);
    if (withv) {
#pragma unroll
        for (int i = 0; i < 2; ++i) __builtin_amdgcn_global_load_lds((const unsigned*)(vimg + (i * 512 + tid) * 16), (LAS unsigned*)(lds + buf * NL_RING + 16384 + (i * 512 + wave * 64) * 16), 16, 0, 0);
    }
}
#define NSA_SYNC(N) do { asm volatile("s_waitcnt vmcnt(" #N ")" ::: "memory"); __builtin_amdgcn_s_barrier(); asm volatile("" ::: "memory"); } while (0)
template <int MODE, int KIND>
__device__ __forceinline__ void nsa_tile(const LAS unsigned char* kb, const LAS unsigned char* vb, int kt, const LAS unsigned char* qlds, const bf16x8 (&Qh)[4], f32x16 (&O)[4], float& m, float& l,
                                         bool colok, int tl, int lim, float il, LAS float* imp_row, int sidx0, int r32, int hi) {
    f32x16 acc;
#pragma unroll
    for (int i = 0; i < 16; ++i) acc[i] = 0.f;
    { const LAS unsigned char* kr = kb + hi * 1024 + (32 * kt + r32) * 16;
        bf16x8 kf[4], qf[4];
#pragma unroll
        for (int ks = 0; ks < 4; ++ks) { kf[ks] = *(const LAS bf16x8*)(kr + ks * 2048); qf[ks] = *(const LAS bf16x8*)(qlds + ks * 1024); }
#pragma unroll
        for (int ks = 0; ks < 4; ++ks) acc = MFMA32(kf[ks], qf[ks], acc);
#pragma unroll
        for (int ks = 0; ks < 4; ++ks) kf[ks] = *(const LAS bf16x8*)(kr + (4 + ks) * 2048);
#pragma unroll
        for (int ks = 0; ks < 4; ++ks) acc = MFMA32(kf[ks], Qh[ks], acc);
        __builtin_amdgcn_sched_group_barrier(0x100, 8, 0);
        __builtin_amdgcn_sched_group_barrier(0x008, 1, 0); __builtin_amdgcn_sched_group_barrier(0x100, 1, 0);
        __builtin_amdgcn_sched_group_barrier(0x008, 1, 0); __builtin_amdgcn_sched_group_barrier(0x100, 1, 0);
        __builtin_amdgcn_sched_group_barrier(0x008, 1, 0); __builtin_amdgcn_sched_group_barrier(0x100, 1, 0);
        __builtin_amdgcn_sched_group_barrier(0x008, 1, 0); __builtin_amdgcn_sched_group_barrier(0x100, 1, 0);
        __builtin_amdgcn_sched_group_barrier(0x008, 4, 0); }
    if (!(KIND == 2 && MODE == 0)) {
#pragma unroll
        for (int reg = 0; reg < 16; ++reg) { const int koff = (reg & 3) + 8 * (reg >> 2) + 4 * hi; bool ok;
            if (MODE == 0) ok = colok; else if (MODE == 1) ok = colok && (32 * kt + koff <= tl); else if (MODE == 2) ok = colok && (32 * kt + koff >= tl + 1); else ok = koff < lim;
            acc[reg] = ok ? acc[reg] : -3e38f; }
    }
    float p[16];
    if (KIND == 0) {
        float tmax = acc[0];
#pragma unroll
        for (int reg = 1; reg < 16; ++reg) tmax = fmaxf(tmax, acc[reg]);
        tmax = fmaxf(tmax, xor32f(tmax));
        const float mnew = fmaxf(m, tmax); l *= __builtin_amdgcn_exp2f((m - mnew) * NSA_C); m = mnew;
        const float mref = fmaxf(m, -1e30f) * NSA_C; float ps = 0.f;
#pragma unroll
        for (int reg = 0; reg < 16; ++reg) ps += __builtin_amdgcn_exp2f(__builtin_fmaf(acc[reg], NSA_C, -mref));
        l += ps + xor32f(ps);
    } else if (KIND == 2) {
        if (__any(m < -1e37f)) {
            float tmax = acc[0];
#pragma unroll
            for (int reg = 1; reg < 16; ++reg) tmax = fmaxf(tmax, acc[reg]);
            tmax = fmaxf(tmax, xor32f(tmax));
            if (MODE == 0) tmax = colok ? tmax : -3e38f;
            m = (m < -1e37f) ? tmax : m;
        }
        float mref = (m < -1e37f) ? 3e38f : m * NSA_C;
        if (MODE == 0) mref = colok ? mref : 3e38f;
        f32x2v ps2 = {0.f, 0.f};
#pragma unroll
        for (int reg = 0; reg < 16; reg += 2) { p[reg] = __builtin_amdgcn_exp2f(fminf(__builtin_fmaf(acc[reg], NSA_C, -mref), 100.f)); p[reg + 1] = __builtin_amdgcn_exp2f(fminf(__builtin_fmaf(acc[reg + 1], NSA_C, -mref), 100.f));
            ps2 += (f32x2v){p[reg], p[reg + 1]}; }
        const float ps = ps2.x + ps2.y;
        l += ps + xor32f(ps);
    } else {
        const float mref = fmaxf(m, -1e30f) * NSA_C;
#pragma unroll
        for (int reg = 0; reg < 16; ++reg) p[reg] = __builtin_amdgcn_exp2f(__builtin_fmaf(acc[reg], NSA_C, -mref)) * il;
#pragma unroll
        for (int q = 0; q < 4; ++q) { float gsum = 2.f * (p[4 * q] + p[4 * q + 1] + p[4 * q + 2]) + p[4 * q + 3], ls = p[4 * q + 3];
            gsum += qxor1f(gsum); ls += qxor1f(ls); gsum += qxor2f(gsum); ls += qxor2f(ls);
            if ((r32 & 3) == 0) { const int sidx = sidx0 + 2 * q + hi;
                __hip_atomic_fetch_add(imp_row + sidx, gsum, __ATOMIC_RELAXED, __HIP_MEMORY_SCOPE_WORKGROUP);
                if (sidx + 1 < NSEL) __hip_atomic_fetch_add(imp_row + sidx + 1, ls, __ATOMIC_RELAXED, __HIP_MEMORY_SCOPE_WORKGROUP); } }
    }
    if (KIND != 0) {
        bf16x8 pb[2];
#pragma unroll
        for (int s2 = 0; s2 < 2; ++s2) { u32x4 w; w.x = pk2(p[8 * s2], p[8 * s2 + 1]); w.y = pk2(p[8 * s2 + 2], p[8 * s2 + 3]); w.z = pk2(p[8 * s2 + 4], p[8 * s2 + 5]); w.w = pk2(p[8 * s2 + 6], p[8 * s2 + 7]); pb[s2] = __builtin_bit_cast(bf16x8, w); }
#pragma unroll
        for (int mt = 0; mt < 4; ++mt) { const LAS unsigned char* vr = vb + hi * 2048 + (32 * mt + r32) * 16;
#pragma unroll
            for (int s2 = 0; s2 < 2; ++s2) O[mt] = MFMA32(*(const LAS bf16x8*)(vr + (2 * kt + s2) * 4096), pb[s2], O[mt]); }
        __builtin_amdgcn_sched_group_barrier(0x100, 8, 1);
        __builtin_amdgcn_sched_group_barrier(0x008, 8, 1);
    }
}

template <int MODE>
__device__ __forceinline__ void nsa_block_fast(const LAS unsigned char* slot, const LAS unsigned char* qf, f32x16 (&O)[4], float m, float& l, bool colok, int tl, int r32, int hi) {
    const LAS unsigned char* kr = slot + hi * 1024 + r32 * 16;
    const LAS unsigned char* vb = slot + 16384 + hi * 2048 + r32 * 16;
    float mref = m * NSA_C;
    if (MODE == 0) mref = colok ? mref : 3e38f;
    f32x16 a0, a1;
#pragma unroll
    for (int i = 0; i < 16; ++i) { a0[i] = 0.f; a1[i] = 0.f; }
    bf16x8 vv[8];
    {
        bf16x8 qv[8], kv[8];
#pragma unroll
        for (int ks = 0; ks < 8; ++ks) { qv[ks] = *(const LAS bf16x8*)(qf + ks * 1024); kv[ks] = *(const LAS bf16x8*)(kr + ks * 2048); }
#pragma unroll
        for (int ks = 0; ks < 8; ++ks) a0 = MFMA32(kv[ks], qv[ks], a0);
#pragma unroll
        for (int ks = 0; ks < 8; ++ks) kv[ks] = *(const LAS bf16x8*)(kr + 512 + ks * 2048);
#pragma unroll
        for (int ks = 0; ks < 8; ++ks) a1 = MFMA32(kv[ks], qv[ks], a1);
    }
#pragma unroll
    for (int mt = 0; mt < 4; ++mt)
#pragma unroll
        for (int s2 = 0; s2 < 2; ++s2) vv[mt * 2 + s2] = *(const LAS bf16x8*)(vb + mt * 512 + s2 * 4096);
    f32x2v ps2 = {0.f, 0.f};
    bf16x8 pb[2];
#pragma unroll
    for (int reg = 0; reg < 16; reg += 2) { float x0 = a0[reg], x1 = a0[reg + 1];
        if (MODE != 0) { const int k0 = (reg & 3) + 8 * (reg >> 2) + 4 * hi, k1 = k0 + 1; const bool o0 = colok && (MODE == 1 ? (k0 <= tl) : (k0 >= tl + 1)), o1 = colok && (MODE == 1 ? (k1 <= tl) : (k1 >= tl + 1)); x0 = o0 ? x0 : -3e38f; x1 = o1 ? x1 : -3e38f; }
        x0 = __builtin_amdgcn_exp2f(fminf(__builtin_fmaf(x0, NSA_C, -mref), 100.f)); x1 = __builtin_amdgcn_exp2f(fminf(__builtin_fmaf(x1, NSA_C, -mref), 100.f));
        ps2 += (f32x2v){x0, x1}; a0[reg] = x0; a0[reg + 1] = x1; }
#pragma unroll
    for (int s2 = 0; s2 < 2; ++s2) { u32x4 w; w.x = pk2(a0[8 * s2], a0[8 * s2 + 1]); w.y = pk2(a0[8 * s2 + 2], a0[8 * s2 + 3]); w.z = pk2(a0[8 * s2 + 4], a0[8 * s2 + 5]); w.w = pk2(a0[8 * s2 + 6], a0[8 * s2 + 7]); pb[s2] = __builtin_bit_cast(bf16x8, w); }
#pragma unroll
    for (int mt = 0; mt < 4; ++mt)
#pragma unroll
        for (int s2 = 0; s2 < 2; ++s2) O[mt] = MFMA32(vv[mt * 2 + s2], pb[s2], O[mt]);
#pragma unroll
    for (int mt = 0; mt < 4; ++mt)
#pragma unroll
        for (int s2 = 0; s2 < 2; ++s2) vv[mt * 2 + s2] = *(const LAS bf16x8*)(vb + mt * 512 + (2 + s2) * 4096);
#pragma unroll
    for (int reg = 0; reg < 16; reg += 2) { float x0 = a1[reg], x1 = a1[reg + 1];
        if (MODE != 0) { const int k0 = 32 + (reg & 3) + 8 * (reg >> 2) + 4 * hi, k1 = k0 + 1; const bool o0 = colok && (MODE == 1 ? (k0 <= tl) : (k0 >= tl + 1)), o1 = colok && (MODE == 1 ? (k1 <= tl) : (k1 >= tl + 1)); x0 = o0 ? x0 : -3e38f; x1 = o1 ? x1 : -3e38f; }
        x0 = __builtin_amdgcn_exp2f(fminf(__builtin_fmaf(x0, NSA_C, -mref), 100.f)); x1 = __builtin_amdgcn_exp2f(fminf(__builtin_fmaf(x1, NSA_C, -mref), 100.f));
        ps2 += (f32x2v){x0, x1}; a1[reg] = x0; a1[reg + 1] = x1; }
#pragma unroll
    for (int s2 = 0; s2 < 2; ++s2) { u32x4 w; w.x = pk2(a1[8 * s2], a1[8 * s2 + 1]); w.y = pk2(a1[8 * s2 + 2], a1[8 * s2 + 3]); w.z = pk2(a1[8 * s2 + 4], a1[8 * s2 + 5]); w.w = pk2(a1[8 * s2 + 6], a1[8 * s2 + 7]); pb[s2] = __builtin_bit_cast(bf16x8, w); }
#pragma unroll
    for (int mt = 0; mt < 4; ++mt)
#pragma unroll
        for (int s2 = 0; s2 < 2; ++s2) O[mt] = MFMA32(vv[mt * 2 + s2], pb[s2], O[mt]);
    const float ps = ps2.x + ps2.y;
    l += ps + xor32f(ps);
}
template <int MODE>
__device__ __forceinline__ void nsa_block(const LAS unsigned char* slot, const LAS unsigned char* qf, f32x16 (&O)[4], float& m, float& l, bool colok, int tl, int r32, int hi) {
    if (__any(m < -1e37f)) {
        bf16x8 Qh[4];
#pragma unroll
        for (int ks = 0; ks < 4; ++ks) Qh[ks] = *(const LAS bf16x8*)(qf + (4 + ks) * 1024);
#pragma unroll 1
        for (int kt = 0; kt < 2; ++kt) nsa_tile<MODE, 2>(slot, slot + 16384, kt, qf, Qh, O, m, l, colok, tl, 0, 0.f, (LAS float*)slot, 0, r32, hi);
    } else nsa_block_fast<MODE>(slot, qf, O, m, l, colok, tl, r32, hi);
}

__device__ __forceinline__ void nsa_item(const Params& p, unsigned char* ws, LAS unsigned char* lds, int item, int tid, int lane, int wave) {
    const int tile = 127 - (item >> 2), bg = item & 3, b = bg >> 1, g = bg & 1, t0 = tile * 64, cur = tile;
    const int r32 = lane & 31, hi = lane >> 5, tl = 8 * wave + (r32 >> 2), head = g * 4 + (r32 & 3), t = t0 + tl, tok = b * T + t;
    const bf16_t* PROJ = (const bf16_t*)(ws + WS_PROJ);
    LAS float* IMP = (LAS float*)(lds + NL_IMP); LAS unsigned* SELM = (LAS unsigned*)(lds + NL_SELM);
    __syncthreads();
    nsa_stage(lds, 0, ws + WS_KC + (size_t)(bg * 8) * 16384, ws + WS_VC, false, tid, wave);
    for (int idx = tid; idx < 64 * NSEL; idx += NTHREADS) IMP[idx] = 0.f;
    LAS unsigned char* const qlds = lds + NL_Q + wave * 4096 + hi * 512 + r32 * 16;
    bf16x8 Qh[4];
#pragma unroll
    for (int ks = 0; ks < 4; ++ks) { *(LAS bf16x8*)(qlds + ks * 1024) = *(const bf16x8*)(PROJ + (size_t)tok * DINP + C_NQ + head * 128 + 16 * ks + 8 * hi);
        Qh[ks] = *(const bf16x8*)(PROJ + (size_t)tok * DINP + C_NQ + head * 128 + 16 * (4 + ks) + 8 * hi); }
    f32x16 O[4];
    float m, l;
#define OB_PTR() bf16_t* ob; { int tk_ = tok; asm volatile("" : "+v"(tk_)); ob = (bf16_t*)(ws + WS_OB) + (size_t)tk_ * D + head * 128 + 4 * hi; }
#define O_ZERO() do { _Pragma("unroll") for (int mt = 0; mt < 4; ++mt) _Pragma("unroll") for (int i = 0; i < 16; ++i) O[mt][i] = 0.f; } while (0)
#define RING_LOOP(NBLK, NOPS, STAGE, ...) do { const int nblk_ = (NBLK); \
        { const int sb_ = 0, slot_ = 0; STAGE; } if (nblk_ > 1) { const int sb_ = 1, slot_ = 1; STAGE; NSA_SYNC(NOPS); } else { NSA_SYNC(0); } \
        int cs_ = 0; \
        _Pragma("unroll 1") for (int st_ = 0; st_ < 2 * nblk_; ++st_) { \
            const int s = st_ >> 1, kt = st_ & 1; const bool more_ = (s + 2 < nblk_); \
            if (kt == 0 && more_) { const int sb_ = s + 2, slot_ = (cs_ == 0 ? 2 : cs_ - 1); STAGE; } \
            { const LAS unsigned char* slotp = lds + cs_ * NL_RING; __VA_ARGS__; } \
            if (kt == 1) { if (more_) { NSA_SYNC(NOPS); } else { NSA_SYNC(0); } cs_ = (cs_ == 2 ? 0 : cs_ + 1); } } } while (0)
#define RING_LOOPB(NBLK, NOPS, STAGE, ...) do { const int nblk_ = (NBLK); \
        { const int sb_ = 0, slot_ = 0; STAGE; } if (nblk_ > 1) { const int sb_ = 1, slot_ = 1; STAGE; NSA_SYNC(NOPS); } else { NSA_SYNC(0); } \
        int cs_ = 0; \
        _Pragma("unroll 1") for (int s = 0; s < nblk_; ++s) { const bool more_ = (s + 2 < nblk_); \
            if (more_) { const int sb_ = s + 2, slot_ = (cs_ == 0 ? 2 : cs_ - 1); STAGE; } \
            { const LAS unsigned char* slotp = lds + cs_ * NL_RING; __VA_ARGS__; } \
            if (more_) { NSA_SYNC(NOPS); } else { NSA_SYNC(0); } cs_ = (cs_ == 2 ? 0 : cs_ + 1); } } while (0)
#define RING_LOOP2(NBLK, NOPS, STAGE, ...) do { const int nblk_ = (NBLK); \
        NSA_SYNC(0);   \
        _Pragma("unroll 1") for (int st_ = 0; st_ < 2 * nblk_; ++st_) { \
            const int s = st_ >> 1, kt = st_ & 1; \
            if (kt == 0 && s + 1 < nblk_) { const int sb_ = s + 1, slot_ = (s + 1) & 1; STAGE; } \
            { const LAS unsigned char* slotp = lds + (s & 1) * NL_RING; __VA_ARGS__; } \
            if (kt == 1) { NSA_SYNC(0); } } } while (0)
#define RING_LOOPB2(NBLK, STAGE, ...) do { const int nblk_ = (NBLK); \
        NSA_SYNC(0);   \
        _Pragma("unroll 1") for (int s = 0; s < nblk_; ++s) { \
            if (s + 1 < nblk_) { const int sb_ = s + 1, slot_ = (s + 1) & 1; STAGE; } \
            { const LAS unsigned char* slotp = lds + (s & 1) * NL_RING; __VA_ARGS__; } \
            NSA_SYNC(0); } } while (0)
#define RING_LOOP4(NBLK, STAGE, ...) do { const int nblk_ = (NBLK); \
        { const int sb_ = 0, slot_ = 0; STAGE; } if (nblk_ > 1) { const int sb_ = 1, slot_ = 1; STAGE; } if (nblk_ > 2) { const int sb_ = 2, slot_ = 2; STAGE; } \
        if (nblk_ > 2) { NSA_SYNC(8); } else if (nblk_ > 1) { NSA_SYNC(4); } else { NSA_SYNC(0); } \
        int cs_ = 0; \
        _Pragma("unroll 1") for (int st_ = 0; st_ < 2 * nblk_; ++st_) { \
            const int s = st_ >> 1, kt = st_ & 1; \
            if (kt == 0 && s + 3 < nblk_) { const int sb_ = s + 3, slot_ = (cs_ + 3) & 3; STAGE; } \
            { const LAS unsigned char* slotp = lds + cs_ * NL_RING; __VA_ARGS__; } \
            if (kt == 1) { if (s + 3 < nblk_) { NSA_SYNC(8); } else if (s + 2 < nblk_) { NSA_SYNC(4); } else { NSA_SYNC(0); } cs_ = (cs_ + 1) & 3; } } } while (0)
    const int nvis = t >= 31 ? min((t - 31) / 16 + 1, NCMP) : 0;
    const int nbc = (min(4 * tile + 3, NCMP) + 63) >> 6;
    const unsigned char* kcb = ws + WS_KC + (size_t)(b * 2 + g) * 8 * 16384; const unsigned char* vcb = ws + WS_VC + (size_t)(b * 2 + g) * 8 * 16384;
    m = -3e38f; l = 0.f;
    RING_LOOP2(nbc, 2, nsa_stage(lds, slot_, kcb + (size_t)sb_ * 16384, vcb, false, tid, wave),
              (nsa_tile<3, 0>(slotp, slotp + 16384, kt, qlds, Qh, O, m, l, true, tl, nvis - 64 * s - 32 * kt, 0.f, IMP, 0, r32, hi)));
    nsa_stage(lds, 0, kcb, vcb, true, tid, wave);
    {
        const float il = 1.f / fmaxf(l, 1e-30f);
        O_ZERO();
        RING_LOOP2(nbc, 4, nsa_stage(lds, slot_, kcb + (size_t)sb_ * 16384, vcb + (size_t)sb_ * 16384, true, tid, wave),
                  (nsa_tile<3, 1>(slotp, slotp + 16384, kt, qlds, Qh, O, m, l, true, tl, nvis - 64 * s - 32 * kt, il, IMP + tl * NSEL, 16 * s + 8 * kt, r32, hi)));
        nsa_stage(lds, 0, ws + WS_KSR + (size_t)(bg * 128) * 16384, ws + WS_VST + (size_t)(bg * 128) * 16384, true, tid, wave);
        const float gt = sigmoidf_(bf2f(PROJ[(size_t)tok * DINP + C_NG + head * 3 + 0]));
        OB_PTR();
#pragma unroll
        for (int mt = 0; mt < 4; ++mt)
#pragma unroll
            for (int q = 0; q < 4; ++q) { u32x2 w; w.x = pk2(O[mt][4 * q] * gt, O[mt][4 * q + 1] * gt); w.y = pk2(O[mt][4 * q + 2] * gt, O[mt][4 * q + 3] * gt); *(u32x2*)(ob + 32 * mt + 8 * q) = w; }
    }
    {
#pragma unroll 1
        for (int tt = 0; tt < 8; ++tt) { const int tokl = 8 * wave + tt; const LAS float* ip = IMP + tokl * NSEL;
            unsigned key0 = 0u, key1 = 0u;
            { const int s0 = lane, s1 = lane + 64;
                if (s0 <= cur) { const bool forced = (s0 == 0) || (s0 == cur) || (s0 == cur - 1); key0 = ((__builtin_bit_cast(unsigned, ip[s0] + (forced ? 1e4f : 0.f)) | 0x80u) & ~0x7Fu) | (unsigned)(127 - s0); }
                if (s1 <= cur) { const bool forced = (s1 == cur) || (s1 == cur - 1); key1 = ((__builtin_bit_cast(unsigned, ip[s1] + (forced ? 1e4f : 0.f)) | 0x80u) & ~0x7Fu) | (unsigned)(127 - s1); } }
            unsigned thr = 0u;
#pragma unroll 4
            for (int bit = 31; bit >= 0; --bit) { const unsigned trial = thr | (1u << bit);
                const int cnt = __popcll(__ballot(key0 >= trial)) + __popcll(__ballot(key1 >= trial));
                thr = (cnt >= TOPN) ? trial : thr; }
            const unsigned long long b0 = __ballot(key0 != 0u && key0 >= thr), b1 = __ballot(key1 != 0u && key1 >= thr);
            if (lane == 0) { SELM[tokl * 4 + 0] = (unsigned)b0; SELM[tokl * 4 + 1] = (unsigned)(b0 >> 32); SELM[tokl * 4 + 2] = (unsigned)b1; SELM[tokl * 4 + 3] = (unsigned)(b1 >> 32); }
        }
        LDS_FENCE();
    }
    __syncthreads();
    LAS unsigned char* const qf = lds + NL_QF + wave * 8192 + hi * 512 + r32 * 16;
    { int tk_ = tok; asm volatile("" : "+v"(tk_)); const bf16_t* qr = (const bf16_t*)(ws + WS_QR) + (size_t)tk_ * D + head * 128 + 8 * hi;
#pragma unroll
        for (int ks = 0; ks < 8; ++ks) *(LAS bf16x8*)(qf + ks * 1024) = *(const bf16x8*)(qr + 16 * ks); }
    {
        const unsigned char* kb0 = ws + WS_KSR + (size_t)(b * 2 + g) * 128 * 16384; const unsigned char* vb0 = ws + WS_VST + (size_t)(b * 2 + g) * 128 * 16384;
        m = -3e38f; l = 0.f; O_ZERO();
        RING_LOOPB2(cur + 1, nsa_stage(lds, slot_, kb0 + (size_t)sb_ * 16384, vb0 + (size_t)sb_ * 16384, true, tid, wave),
                  { const bool colok = (SELM[tl * 4 + (s >> 5)] >> (s & 31)) & 1u;
                    if (__any(colok)) { if (s == cur) nsa_block<1>(slotp, qf, O, m, l, colok, tl, r32, hi); else nsa_block<0>(slotp, qf, O, m, l, colok, tl, r32, hi); } });
        { const int slo_ = cur >= 8 ? cur - 8 : 0; nsa_stage(lds, 0, ws + WS_KWR + (size_t)(bg * 128 + slo_) * 16384, ws + WS_VWT + (size_t)(bg * 128 + slo_) * 16384, true, tid, wave); }
        const float gt = sigmoidf_(bf2f(PROJ[(size_t)tok * DINP + C_NG + head * 3 + 1])) / fmaxf(l, 1e-30f);
        OB_PTR();
        u32x2 ow[16];
#pragma unroll
        for (int i = 0; i < 16; ++i) ow[i] = *(const u32x2*)(ob + 32 * (i >> 2) + 8 * (i & 3));
        asm volatile("" ::: "memory");
#pragma unroll
        for (int mt = 0; mt < 4; ++mt)
#pragma unroll
            for (int q = 0; q < 4; ++q) { u32x2 w = ow[mt * 4 + q];
                w.x = pk2(bflo(w.x) + O[mt][4 * q] * gt, bfhi(w.x) + O[mt][4 * q + 1] * gt); w.y = pk2(bflo(w.y) + O[mt][4 * q + 2] * gt, bfhi(w.y) + O[mt][4 * q + 3] * gt); *(u32x2*)(ob + 32 * mt + 8 * q) = w; }
    }
    {
        const int slo = cur >= 8 ? cur - 8 : 0;
        const unsigned char* kb0 = ws + WS_KWR + (size_t)((b * 2 + g) * 128 + slo) * 16384; const unsigned char* vb0 = ws + WS_VWT + (size_t)((b * 2 + g) * 128 + slo) * 16384;
        m = -3e38f; l = 0.f; O_ZERO();
        RING_LOOPB2(cur - slo + 1, nsa_stage(lds, slot_, kb0 + (size_t)sb_ * 16384, vb0 + (size_t)sb_ * 16384, true, tid, wave),
                  { const int sa = slo + s; if (sa == cur) nsa_block<1>(slotp, qf, O, m, l, true, tl, r32, hi);
                    else if (sa == cur - 8) nsa_block<2>(slotp, qf, O, m, l, true, tl, r32, hi);
                    else nsa_block<0>(slotp, qf, O, m, l, true, tl, r32, hi); });
        const float gt = sigmoidf_(bf2f(PROJ[(size_t)tok * DINP + C_NG + head * 3 + 2])) / fmaxf(l, 1e-30f);
        OB_PTR();
        u32x2 ow[16];
#pragma unroll
        for (int i = 0; i < 16; ++i) ow[i] = *(const u32x2*)(ob + 32 * (i >> 2) + 8 * (i & 3));
        asm volatile("" ::: "memory");
#pragma unroll
        for (int mt = 0; mt < 4; ++mt)
#pragma unroll
            for (int q = 0; q < 4; ++q) { u32x2 w = ow[mt * 4 + q];
                w.x = pk2(bflo(w.x) + O[mt][4 * q] * gt, bfhi(w.x) + O[mt][4 * q + 1] * gt); w.y = pk2(bflo(w.y) + O[mt][4 * q + 2] * gt, bfhi(w.y) + O[mt][4 * q + 3] * gt); *(u32x2*)(ob + 32 * mt + 8 * q) = w; }
    }
    asm volatile("s_waitcnt vmcnt(0)" ::: "memory");
#undef OB_PTR
#undef O_ZERO
}

__device__ __forceinline__ void cmp_item(const Params& p, unsigned char* ws, LAS unsigned char* lds, int item, int tid, int lane, int wave) {
    const int which = item >> 6, b = (item >> 5) & 1, g = (item >> 4) & 1, n0 = (item & 15) * 32;
    const bf16_t* PROJ = (const bf16_t*)(ws + WS_PROJ);
    const int ccol = (which ? C_NVC : C_NKC) + g * 128;
    const float* pe = p.in[which ? 11 : 8];
    const unsigned char* w1t = ws + WS_W1T + (size_t)which * 128 * 4096 * 2;
    const int fr = lane & 15, fq = lane >> 4;
    LAS unsigned char* LA = lds; LAS unsigned char* LB = lds + 16384; LAS bf16_t* HID = (LAS bf16_t*)(lds + 81920); LAS bf16_t* W2L = (LAS bf16_t*)(lds + 90624);
    __syncthreads();
    { const bf16_t* w2t = (const bf16_t*)(ws + WS_W2T) + which * 128 * 128;
        for (int idx = tid; idx < 128 * 16; idx += NTHREADS) { const int rr = idx >> 4, c = idx & 15; *(LAS u32x4*)(W2L + rr * PK + c * 8) = *(const u32x4*)(w2t + rr * 128 + c * 8); } }
    const int arow = tid >> 4, ach = tid & 15;
    auto stageB = [&](int pp, int buf) {
#pragma unroll
        for (int i = 0; i < 4; ++i) { const int pi = tid + 512 * i, row = pi >> 4, ch = (pi & 15) ^ (row & 15);
            __builtin_amdgcn_global_load_lds((const unsigned*)(w1t + (size_t)row * 8192 + pp * 256 + ch * 16), (LAS unsigned*)(LB + buf * 32768 + (i * 512 + wave * 64) * 16), 16, 0, 0); } };
    auto loadA = [&](int pp) -> u32x4 { const int tkn = 16 * (n0 + arow) + pp;
        if (tkn >= T) return (u32x4){0u, 0u, 0u, 0u};
        const u32x4 x = *(const u32x4*)(PROJ + (size_t)(b * T + tkn) * DINP + ccol + ach * 8); const f32x4 e0 = *(const f32x4*)(pe + pp * 128 + ach * 8), e1 = *(const f32x4*)(pe + pp * 128 + ach * 8 + 4);
        u32x4 o; o.x = pk2(bflo(x.x) + e0.x, bfhi(x.x) + e0.y); o.y = pk2(bflo(x.y) + e0.z, bfhi(x.y) + e0.w); o.z = pk2(bflo(x.z) + e1.x, bfhi(x.z) + e1.y); o.w = pk2(bflo(x.w) + e1.z, bfhi(x.w) + e1.w); return o; };
    f32x4 acc[2] = {(f32x4){0.f, 0.f, 0.f, 0.f}, (f32x4){0.f, 0.f, 0.f, 0.f}};
    stageB(0, 0); u32x4 areg = loadA(0);
    *(LAS u32x4*)(LA + arow * 256 + ((ach ^ (arow & 15)) << 4)) = areg;
    asm volatile("s_waitcnt vmcnt(0)" ::: "memory"); __syncthreads();
#pragma unroll 1
    for (int pp = 0; pp < 32; ++pp) { const int buf = pp & 1;
        if (pp + 1 < 32) { stageB(pp + 1, buf ^ 1); areg = loadA(pp + 1); }
        const LAS unsigned char* Ab = LA + buf * 8192; const LAS unsigned char* Bb = LB + buf * 32768;
#pragma unroll
        for (int kk = 0; kk < 4; ++kk) { const int wrow = 16 * wave + fr;
            const bf16x8 wf = *(const LAS bf16x8*)(Bb + wrow * 256 + (((4 * kk + fq) ^ (wrow & 15)) << 4));
#pragma unroll
            for (int nt = 0; nt < 2; ++nt) { const int nrow = 16 * nt + fr;
                acc[nt] = MFMA16(wf, *(const LAS bf16x8*)(Ab + nrow * 256 + (((4 * kk + fq) ^ (nrow & 15)) << 4)), acc[nt]); } }
        if (pp + 1 < 32) *(LAS u32x4*)(LA + (buf ^ 1) * 8192 + arow * 256 + ((ach ^ (arow & 15)) << 4)) = areg;
        asm volatile("s_waitcnt vmcnt(0)" ::: "memory"); __syncthreads();
    }
#pragma unroll
    for (int nt = 0; nt < 2; ++nt) { f32x4 hv;
#pragma unroll
        for (int r = 0; r < 4; ++r) hv[r] = siluf_(acc[nt][r]);
        *(LAS u32x2*)(HID + (16 * nt + fr) * PK + 16 * wave + 4 * fq) = pk4(hv); }
    __syncthreads();
    if (which == 0) {
        f32x4 o[2] = {(f32x4){0.f, 0.f, 0.f, 0.f}, (f32x4){0.f, 0.f, 0.f, 0.f}};
#pragma unroll
        for (int kk = 0; kk < 4; ++kk) { const bf16x8 af = FRAG(W2L, PK, 16 * wave + fr, 32 * kk + 8 * fq);
#pragma unroll
            for (int nt = 0; nt < 2; ++nt) o[nt] = MFMA16(af, FRAG(HID, PK, 16 * nt + fr, 32 * kk + 8 * fq), o[nt]); }
#pragma unroll
        for (int nt = 0; nt < 2; ++nt) { const int n = n0 + 16 * nt + fr; const f32x4 z = {0.f, 0.f, 0.f, 0.f};
            *(u32x2*)((bf16_t*)(ws + WS_KC) + ((size_t)((b * 2 + g) * 8 + (n >> 6)) << 13) + kimg_off(n & 63, 16 * wave + 4 * fq)) = pk4(n < NCMP ? o[nt] : z); }
    } else {
        f32x4 o[2] = {(f32x4){0.f, 0.f, 0.f, 0.f}, (f32x4){0.f, 0.f, 0.f, 0.f}};
#pragma unroll
        for (int kk = 0; kk < 4; ++kk) { const bf16x8 bfw = FRAG(W2L, PK, 16 * wave + fr, 32 * kk + 8 * fq);
#pragma unroll
            for (int nt = 0; nt < 2; ++nt) o[nt] = MFMA16(FRAG(HID, PK, 16 * nt + fr, 32 * kk + 8 * fq), bfw, o[nt]); }
#pragma unroll
        for (int nt = 0; nt < 2; ++nt) { f32x4 v = o[nt]; if (n0 + 16 * nt + 4 * fq + 3 >= NCMP) { if (n0 + 16 * nt + 4 * fq + 3 == NCMP) v[3] = 0.f; }
            { const int nb = n0 + 16 * nt; *(u32x2*)((bf16_t*)(ws + WS_VC) + ((size_t)((b * 2 + g) * 8 + (nb >> 6)) << 13) + vimg_off(16 * wave + fr, (nb & 63) + (fq & 1) * 8 + (fq >> 1) * 4)) = pk4(v); } }
    }
}

__device__ __forceinline__ void xattn_item(unsigned char* ws, LAS unsigned char* lds, int item, int tid, int lane, int wave) {
    const int b = item >> 7, h = (item >> 5) & 3, t0 = (item & 31) * 256;
    const int r32 = lane & 31, hi = lane >> 5, tok = b * T + t0 + 32 * wave + r32;
    LAS unsigned char* const qf = lds + NL_QF + wave * 8192 + hi * 512 + r32 * 16;
    __syncthreads();
#pragma unroll
    for (int ks = 0; ks < 8; ++ks) *(LAS bf16x8*)(qf + ks * 1024) = *(const bf16x8*)((const bf16_t*)(ws + WS_QX) + (size_t)tok * XD + h * 128 + 16 * ks + 8 * hi);
    f32x16 O[4]; float m = -3e38f, l = 0.f;
#pragma unroll
    for (int mt = 0; mt < 4; ++mt)
#pragma unroll
        for (int i = 0; i < 16; ++i) O[mt][i] = 0.f;
    const unsigned char* kb0 = ws + WS_XVT + 524288 + (size_t)(b * 4 + h) * 4 * 16384; const unsigned char* vb0 = ws + WS_XVT + (size_t)(b * 4 + h) * 4 * 16384;
    __syncthreads();
    nsa_stage(lds, 0, kb0, vb0, true, tid, wave);
    RING_LOOPB2(4, nsa_stage(lds, slot_, kb0 + (size_t)sb_ * 16384, vb0 + (size_t)sb_ * 16384, true, tid, wave),
              (nsa_block<0>(slotp, qf, O, m, l, true, 0, r32, hi)));
    const float il = 1.f / l;
    bf16_t* ox = (bf16_t*)(ws + WS_OX) + (size_t)tok * XD + h * 128 + 4 * hi;
#pragma unroll
    for (int mt = 0; mt < 4; ++mt)
#pragma unroll
        for (int q = 0; q < 4; ++q) { u32x2 w; w.x = pk2(O[mt][4 * q] * il, O[mt][4 * q + 1] * il); w.y = pk2(O[mt][4 * q + 2] * il, O[mt][4 * q + 3] * il); *(u32x2*)(ox + 32 * mt + 8 * q) = w; }
}


#define XB_TMO      128
#define XB_XCNT(j)  (256  + 64 * (j))
#define XB_XSUB(j)  (1280 + 64 * (j))
#define XB_XGEN(j)  (2304 + 64 * (j))
#define XB_TOP      3328
#define XB_TOPGEN   3392
#define XCD_BAR_WORDS 3456
#define XB_SPIN_CAP (1u << 18)
__device__ __forceinline__ unsigned xb_ld(unsigned* p)              { return __hip_atomic_load(p, __ATOMIC_RELAXED, __HIP_MEMORY_SCOPE_AGENT); }
__device__ __forceinline__ unsigned xb_add(unsigned* p, unsigned v) { return __hip_atomic_fetch_add(p, v, __ATOMIC_RELAXED, __HIP_MEMORY_SCOPE_AGENT); }
__device__ __forceinline__ unsigned xb_xcc_id() { return (unsigned)__builtin_amdgcn_s_getreg((3 << 11) | 20) & 0xFu; }
#define XB_SPIN(cond, bar) do { unsigned _sp = 0; while (cond) { __builtin_amdgcn_s_sleep(1); \
    if ((++_sp & 255u) == 0u) { if (xb_ld(&(bar)[XB_TMO])) break; if (_sp > XB_SPIN_CAP) { atomicAdd(&(bar)[XB_TMO], 1u); break; } } } } while (0)
struct XcdBarrier { unsigned* bar; unsigned x; volatile LAS unsigned* st; };
__device__ __forceinline__ XcdBarrier xcd_barrier_post(unsigned* bar, volatile LAS unsigned* st) {
    XcdBarrier b; b.bar = bar; b.x = xb_xcc_id(); b.st = st;
    if (threadIdx.x == 0) (void)xb_add(&bar[XB_XCNT(b.x)], 1u);
    return b;
}
__device__ __forceinline__ void xcd_barrier_complete(unsigned* bar, unsigned x, unsigned& nloc, unsigned& nx) {
    const unsigned G = gridDim.x * gridDim.y * gridDim.z;
    unsigned sum, cnt, mine, sp = 0u;
    for (;;) {
        sum = 0u; cnt = 0u; mine = 0u;
#pragma unroll
        for (unsigned j = 0; j < 16; ++j) { const unsigned c = xb_ld(&bar[XB_XCNT(j)]); sum += c; cnt += (c > 0u) ? 1u : 0u; mine = (j == x) ? c : mine; }
        if (sum == G) break;
        __builtin_amdgcn_s_sleep(1);
        if ((++sp & 255u) == 0u) { if (xb_ld(&bar[XB_TMO])) break; if (sp > XB_SPIN_CAP) { atomicAdd(&bar[XB_TMO], 1u); break; } }
    }
    nloc = mine > 0u ? mine : 1u; nx = cnt > 0u ? cnt : 1u;
}
__device__ __forceinline__ void xcd_barrier(const XcdBarrier& b) {
    asm volatile("s_waitcnt vmcnt(0)" ::: "memory");
    __syncthreads();
    if (threadIdx.x == 0) {
        unsigned* bar = b.bar;
        __builtin_amdgcn_s_waitcnt(0);
        unsigned nloc = b.st[0], nx = b.st[1];
        if (nloc == 0u) { xcd_barrier_complete(bar, b.x, nloc, nx); b.st[0] = nloc; b.st[1] = nx; }
        const unsigned old = xb_add(&bar[XB_XSUB(b.x)], 1u);
        const unsigned gen = old / nloc;
        if (old + 1u == (gen + 1u) * nloc) {
            __builtin_amdgcn_fence(__ATOMIC_RELEASE, "agent");
            asm volatile("s_waitcnt vmcnt(0)" ::: "memory");
            const unsigned og = xb_add(&bar[XB_TOP], 1u);
            const unsigned tg = og / nx;
            if (og + 1u == (tg + 1u) * nx) xb_add(&bar[XB_TOPGEN], 1u);
            else XB_SPIN(xb_ld(&bar[XB_TOPGEN]) == tg, bar);
            __builtin_amdgcn_fence(__ATOMIC_ACQUIRE, "agent");
            xb_add(&bar[XB_XGEN(b.x)], 1u);
            asm volatile("s_waitcnt vmcnt(0)" ::: "memory");
        } else {
            XB_SPIN(xb_ld(&bar[XB_XGEN(b.x)]) == gen, bar);
            __builtin_amdgcn_fence(__ATOMIC_ACQUIRE, "agent");
            asm volatile("s_waitcnt vmcnt(0)" ::: "memory");
        }
    }
    __syncthreads();
}

__global__ void __launch_bounds__(NTHREADS) mega(Params p) {
    extern __shared__ __attribute__((aligned(16))) unsigned char smem[];
    LAS unsigned char* lds = (LAS unsigned char*)smem;
    cg::grid_group grid = cg::this_grid();
    const int tid = threadIdx.x, lane = tid & 63, wave = __builtin_amdgcn_readfirstlane(tid >> 6);
    const int G = gridDim.x, bx = blockIdx.x;
    const int gw = bx * NWAVES + wave, NGW = G * NWAVES;
    unsigned char* ws = p.ws;
    const float* x = p.in[0];
    bf16_t* PROJ = (bf16_t*)(ws + WS_PROJ); bf16_t* Hb = (bf16_t*)(ws + WS_H);
    unsigned* ctl = (unsigned*)(ws + WS_CTL);
    const int lo = p.ph_lo, hi = p.ph_hi;
#define IN(k) (lo <= (k) && (k) < hi)
#ifndef PROBE_MASK
#define PROBE_MASK 0
#endif
#define PH(k) if (IN(k)) for (int rep_ = 0; rep_ < (((PROBE_MASK >> (k)) & 1) ? 2 : 1); ++rep_)
    volatile LAS unsigned* xst = (volatile LAS unsigned*)(lds + 131072 + 14336);
    if (tid < 2) xst[tid] = 0u;
    __syncthreads();
    const XcdBarrier xbar = xcd_barrier_post(ctl + CW_BAR, xst);
#define SEAM(k) do { if (IN(k) && IN((k) + 1)) { if ((k) == 0) grid.sync(); else xcd_barrier(xbar); } } while (0)

    PH(0) {
        LAS float* scr = (LAS float*)(lds + wave * 16384);
        constexpr int I_IN = 16 * (DINP / 32), I_SQ = 16 * 32, I_XQ = 16 * 16, I_XKV = 16 * 32, I_XO = 8 * 32, I_GU = NE * 16 * 64, I_DN = NE * 16 * 32, I_W1 = 64 * 4, I_W2 = 2 * 4;
        constexpr int NITEMS = I_IN + 3 * I_SQ + I_XQ + I_XKV + I_XO + 2 * I_W1 + 2 * I_W2 + I_GU + I_DN;
        auto decode = [&](int it) -> TrItem {
            int r = it;
            if (r < I_IN) { const int nb = r % (DINP / 32), kb = r / (DINP / 32); return TrItem{p.in[3], (bf16_t*)(ws + WS_WIN_T), D, DIN, DIN, nb * 32, kb * 64, nb * 32}; } r -= I_IN;
            if (r < I_SQ) { const int nb = r % 32, kb = r / 32; return TrItem{p.in[14], (bf16_t*)(ws + WS_WA_T), D, D, D, nb * 32, kb * 64, nb * 32}; } r -= I_SQ;
            if (r < I_SQ) { const int nb = r % 32, kb = r / 32; return TrItem{p.in[15], (bf16_t*)(ws + WS_WB_T), D, D, D, nb * 32, kb * 64, nb * 32}; } r -= I_SQ;
            if (r < I_SQ) { const int nb = r % 32, kb = r / 32; return TrItem{p.in[16], (bf16_t*)(ws + WS_WMIX_T), D, D, D, nb * 32, kb * 64, nb * 32}; } r -= I_SQ;
            if (r < I_XQ) { const int nb = r % 16, kb = r / 16; return TrItem{p.in[19], (bf16_t*)(ws + WS_WXQ_T), D, XD, XD, nb * 32, kb * 64, nb * 32}; } r -= I_XQ;
            if (r < I_XKV) { const int nb = r % 32, kb = r / 32; return TrItem{p.in[20], (bf16_t*)(ws + WS_WXKV_T), D, 2 * XD, 2 * XD, nb * 32, kb * 64, nb * 32}; } r -= I_XKV;
            if (r < I_XO) { const int nb = r % 32, kb = r / 32; return TrItem{p.in[21], (bf16_t*)(ws + WS_WXO_T), XD, D, D, nb * 32, kb * 64, nb * 32}; } r -= I_XO;
            if (r < I_W1) { const int nb = r % 4, kb = r / 4; return TrItem{p.in[9], (bf16_t*)(ws + WS_W1T), 4096, 128, 128, nb * 32, kb * 64, nb * 32}; } r -= I_W1;
            if (r < I_W1) { const int nb = r % 4, kb = r / 4; return TrItem{p.in[12], (bf16_t*)(ws + WS_W1T) + 128 * 4096, 4096, 128, 128, nb * 32, kb * 64, nb * 32}; } r -= I_W1;
            if (r < I_W2) { const int nb = r % 4, kb = r / 4; return TrItem{p.in[10], (bf16_t*)(ws + WS_W2T), 128, 128, 128, nb * 32, kb * 64, nb * 32}; } r -= I_W2;
            if (r < I_W2) { const int nb = r % 4, kb = r / 4; return TrItem{p.in[13], (bf16_t*)(ws + WS_W2T) + 128 * 128, 128, 128, 128, nb * 32, kb * 64, nb * 32}; } r -= I_W2;
            if (r < I_GU) { const int e = r / (16 * 64), q = r % (16 * 64), nb = q % 64, kb = q / 64; const int c0 = nb * 32, bj = c0 / 1024, cc = c0 % 1024;
                return TrItem{p.in[25] + (size_t)e * D * 2048, (bf16_t*)(ws + WS_WGU_T) + (size_t)e * 2048 * D, D, 2048, 2048, (cc / 128) * 256 + bj * 128 + (cc % 128), kb * 64, c0}; } r -= I_GU;
            { const int e = r / (16 * 32), q = r % (16 * 32), nb = q % 32, kb = q / 32;
                return TrItem{p.in[27] + (size_t)e * D * D, (bf16_t*)(ws + WS_WDN_T) + (size_t)e * D * D, D, D, D, nb * 32, kb * 64, nb * 32}; }
        };
        if (gw < NITEMS) {
            float v[32]; TrItem cur = decode(gw); tr_load(cur, v, lane);
            for (int it = gw; it < NITEMS; it += NGW) {
                tr_lds_write(v, scr, lane);
                const bool has = it + NGW < NITEMS; TrItem nxt = cur;
                if (has) { nxt = decode(it + NGW); tr_load(nxt, v, lane); }
                asm volatile("" ::: "memory");
                tr_store(cur, scr, lane);
                cur = nxt;
            }
        }
        for (int m = gw; m < NT; m += 2 * NGW) { const int m2 = m + NGW; const bool hb = m2 < NT; const int mb = hb ? m2 : m;
            rms_rows2_to_bf16(x + (size_t)m * D, x + (size_t)mb * D, p.in[2], Hb + (size_t)m * D, Hb + (size_t)mb * D, hb, lane); }
        for (int m = gw; m < BATCH * MEM; m += NGW) rms_row_to_bf16(p.in[1] + (size_t)m * D, p.in[18], (bf16_t*)(ws + WS_MEMN) + (size_t)m * D, lane);
    }
    SEAM(0);

    PH(1) {
        { pg8::Gemm g{D, D, D}; pg8::DenseOrder S; S.init(NT, DINP, G, bx, Hb, D, ws + WS_WIN_T, D); EpiStoreBf16 E{PROJ, DINP}; pg8::gemm_phase(lds, g, S, E); }
        { pg8::Gemm g{D, D, D}; pg8::DenseOrder S; S.init(BATCH * MEM, 2 * XD, G, (bx + 8) % G, ws + WS_MEMN, D, ws + WS_WXKV_T, D); EpiStoreBf16 E{(bf16_t*)(ws + WS_KVM), 2 * XD}; pg8::gemm_phase(lds, g, S, E); }
    }
    SEAM(1);

    PH(2) {
        { LAS int* qslot = (LAS int*)(lds + 131072 + 12288);
            for (;;) {
                __syncthreads();
                if (tid == 0) *qslot = (int)atomicAdd(ctl + CW_QUEUE + 8 + rep_, 1u);
                __syncthreads();
                const int it = *qslot;
                if (it >= 128 + BATCH * 8 * 128) break;
                if (it < 128) cmp_item(p, ws, lds, it, tid, lane, wave); else gdn_chunk_item(p, ws, lds, it - 128, tid, lane, wave);
            }
        }
        __syncthreads();
        {
            bf16_t* QR = (bf16_t*)(ws + WS_QR); bf16_t* KSR = (bf16_t*)(ws + WS_KSR); bf16_t* KWR = (bf16_t*)(ws + WS_KWR);
            for (int tok = gw; tok < NT; tok += NGW) {
                const int t = tok & (T - 1);
                const int dd = 2 * lane; float c0 = 1.f, s0 = 0.f, c1 = 1.f, s1 = 0.f;
                if (lane < 16) { const int i0 = dd & 15, i1 = i0 + 1;
                    const double f0 = exp2(-18.931568569324174 * (double)i0 / 16.0), f1 = exp2(-18.931568569324174 * (double)i1 / 16.0);
                    double r0 = (double)t * f0 * 0.15915494309189535, r1 = (double)t * f1 * 0.15915494309189535; r0 -= floor(r0); r1 -= floor(r1);
                    const float a0 = (float)(r0 * 6.283185307179586), a1 = (float)(r1 * 6.283185307179586);
                    c0 = __cosf(a0); s0 = __sinf(a0); c1 = __cosf(a1); s1 = __sinf(a1); }
                unsigned vin[12];
#pragma unroll
                for (int hh = 0; hh < 12; ++hh) vin[hh] = *(const unsigned*)(PROJ + (size_t)tok * DINP + (hh < 8 ? C_NQ + hh * 128 : (hh < 10 ? C_NKS + (hh - 8) * 128 : C_NKW + (hh - 10) * 128)) + dd);
                asm volatile("" ::: "memory");
#pragma unroll
                for (int hh = 0; hh < 12; ++hh) {
                    bf16_t* dst = hh < 8 ? QR + (size_t)tok * D + hh * 128 + dd : ((hh < 10 ? KSR : KWR) + ((size_t)(((tok >> 13) * 2 + (hh & 1)) * 128 + (t >> 6)) << 13) + kimg_off(t & 63, dd));
                    const unsigned v = vin[hh]; float v0 = bflo(v), v1 = bfhi(v);
                    const float p0 = __shfl_xor(v0, 8), p1 = __shfl_xor(v1, 8);
                    if (lane < 8) { v0 = v0 * c0 - p0 * s0; v1 = v1 * c1 - p1 * s1; } else if (lane < 16) { v0 = v0 * c0 + p0 * s0; v1 = v1 * c1 + p1 * s1; }
                    *(unsigned*)dst = pk2(v0, v1);
                }
            }
        }
        {
            LAS bf16_t* tt = (LAS bf16_t*)lds;
            for (int it = bx; it < 2 * BATCH * 2 * 128; it += G) {
                const int which = it >> 9, b = (it >> 8) & 1, g = (it >> 7) & 1, blk = it & 127;
                __syncthreads();
                { const int tk = tid >> 3, c = tid & 7; const bf16_t* src = PROJ + (size_t)(b * T + blk * 64 + tk) * DINP + (which ? C_NVW : C_NVS) + g * 128 + c * 16;
                    const u32x4 x0 = *(const u32x4*)src, x1 = *(const u32x4*)(src + 8); const int pos = (tk & ~15) + vperm16(tk & 15);
                    const unsigned xs[8] = {x0.x, x0.y, x0.z, x0.w, x1.x, x1.y, x1.z, x1.w};
#pragma unroll
                    for (int e = 0; e < 8; ++e) { tt[(c * 16 + 2 * e) * 72 + pos] = (bf16_t)(xs[e] & 0xffffu); tt[(c * 16 + 2 * e + 1) * 72 + pos] = (bf16_t)(xs[e] >> 16); } }
                __syncthreads();
                { const int dv = tid >> 2, pc = tid & 3; const LAS u32x4* sp = (const LAS u32x4*)(tt + dv * 72 + pc * 16);
                    bf16_t* dst = (bf16_t*)(ws + (which ? WS_VWT : WS_VST)) + ((size_t)((b * 2 + g) * 128 + blk) << 13);
                    *(u32x4*)(dst + vimg_off(dv, pc * 16)) = sp[0]; *(u32x4*)(dst + vimg_off(dv, pc * 16 + 8)) = sp[1]; }
            }
            __syncthreads();
        }
        {
            LAS bf16_t* tt = (LAS bf16_t*)lds;
            for (int it = bx; it < BATCH * 4 * 4; it += G) {
                const int b = it >> 4, h = (it >> 2) & 3, blk = it & 3;
                __syncthreads();
                { const int tk = tid >> 3, c = tid & 7; const bf16_t* src = (const bf16_t*)(ws + WS_KVM) + (size_t)(b * MEM + blk * 64 + tk) * 1024 + 512 + h * 128 + c * 16;
                    const u32x4 x0 = *(const u32x4*)src, x1 = *(const u32x4*)(src + 8); const int pos = (tk & ~15) + vperm16(tk & 15);
                    const unsigned xs[8] = {x0.x, x0.y, x0.z, x0.w, x1.x, x1.y, x1.z, x1.w};
#pragma unroll
                    for (int e = 0; e < 8; ++e) { tt[(c * 16 + 2 * e) * 72 + pos] = (bf16_t)(xs[e] & 0xffffu); tt[(c * 16 + 2 * e + 1) * 72 + pos] = (bf16_t)(xs[e] >> 16); } }
                __syncthreads();
                { const int dv = tid >> 2, pc = tid & 3; const LAS u32x4* sp = (const LAS u32x4*)(tt + dv * 72 + pc * 16);
                    bf16_t* dst = (bf16_t*)(ws + WS_XVT) + ((size_t)((b * 4 + h) * 4 + blk) << 13);
                    *(u32x4*)(dst + vimg_off(dv, pc * 16)) = sp[0]; *(u32x4*)(dst + vimg_off(dv, pc * 16 + 8)) = sp[1]; }
                { const int tk = tid >> 3, c = tid & 7; const bf16_t* src = (const bf16_t*)(ws + WS_KVM) + (size_t)(b * MEM + blk * 64 + tk) * 1024 + h * 128 + c * 16;
                    bf16_t* dst = (bf16_t*)(ws + WS_XVT + 524288) + ((size_t)((b * 4 + h) * 4 + blk) << 13);
                    *(u32x4*)(dst + kimg_off(tk, c * 16)) = *(const u32x4*)src; *(u32x4*)(dst + kimg_off(tk, c * 16 + 8)) = *(const u32x4*)(src + 8); }
            }
            __syncthreads();
        }
    }
    SEAM(2);

    if (IN(3)) {
        if (bx < 32) { gdn_scan(ws, lds, bx, tid, lane, wave);
            if (tid == 0) { __builtin_amdgcn_fence(__ATOMIC_RELEASE, "agent"); asm volatile("s_waitcnt vmcnt(0)" ::: "memory"); __hip_atomic_fetch_add(ctl + CW_SCANDONE, 1u, __ATOMIC_RELAXED, __HIP_MEMORY_SCOPE_AGENT); } }
        {
            LAS int* qslot = (LAS int*)(lds + 131072 + 12288);
            for (;;) {
                __syncthreads();
                if (tid == 0) *qslot = (int)atomicAdd(ctl + CW_QUEUE, 1u);
                __syncthreads();
                const int it = *qslot;
                if (it >= 512) break;
                nsa_item(p, ws, lds, it, tid, lane, wave);
            }
        }
        {
            LAS int* qslot = (LAS int*)(lds + 131072 + 12288);
            if (tid == 0) { unsigned sp = 0; while (__hip_atomic_load(ctl + CW_SCANDONE, __ATOMIC_RELAXED, __HIP_MEMORY_SCOPE_AGENT) < 32u) { __builtin_amdgcn_s_sleep(2); if (++sp > (1u << 22)) break; }
                __builtin_amdgcn_fence(__ATOMIC_ACQUIRE, "agent"); asm volatile("s_waitcnt vmcnt(0)" ::: "memory"); }
            __syncthreads();
            const float* GO = (const float*)(ws + WS_GO); bf16_t* OA = (bf16_t*)(ws + WS_OA);
            for (;;) {
                __syncthreads();
                if (tid == 0) *qslot = (int)atomicAdd(ctl + CW_P4Q, 1u);
                __syncthreads();
                const int it0 = *qslot; if (it0 >= NT / 64) break;
                const float gn0 = p.in[7][2 * lane], gn1 = p.in[7][2 * lane + 1];
#pragma unroll 1
                for (int q0 = wave * 8; q0 < 512; q0 += NWAVES * 8) {
                    float v0[8], v1[8]; unsigned z[8];
#pragma unroll
                    for (int i = 0; i < 8; ++i) { const int q = q0 + i, tok = it0 * 64 + (q >> 3), h = q & 7; const size_t o = (size_t)tok * D + h * 128 + 2 * lane;
                        const f32x2v g2 = *(const f32x2v*)(GO + o); v0[i] = g2.x; v1[i] = g2.y; z[i] = *(const unsigned*)(PROJ + (size_t)tok * DINP + C_GZ + h * 128 + 2 * lane); }
                    asm volatile("" ::: "memory");
#pragma unroll
                    for (int i = 0; i < 8; ++i) { const int q = q0 + i, tok = it0 * 64 + (q >> 3), h = q & 7; const size_t o = (size_t)tok * D + h * 128 + 2 * lane;
                        const float r = __builtin_amdgcn_rsqf(wave_sum(v0[i] * v0[i] + v1[i] * v1[i]) * (1.f / 128.f) + 1e-6f);
                        *(unsigned*)(OA + o) = pk2(v0[i] * r * gn0 * siluf_(bflo(z[i])), v1[i] * r * gn1 * siluf_(bfhi(z[i]))); }
                }
            }
        }
    }
    SEAM(3);


    PH(5) {
        bf16_t* MIXED = (bf16_t*)(ws + WS_MIXED);
        { pg8::Gemm g{D, D, D}; pg8::DenseOrder S; S.init(NT, D, G, bx, ws + WS_OA, D, ws + WS_WA_T, D); EpiGate E{MIXED, PROJ, C_MA, 0}; pg8::gemm_phase(lds, g, S, E); }
        { pg8::Gemm g{D, D, D}; pg8::DenseOrder S; S.init(NT, D, G, bx, ws + WS_OB, D, ws + WS_WB_T, D); EpiGate E{MIXED, PROJ, C_MB, 1}; pg8::gemm_phase(lds, g, S, E); }
    }
    SEAM(5);

    PH(6) { pg8::Gemm g{D, D, D}; pg8::DenseOrder S; S.init(NT, D, G, bx, ws + WS_MIXED, D, ws + WS_WMIX_T, D);
        EpiResidualNorm E{(float*)(ws + WS_X1), x, Hb, p.in[17], (float*)(ctl + CW_SS1)}; pg8::gemm_phase(lds, g, S, E); }
    SEAM(6);
    PH(8) { pg8::Gemm g{D, D, D}; pg8::DenseOrder S; S.init(NT, XD, G, bx, Hb, D, ws + WS_WXQ_T, D); EpiScaleRowsBf16 E{(bf16_t*)(ws + WS_QX), XD, (const float*)(ctl + CW_SS1)}; pg8::gemm_phase(lds, g, S, E); }
    SEAM(8);
    PH(9) { for (int it = bx; it < BATCH * 4 * 32; it += G) xattn_item(ws, lds, it, tid, lane, wave); __syncthreads(); }
    SEAM(9);
    if (IN(10)) { pg8::Gemm g{XD, XD, XD}; pg8::DenseOrder S; S.init(NT, D, G, bx, ws + WS_OX, XD, ws + WS_WXO_T, XD); EpiResidual E{(float*)(ws + WS_X1), (const float*)(ws + WS_X1)}; pg8::gemm_phase(lds, g, S, E); }
    SEAM(10);
    PH(11) {
        LAS float* xl = (LAS float*)lds + wave * 4096;
        LAS int* lcnt = (LAS int*)(lds + 131072 + 8192);
        if (tid < 32) lcnt[tid] = 0;
        __syncthreads();
        const float* X2 = (const float*)(ws + WS_X1); int* TOPE = (int*)(ws + WS_TOPE); float* TOPG = (float*)(ws + WS_TOPG);
        const float* rwg = p.in[23];
        for (int base = gw; base < NT; base += 4 * NGW) {
#pragma unroll 1
            for (int q = 0; q < 4; ++q) { const int tok = base + q * NGW; if (tok >= NT) break;
                const f32x4* xr = (const f32x4*)(X2 + (size_t)tok * D) + lane; const f32x4* gr = (const f32x4*)p.in[22] + lane;
                f32x4 v[4]; float s = 0.f;
#pragma unroll
                for (int j = 0; j < 4; ++j) { v[j] = xr[64 * j]; s += (v[j].x * v[j].x + v[j].y * v[j].y) + (v[j].z * v[j].z + v[j].w * v[j].w); }
                const float rstd = __builtin_amdgcn_rsqf(wave_sum(s) * (1.f / D) + 1e-6f);
                u32x2* o8 = (u32x2*)(Hb + (size_t)tok * D) + lane;
#pragma unroll
                for (int j = 0; j < 4; ++j) { const f32x4 gg = gr[64 * j]; const f32x4 hv = {v[j].x * rstd * gg.x, v[j].y * rstd * gg.y, v[j].z * rstd * gg.z, v[j].w * rstd * gg.w};
                    u32x2 w; w.x = pk2(hv.x, hv.y); w.y = pk2(hv.z, hv.w); o8[64 * j] = w; *(LAS f32x4*)(xl + q * 1024 + 4 * lane + 256 * j) = hv; }
            }
            LDS_FENCE();
            const int e = lane & 31, kh = (lane >> 5) * 512; float acc[4] = {0.f, 0.f, 0.f, 0.f};
#pragma unroll 16
            for (int k = 0; k < 512; ++k) { const float w = rwg[(kh + k) * 32 + e];
#pragma unroll
                for (int q = 0; q < 4; ++q) acc[q] += xl[q * 1024 + kh + k] * w; }
            LDS_FENCE();
#pragma unroll
            for (int q = 0; q < 4; ++q) { const int tok = base + q * NGW; if (tok < NT) {
                float logit = acc[q] + __shfl_xor(acc[q], 32) + p.in[24][e];
                float tv[4]; int ti[4];
#pragma unroll
                for (int r = 0; r < 4; ++r) { float bv = logit; int bi = e;
#pragma unroll
                    for (int o = 1; o < 32; o <<= 1) { const float ov = __shfl_xor(bv, o); const int oi = __shfl_xor(bi, o); if (ov > bv || (ov == bv && oi < bi)) { bv = ov; bi = oi; } }
                    tv[r] = bv; ti[r] = bi; if (e == bi) logit = -3e38f; }
                const float e1 = __expf(tv[1] - tv[0]), e2 = __expf(tv[2] - tv[0]), e3 = __expf(tv[3] - tv[0]), inv = 1.f / (1.f + e1 + e2 + e3);
                if (lane == 0) { int* te = TOPE + tok * 4; float* tg = TOPG + tok * 4; te[0] = ti[0]; te[1] = ti[1]; te[2] = ti[2]; te[3] = ti[3]; tg[0] = inv; tg[1] = e1 * inv; tg[2] = e2 * inv; tg[3] = e3 * inv;
#pragma unroll
                    for (int r = 0; r < 4; ++r) __hip_atomic_fetch_add(lcnt + ti[r], 1, __ATOMIC_RELAXED, __HIP_MEMORY_SCOPE_WORKGROUP); }
            } }
        }
        __syncthreads();
        if (tid < 32) ctl[CW_BLKCNT + bx * 32 + tid] = (unsigned)lcnt[tid];
        __syncthreads();
    }
    SEAM(11);
    LAS int* moe_cum = (LAS int*)(lds + 131072);
    LAS int* moe_before = moe_cum + 64;
    if (IN(12) || IN(13) || IN(14)) {
        LAS int* tmp = moe_cum + 128;
        __syncthreads();
        { const int e = tid & 31, part = tid >> 5; int tot = 0, bef = 0;
            for (int bb = part; bb < G; bb += 16) { const int c = (int)ctl[CW_BLKCNT + bb * 32 + e]; tot += c; if (bb < bx) bef += c; }
            tmp[part * 32 + e] = tot; tmp[512 + part * 32 + e] = bef; }
        __syncthreads();
        if (tid == 0) { int cumb = 0, prow = 0; moe_cum[0] = 0;
            for (int e = 0; e < NE; ++e) { int tot = 0, bef = 0; for (int q = 0; q < 16; ++q) { tot += tmp[q * 32 + e]; bef += tmp[512 + q * 32 + e]; }
                moe_before[e] = prow + bef; const int pb = (tot + MOEB - 1) / MOEB; cumb += pb; prow += pb * MOEB; moe_cum[e + 1] = cumb; } }
        __syncthreads();
    }
    PH(12) {
        LAS int* lcnt = moe_cum + 1200;
        if (tid < 32) lcnt[tid] = 0;
        __syncthreads();
        const int* TOPE = (const int*)(ws + WS_TOPE); const float* TOPG = (const float*)(ws + WS_TOPG); int* POS = (int*)(ws + WS_POS); float* RG = (float*)(ws + WS_ROWGATE);
        int* RT = (int*)(ws + WS_ROWTOK);
        {
            const int tok = gw + (lane >> 2) * NGW;
            if (tok < NT) { const int e = TOPE[tok * 4 + (lane & 3)]; const float gte = TOPG[tok * 4 + (lane & 3)];
                const int slot = moe_before[e] + __hip_atomic_fetch_add(lcnt + e, 1, __ATOMIC_RELAXED, __HIP_MEMORY_SCOPE_WORKGROUP);
                POS[tok * 4 + (lane & 3)] = slot; RG[slot] = gte; RT[slot] = tok; }
            for (int tk = gw + 16 * NGW; tk < NT; tk += NGW) { if (lane < 4) { const int e = TOPE[tk * 4 + lane]; const int slot = moe_before[e] + __hip_atomic_fetch_add(lcnt + e, 1, __ATOMIC_RELAXED, __HIP_MEMORY_SCOPE_WORKGROUP);
                POS[tk * 4 + lane] = slot; RG[slot] = TOPG[tk * 4 + lane]; RT[slot] = tk; } }
        }
    }
    SEAM(12);
    PH(13) { pg8::Gemm g{D, D, D}; MoeOrder S{G, bx, 8, moe_cum, (const char*)Hb, (const char*)(ws + WS_WGU_T), (size_t)2048 * D * 2, (const int*)(ws + WS_ROWTOK)};
        EpiSwiglu E{(bf16_t*)(ws + WS_ACT), p.in[26]}; pg8::gemm_phase<EpiSwiglu, MoeOrder, true>(lds, g, S, E); }
    SEAM(13);
    PH(14) { pg8::Gemm g{D, D, D}; MoeOrder S{G, bx, 4, moe_cum, (const char*)(ws + WS_ACT), (const char*)(ws + WS_WDN_T), (size_t)D * D * 2, nullptr};
        EpiDown E{(bf16_t*)(ws + WS_Y), p.in[28], (const float*)(ws + WS_ROWGATE)}; pg8::gemm_phase(lds, g, S, E); }
    SEAM(14);
    PH(15) {
        const float* X2 = (const float*)(ws + WS_X1); const int* POS = (const int*)(ws + WS_POS); const bf16_t* Y = (const bf16_t*)(ws + WS_Y);
        for (int tok = gw; tok < NT; tok += NGW) {
            const f32x4* xr = (const f32x4*)(X2 + (size_t)tok * D) + lane; f32x4 v[4];
#pragma unroll
            for (int j = 0; j < 4; ++j) v[j] = xr[64 * j];
#pragma unroll
            for (int k = 0; k < 4; ++k) { const u32x2* yr = (const u32x2*)(Y + (size_t)POS[tok * 4 + k] * D) + lane;
#pragma unroll
                for (int j = 0; j < 4; ++j) { const u32x2 w = yr[64 * j]; v[j].x += bflo(w.x); v[j].y += bfhi(w.x); v[j].z += bflo(w.y); v[j].w += bfhi(w.y); } }
            float s = 0.f;
#pragma unroll
            for (int j = 0; j < 4; ++j) s += (v[j].x * v[j].x + v[j].y * v[j].y) + (v[j].z * v[j].z + v[j].w * v[j].w);
            const float rstd = __builtin_amdgcn_rsqf(wave_sum(s) * (1.f / D) + 1e-6f);
            f32x4* orow = (f32x4*)(p.out + (size_t)tok * D) + lane; const f32x4* gr = (const f32x4*)p.in[29] + lane;
#pragma unroll
            for (int j = 0; j < 4; ++j) { const f32x4 gg = gr[64 * j]; orow[64 * j] = (f32x4){v[j].x * rstd * gg.x, v[j].y * rstd * gg.y, v[j].z * rstd * gg.z, v[j].w * rstd * gg.w}; }
        }
    }
}

constexpr int NPHASES = 16;
extern "C" void kernel_launch(void* const* d_in, const int* in_sizes, int n_in, void* d_out, int out_size, void* d_ws, size_t ws_size, hipStream_t stream) {
    static int grid = 0;
    if (grid == 0) {
        int dev = 0, cus = 0, per_cu = 0;
        (void)hipGetDevice(&dev); (void)hipDeviceGetAttribute(&cus, hipDeviceAttributeMultiprocessorCount, dev);
        (void)hipFuncSetAttribute((const void*)mega, hipFuncAttributeMaxDynamicSharedMemorySize, LDS_BYTES);
        (void)hipOccupancyMaxActiveBlocksPerMultiprocessor(&per_cu, (const void*)mega, NTHREADS, LDS_BYTES);
        if (per_cu < 1) { fprintf(stderr, "occupancy query says %d blocks/CU\n", per_cu); per_cu = 1; }
        grid = cus * 1;
        if (ws_size < WS_END) fprintf(stderr, "workspace too small: %zu < %zu\n", ws_size, (size_t)WS_END);
    }
    (void)hipMemsetAsync((char*)d_ws + WS_CTL, 0, CTL_ZERO, stream);
    (void)hipMemsetAsync((char*)d_ws + WS_ROWTOK, 0, (size_t)NROWS * 4, stream);
    Params p{};
    for (int i = 0; i < 30; ++i) p.in[i] = (const float*)d_in[i];
    p.out = (float*)d_out; p.ws = (unsigned char*)d_ws;
#if SINGLE_LAUNCH
    p.ph_lo = 0; p.ph_hi = NPHASES;
    void* args[] = {&p};
    hipError_t e = hipLaunchCooperativeKernel((const void*)mega, dim3(grid), dim3(NTHREADS), args, LDS_BYTES, stream);
    if (e != hipSuccess) fprintf(stderr, "cooperative launch failed: %s (grid %d)\n", hipGetErrorString(e), grid);
#else
    for (int ph = 0; ph < NPHASES; ++ph) { p.ph_lo = ph; p.ph_hi = ph + 1; hipLaunchKernelGGL(mega, dim3(grid), dim3(NTHREADS), LDS_BYTES, stream, p); }
#endif
}
```

```cpp
#include <hip/hip_runtime.h>
#include <hip/hip_cooperative_groups.h>
#include <cstdio>
#include <cstdint>
namespace cg = cooperative_groups;

#ifndef SINGLE_LAUNCH
#define SINGLE_LAUNCH 1
#endif

#define LAS __attribute__((address_space(3)))
typedef unsigned short bf16_t;
typedef short bf16x8 __attribute__((ext_vector_type(8)));
typedef float f32x4 __attribute__((ext_vector_type(4)));
typedef unsigned u32x4 __attribute__((ext_vector_type(4)));
typedef int i32x4 __attribute__((ext_vector_type(4)));
typedef unsigned u32x2 __attribute__((ext_vector_type(2)));

constexpr int BATCH = 2, T = 8192, NT = BATCH * T, D = 1024;
constexpr int DIN = 8744, DINP = 8960;
constexpr int C_GQ = 0, C_GK = 1024, C_GV = 2048, C_GZ = 3072, C_GB = 4096, C_GA = 4104, C_NQ = 4112, C_NKC = 5136, C_NVC = 5392,
              C_NKS = 5648, C_NVS = 5904, C_NKW = 6160, C_NVW = 6416, C_NG = 6672, C_MA = 6696, C_MB = 7720;
constexpr int NCMP = 511, NCMPP = 512, NSEL = 128, TOPN = 16, WIN = 512;
constexpr int MEM = 256, XD = 512;
constexpr int NE = 32, TOPK = 4, MOEB = 256, NROWS = NT * TOPK + NE * MOEB;
constexpr int NTHREADS = 512, NWAVES = 8;
constexpr int LDS_BYTES = 147456;

constexpr size_t MiB = 1u << 20;
constexpr size_t WS_CTL = 0, CTL_BYTES = 1 * MiB;
constexpr size_t WS_WIN_T = 1 * MiB, WS_WA_T = 19 * MiB, WS_WB_T = 21 * MiB, WS_WMIX_T = 23 * MiB, WS_WXQ_T = 25 * MiB, WS_WXKV_T = 26 * MiB,
                 WS_WXO_T = 28 * MiB, WS_WGU_T = 30 * MiB, WS_WDN_T = 158 * MiB;
constexpr size_t WS_H = 222 * MiB;
constexpr size_t WS_MEMN = 254 * MiB, WS_KVM = 255 * MiB;
constexpr size_t WS_PROJ = 256 * MiB;
constexpr size_t WS_CHK = 536 * MiB;
constexpr size_t WS_U = 648 * MiB;
constexpr size_t WS_GO = 712 * MiB;
constexpr size_t WS_XS = 256 * MiB, WS_ACT = 400 * MiB, WS_Y = 544 * MiB;
constexpr size_t WS_OA = 776 * MiB, WS_OB = 808 * MiB, WS_QR = 840 * MiB, WS_MIXED = 840 * MiB;
constexpr size_t WS_KSR = 872 * MiB, WS_KWR = 880 * MiB, WS_KC = 888 * MiB, WS_VC = 890 * MiB;
constexpr size_t WS_X1 = 892 * MiB;
constexpr size_t WS_QX = 956 * MiB, WS_OX = 972 * MiB;
constexpr size_t WS_GL = 988 * MiB;
constexpr size_t WS_TOPE = 989 * MiB, WS_TOPG = WS_TOPE + 256 * 1024, WS_POS = WS_TOPG + 256 * 1024, WS_ROWGATE = WS_POS + 256 * 1024;
constexpr size_t WS_ROWTOK = WS_ROWGATE + 512 * 1024;
constexpr size_t WS_VST = 991 * MiB, WS_VWT = 999 * MiB;
constexpr size_t WS_W1T = 1007 * MiB;
constexpr size_t WS_W2T = 1009 * MiB;
constexpr size_t WS_XVT = 1010 * MiB;
constexpr size_t WS_END = 1011 * MiB;
constexpr int CH_NEGW = 0, CH_QD = 16384, CH_KDT = 32768, CH_QK = 49152, CH_BYTES = 57344;
constexpr int CW_QUEUE = 0;
constexpr int CW_SCANDONE = 64;
constexpr int CW_P4Q = 65;
constexpr int CW_BLKCNT = 1024;
constexpr int CW_BAR = 16384;
constexpr int CW_SS1 = 32768;
constexpr int CW_SS2 = 49152;
constexpr size_t CTL_ZERO = 131072 + 65536 + 65536;

struct Params {
    const float* in[30];
    float* out;
    unsigned char* ws;
    int ph_lo, ph_hi;
};

__device__ __forceinline__ unsigned f2bf(float f) { unsigned u = __builtin_bit_cast(unsigned, f); return (u + 0x7fffu + ((u >> 16) & 1u)) >> 16; }
typedef float f32x2_t __attribute__((ext_vector_type(2)));
typedef __bf16 bf16x2_t __attribute__((ext_vector_type(2)));
__device__ __forceinline__ unsigned pk2(float lo, float hi) { f32x2_t v = {lo, hi}; bf16x2_t b = __builtin_convertvector(v, bf16x2_t); return __builtin_bit_cast(unsigned, b); }
__device__ __forceinline__ float bf2f(unsigned short v) { return __builtin_bit_cast(float, (unsigned)v << 16); }
__device__ __forceinline__ float bflo(unsigned v) { return __builtin_bit_cast(float, v << 16); }
__device__ __forceinline__ float bfhi(unsigned v) { return __builtin_bit_cast(float, v & 0xffff0000u); }
__device__ __forceinline__ float wave_sum(float v) {
#pragma unroll
    for (int o = 1; o < 64; o <<= 1) v += __shfl_xor(v, o);
    return v;
}
__device__ __forceinline__ float wave_max(float v) {
#pragma unroll
    for (int o = 1; o < 64; o <<= 1) v = fmaxf(v, __shfl_xor(v, o));
    return v;
}
__device__ __forceinline__ float sigmoidf_(float x) { return __builtin_amdgcn_rcpf(1.f + __builtin_amdgcn_exp2f(x * -1.4426950408889634f)); }
__device__ __forceinline__ float siluf_(float x) { return x * __builtin_amdgcn_rcpf(1.f + __builtin_amdgcn_exp2f(x * -1.4426950408889634f)); }
#define LDS_FENCE() asm volatile("s_waitcnt lgkmcnt(0)" ::: "memory")

namespace pg8 {
constexpr int BM = 256, BK = 64, HALF = 128, HTB = HALF * BK * 2, NXCD = 8, WGM = 8;
__device__ __forceinline__ int lds_byte(int r, int c) { const int st = (r >> 4) * 2 + (c >> 5), rr = r & 15, cc = c & 31, ob = rr * 64 + cc * 2; return st * 1024 + (ob ^ (((ob >> 9) & 1) << 5)); }
__device__ __forceinline__ void stage_rc(int b, int& R, int& C) { const int st = b / 1024, sb = b % 1024, swz = sb ^ (((sb >> 9) & 1) << 5); R = (st >> 1) * 16 + swz / 64; C = (st & 1) * 32 + (swz % 64) / 2; }
__device__ __forceinline__ int perm32(int rho) { const int n = rho >> 4, i = rho & 15; return 8 * (i >> 2) + 4 * n + (i & 3); }

struct Unit { int pm, pn, aux; const char* a; const char* b; const int* rows; };
struct Gemm { int lda, ldb, K; };

template <class Epi, class Sched, bool GATHER = false>
__device__ __forceinline__ void gemm_phase(LAS unsigned char* lds, const Gemm g, const Sched& S, const Epi& E) {
    int tid_o = threadIdx.x; asm volatile("" : "+v"(tid_o));
    const int tid = tid_o, wid = __builtin_amdgcn_readfirstlane(tid >> 6), lane = tid & 63, wr = wid >> 2, wc = wid & 3, fr = lane & 15, fq = lane >> 4;
    const int K = g.K, nt = K / BK;
    unsigned voffA[2], voffB[2];
#pragma unroll
    for (int i = 0; i < 2; ++i) { int R, C; stage_rc(tid * 16 + i * 8192, R, C); const int Rb = (R & ~31) + perm32(R & 31);
        voffA[i] = (unsigned)(R * g.lda + C) * 2u; voffB[i] = (unsigned)(Rb * g.ldb + C) * 2u; }
    int gR[2], gC[2];
#pragma unroll
    for (int i = 0; i < 2; ++i) stage_rc(tid * 16 + i * 8192, gR[i], gC[i]);
    unsigned goff[2][2], gnoff[2][2];
    auto load_goff = [&](const Unit& u, unsigned (&o)[2][2]) {
#pragma unroll
        for (int h = 0; h < 2; ++h)
#pragma unroll
            for (int i = 0; i < 2; ++i) o[h][i] = ((unsigned)u.rows[h * HALF + gR[i]] * (unsigned)g.lda + (unsigned)gC[i]) * 2u; };
    const size_t kstep = (size_t)(BK * 2);
    const size_t hstepA = (size_t)HALF * g.lda * 2, hstepB = (size_t)HALF * g.ldb * 2;
    const unsigned ldsw = (unsigned)wid * 1024u;
    const int aoff = lds_byte(wr * 64 + fr, fq * 8), boff = lds_byte(wc * 32 + fr, fq * 8);
#define PG8_SA(b, h) (((b) * 2 + (h)) * HTB)
#define PG8_SB(b, h) ((4 + (b) * 2 + (h)) * HTB)
#define PG8_STAGE(bufoff, gbase, voff) do { _Pragma("unroll") for (int _i = 0; _i < 2; ++_i) \
        __builtin_amdgcn_global_load_lds((const unsigned*)((const char*)(gbase) + (voff)[_i]), (LAS unsigned*)(lds + (bufoff) + ldsw + _i * 8192), 16, 0, 0); } while (0)
#define PG8_STAGEG(bufoff, gbase, o0, o1) do { \
        __builtin_amdgcn_global_load_lds((const unsigned*)((const char*)(gbase) + (o0)), (LAS unsigned*)(lds + (bufoff) + ldsw), 16, 0, 0); \
        __builtin_amdgcn_global_load_lds((const unsigned*)((const char*)(gbase) + (o1)), (LAS unsigned*)(lds + (bufoff) + ldsw + 8192), 16, 0, 0); } while (0)
#define PG8_STAGEA(bufoff, ptr, h, nx) do { if constexpr (GATHER) { PG8_STAGEG(bufoff, ptr, (nx) ? gnoff[h][0] : goff[h][0], (nx) ? gnoff[h][1] : goff[h][1]); } else { PG8_STAGE(bufoff, (ptr) + (h) * hstepA, voffA); } } while (0)
#define PG8_LDA(dst, b, h) do { _Pragma("unroll") for (int m = 0; m < 4; ++m) _Pragma("unroll") for (int k = 0; k < 2; ++k) dst[m][k] = *(const LAS bf16x8*)(lds + PG8_SA(b, h) + aoff + m * 2048 + k * 1024); } while (0)
#define PG8_LDB(dst, b, h) do { _Pragma("unroll") for (int n = 0; n < 2; ++n) _Pragma("unroll") for (int k = 0; k < 2; ++k) dst[n][k] = *(const LAS bf16x8*)(lds + PG8_SB(b, h) + boff + n * 2048 + k * 1024); } while (0)
#define PG8_MMA(ai, bj, At, Bt) do { __builtin_amdgcn_s_setprio(1); _Pragma("unroll") for (int m = 0; m < 4; ++m) _Pragma("unroll") for (int n = 0; n < 2; ++n) _Pragma("unroll") for (int k = 0; k < 2; ++k) \
        acc[ai][bj][m][n] = __builtin_amdgcn_mfma_f32_16x16x32_bf16(Bt[n][k], At[m][k], acc[ai][bj][m][n], 0, 0, 0); __builtin_amdgcn_s_setprio(0); } while (0)
#define PG8_WAIT_V(n) asm volatile("s_waitcnt vmcnt(" #n ")" ::: "memory")
#define PG8_WAIT_L(n) asm volatile("s_waitcnt lgkmcnt(" #n ")" ::: "memory")
#define PG8_BAR __builtin_amdgcn_s_barrier()
#define PG8_SCHED __builtin_amdgcn_sched_barrier(0)
    Unit cur, nxt; int ui = 0;
    if (!S.next(0, cur)) return;
    f32x4 acc[2][2][4][2];
#pragma unroll
    for (int a = 0; a < 2; ++a)
#pragma unroll
        for (int b = 0; b < 2; ++b)
#pragma unroll
            for (int m = 0; m < 4; ++m)
#pragma unroll
                for (int n = 0; n < 2; ++n) acc[a][b][m][n] = (f32x4){0.f, 0.f, 0.f, 0.f};
    bf16x8 At[4][2], B0[2][2], B1[2][2];
    const char* cA = cur.a; const char* cB = cur.b;
    if constexpr (GATHER) load_goff(cur, goff);
    PG8_STAGE(PG8_SB(0, 0), cB, voffB); PG8_STAGE(PG8_SB(0, 1), cB + hstepB, voffB); PG8_STAGEA(PG8_SA(0, 0), cA, 0, false); PG8_STAGEA(PG8_SA(0, 1), cA, 1, false);
    if (wr == 1) PG8_BAR;
    PG8_WAIT_V(2); PG8_BAR;
    PG8_STAGE(PG8_SB(1, 0), cB + kstep, voffB); PG8_STAGEA(PG8_SA(1, 0), cA + kstep, 0, false); PG8_STAGE(PG8_SB(1, 1), cB + hstepB + kstep, voffB);
    PG8_WAIT_V(6); PG8_BAR;
    for (;;) {
        const bool has_next = S.next(ui + 1, nxt);
        const char* nA = has_next ? nxt.a : cA; const char* nB = has_next ? nxt.b : cB;
        if constexpr (GATHER) { if (has_next) load_goff(nxt, gnoff); else { _Pragma("unroll") for (int h = 0; h < 2; ++h) { gnoff[h][0] = goff[h][0]; gnoff[h][1] = goff[h][1]; } } }
        for (int t = 0; t < nt; t += 2) {
            const bool last = (t == nt - 2);
            const char* a1 = cA + (size_t)(t + 1) * kstep;
            const char* a2 = last ? nA : cA + (size_t)(t + 2) * kstep; const char* b2 = last ? nB : cB + (size_t)(t + 2) * kstep;
            const char* a3 = a2 + kstep; const char* b3 = b2 + kstep;
            PG8_LDB(B0, 0, 0); PG8_LDB(B1, 0, 1); PG8_SCHED; PG8_LDA(At, 0, 0); PG8_STAGEA(PG8_SA(1, 1), a1, 1, false);
            PG8_WAIT_V(8); PG8_WAIT_L(0); PG8_BAR; PG8_MMA(0, 0, At, B0); PG8_MMA(0, 1, At, B1); PG8_BAR; PG8_SCHED;
            PG8_LDA(At, 0, 1); PG8_STAGE(PG8_SB(0, 0), b2, voffB); PG8_STAGE(PG8_SB(0, 1), b2 + hstepB, voffB); PG8_STAGEA(PG8_SA(0, 0), a2, 0, last);
            PG8_WAIT_V(8); PG8_WAIT_L(0); PG8_BAR; PG8_MMA(1, 0, At, B0); PG8_MMA(1, 1, At, B1); PG8_BAR; PG8_SCHED;
            PG8_LDB(B0, 1, 0); PG8_LDB(B1, 1, 1); PG8_SCHED; PG8_LDA(At, 1, 0); PG8_STAGEA(PG8_SA(0, 1), a2, 1, last);
            PG8_WAIT_V(8); PG8_WAIT_L(0); PG8_BAR; PG8_MMA(0, 0, At, B0); PG8_MMA(0, 1, At, B1); PG8_BAR; PG8_SCHED;
            PG8_LDA(At, 1, 1); PG8_STAGE(PG8_SB(1, 0), b3, voffB); PG8_STAGE(PG8_SB(1, 1), b3 + hstepB, voffB); PG8_STAGEA(PG8_SA(1, 0), a3, 0, last);
            PG8_WAIT_V(8); PG8_WAIT_L(0); PG8_BAR; PG8_MMA(1, 0, At, B0); PG8_MMA(1, 1, At, B1); PG8_BAR; PG8_SCHED;
        }
        if (wr == 0) PG8_BAR;
        E(acc, cur, wr, wc, fr, fq);
        if (!has_next) break;
#pragma unroll
        for (int a = 0; a < 2; ++a)
#pragma unroll
            for (int b = 0; b < 2; ++b)
#pragma unroll
                for (int m = 0; m < 4; ++m)
#pragma unroll
                    for (int n = 0; n < 2; ++n) acc[a][b][m][n] = (f32x4){0.f, 0.f, 0.f, 0.f};
        cur = nxt; cA = nA; cB = nB; ++ui;
        if constexpr (GATHER) { _Pragma("unroll") for (int h = 0; h < 2; ++h) { goff[h][0] = gnoff[h][0]; goff[h][1] = gnoff[h][1]; } }
        if (wr == 1) PG8_BAR;
    }
    PG8_WAIT_V(0);
    PG8_BAR;
#undef PG8_SA
#undef PG8_SB
#undef PG8_STAGE
#undef PG8_STAGEG
#undef PG8_STAGEA
#undef PG8_LDA
#undef PG8_LDB
#undef PG8_MMA
#undef PG8_WAIT_V
#undef PG8_WAIT_L
#undef PG8_BAR
#undef PG8_SCHED
}

struct DenseOrder {
    int nM, nN, nwg, G, c; const char* A; const char* Bt; size_t tstepA, tstepB;
    __device__ void init(int M, int N, int G_, int c_, const void* A_, int lda, const void* Bt_, int ldb) {
        nM = M / BM; nN = N / BM; nwg = nM * nN; G = G_; c = c_; A = (const char*)A_; Bt = (const char*)Bt_; tstepA = (size_t)BM * lda * 2; tstepB = (size_t)BM * ldb * 2; }
    __device__ bool next(int i, Unit& u) const {
        const long L = (long)i * G + c; if (L >= nwg) return false;
        int wgid = (int)L; { const int q = nwg / NXCD, r = nwg % NXCD, xcd = wgid % NXCD, off = wgid / NXCD; wgid = (xcd < r ? xcd * (q + 1) : r * (q + 1) + (xcd - r) * q) + off; }
        const int nig = WGM * nN, gid = wgid / nig, fm = gid * WGM, gsz = (nM - fm) < WGM ? (nM - fm) : WGM;
        u.pm = fm + ((wgid % nig) % gsz); u.pn = (wgid % nig) / gsz; u.aux = 0; u.rows = nullptr;
        u.a = A + (size_t)u.pm * tstepA; u.b = Bt + (size_t)u.pn * tstepB; return true;
    }
};
}

#define EPI_LOOP _Pragma("unroll") for (int ai = 0; ai < 2; ++ai) _Pragma("unroll") for (int m = 0; m < 4; ++m) _Pragma("unroll") for (int bj = 0; bj < 2; ++bj)
#define EPI_ROW(u) ((u).pm * 256 + ai * 128 + wr * 64 + m * 16 + fr)
#define EPI_COL(u) ((u).pn * 256 + bj * 128 + wc * 32 + fq * 8)

struct EpiStoreBf16 {
    bf16_t* O; int ldc;
    __device__ __forceinline__ void operator()(const f32x4 (&acc)[2][2][4][2], const pg8::Unit& u, int wr, int wc, int fr, int fq) const {
        EPI_LOOP { const f32x4 v0 = acc[ai][bj][m][0], v1 = acc[ai][bj][m][1];
            u32x4 w; w.x = pk2(v0[0], v0[1]); w.y = pk2(v0[2], v0[3]); w.z = pk2(v1[0], v1[1]); w.w = pk2(v1[2], v1[3]);
            *(u32x4*)(O + (size_t)EPI_ROW(u) * ldc + EPI_COL(u)) = w; }
    }
};
struct EpiGate {
    bf16_t* O; const bf16_t* proj; int gcol; int add;
    __device__ __forceinline__ void operator()(const f32x4 (&acc)[2][2][4][2], const pg8::Unit& u, int wr, int wc, int fr, int fq) const {
#pragma unroll
        for (int ai = 0; ai < 2; ++ai) {
            u32x4 gv[4][2], pv[4][2];
#pragma unroll
            for (int m = 0; m < 4; ++m)
#pragma unroll
                for (int bj = 0; bj < 2; ++bj) { const int row = EPI_ROW(u), col = EPI_COL(u);
                    gv[m][bj] = *(const u32x4*)(proj + (size_t)row * DINP + gcol + col);
                    pv[m][bj] = add ? *(const u32x4*)(O + (size_t)row * D + col) : (u32x4){0u, 0u, 0u, 0u}; }
            asm volatile("" ::: "memory");
#pragma unroll
            for (int m = 0; m < 4; ++m)
#pragma unroll
                for (int bj = 0; bj < 2; ++bj) { const int row = EPI_ROW(u), col = EPI_COL(u); const u32x4 g = gv[m][bj], q = pv[m][bj];
                    float r[8]; const f32x4 v0 = acc[ai][bj][m][0], v1 = acc[ai][bj][m][1];
                    r[0] = v0[0] * sigmoidf_(bflo(g.x)); r[1] = v0[1] * sigmoidf_(bfhi(g.x)); r[2] = v0[2] * sigmoidf_(bflo(g.y)); r[3] = v0[3] * sigmoidf_(bfhi(g.y));
                    r[4] = v1[0] * sigmoidf_(bflo(g.z)); r[5] = v1[1] * sigmoidf_(bfhi(g.z)); r[6] = v1[2] * sigmoidf_(bflo(g.w)); r[7] = v1[3] * sigmoidf_(bfhi(g.w));
                    if (add) { r[0] += bflo(q.x); r[1] += bfhi(q.x); r[2] += bflo(q.y); r[3] += bfhi(q.y); r[4] += bflo(q.z); r[5] += bfhi(q.z); r[6] += bflo(q.w); r[7] += bfhi(q.w); }
                    u32x4 w; w.x = pk2(r[0], r[1]); w.y = pk2(r[2], r[3]); w.z = pk2(r[4], r[5]); w.w = pk2(r[6], r[7]); *(u32x4*)(O + (size_t)row * D + col) = w; }
        }
    }
};
struct EpiResidual {
    float* O; const float* R;
    __device__ __forceinline__ void operator()(const f32x4 (&acc)[2][2][4][2], const pg8::Unit& u, int wr, int wc, int fr, int fq) const {
#pragma unroll
        for (int ai = 0; ai < 2; ++ai) {
            f32x4 rv[4][2][2];
#pragma unroll
            for (int m = 0; m < 4; ++m)
#pragma unroll
                for (int bj = 0; bj < 2; ++bj) { const size_t o = (size_t)EPI_ROW(u) * D + EPI_COL(u); rv[m][bj][0] = *(const f32x4*)(R + o); rv[m][bj][1] = *(const f32x4*)(R + o + 4); }
            asm volatile("" ::: "memory");
#pragma unroll
            for (int m = 0; m < 4; ++m)
#pragma unroll
                for (int bj = 0; bj < 2; ++bj) { const size_t o = (size_t)EPI_ROW(u) * D + EPI_COL(u);
                    *(f32x4*)(O + o) = rv[m][bj][0] + acc[ai][bj][m][0]; *(f32x4*)(O + o + 4) = rv[m][bj][1] + acc[ai][bj][m][1]; }
        }
    }
};
struct EpiResidualSS {
    float* O; const float* R; float* ss;
    __device__ __forceinline__ void operator()(const f32x4 (&acc)[2][2][4][2], const pg8::Unit& u, int wr, int wc, int fr, int fq) const {
#pragma unroll
        for (int ai = 0; ai < 2; ++ai) {
            f32x4 rv[4][2][2];
#pragma unroll
            for (int m = 0; m < 4; ++m)
#pragma unroll
                for (int bj = 0; bj < 2; ++bj) { const size_t o = (size_t)EPI_ROW(u) * D + EPI_COL(u); rv[m][bj][0] = *(const f32x4*)(R + o); rv[m][bj][1] = *(const f32x4*)(R + o + 4); }
            asm volatile("" ::: "memory");
#pragma unroll
            for (int m = 0; m < 4; ++m) { float sq = 0.f;
#pragma unroll
                for (int bj = 0; bj < 2; ++bj) { const size_t o = (size_t)EPI_ROW(u) * D + EPI_COL(u);
                    const f32x4 v0 = rv[m][bj][0] + acc[ai][bj][m][0], v1 = rv[m][bj][1] + acc[ai][bj][m][1];
                    *(f32x4*)(O + o) = v0; *(f32x4*)(O + o + 4) = v1;
                    sq += (v0[0] * v0[0] + v0[1] * v0[1]) + (v0[2] * v0[2] + v0[3] * v0[3]) + (v1[0] * v1[0] + v1[1] * v1[1]) + (v1[2] * v1[2] + v1[3] * v1[3]); }
                sq += __shfl_xor(sq, 16); sq += __shfl_xor(sq, 32);
                if (fq == 0) atomicAdd(ss + u.pm * 256 + ai * 128 + wr * 64 + m * 16 + fr, sq); }
        }
    }
};
struct EpiResidualNorm {
    float* O; const float* R; bf16_t* Hraw; const float* gain; float* ss;
    __device__ __forceinline__ void operator()(const f32x4 (&acc)[2][2][4][2], const pg8::Unit& u, int wr, int wc, int fr, int fq) const {
        f32x4 gn[2][2];
#pragma unroll
        for (int bj = 0; bj < 2; ++bj) { const int col = u.pn * 256 + bj * 128 + wc * 32 + fq * 8; gn[bj][0] = *(const f32x4*)(gain + col); gn[bj][1] = *(const f32x4*)(gain + col + 4); }
#pragma unroll
        for (int ai = 0; ai < 2; ++ai) {
            f32x4 rv[4][2][2];
#pragma unroll
            for (int m = 0; m < 4; ++m)
#pragma unroll
                for (int bj = 0; bj < 2; ++bj) { const size_t o = (size_t)EPI_ROW(u) * D + EPI_COL(u); rv[m][bj][0] = *(const f32x4*)(R + o); rv[m][bj][1] = *(const f32x4*)(R + o + 4); }
            asm volatile("" ::: "memory");
#pragma unroll
            for (int m = 0; m < 4; ++m) { const int row = u.pm * 256 + ai * 128 + wr * 64 + m * 16 + fr; float sq = 0.f;
#pragma unroll
                for (int bj = 0; bj < 2; ++bj) { const int col = u.pn * 256 + bj * 128 + wc * 32 + fq * 8; const size_t o = (size_t)row * D + col;
                    const f32x4 v0 = rv[m][bj][0] + acc[ai][bj][m][0], v1 = rv[m][bj][1] + acc[ai][bj][m][1];
                    *(f32x4*)(O + o) = v0; *(f32x4*)(O + o + 4) = v1;
                    sq += (v0[0] * v0[0] + v0[1] * v0[1]) + (v0[2] * v0[2] + v0[3] * v0[3]) + (v1[0] * v1[0] + v1[1] * v1[1]) + (v1[2] * v1[2] + v1[3] * v1[3]);
                    const f32x4 g0 = gn[bj][0], g1 = gn[bj][1];
                    u32x4 w; w.x = pk2(v0[0] * g0[0], v0[1] * g0[1]); w.y = pk2(v0[2] * g0[2], v0[3] * g0[3]); w.z = pk2(v1[0] * g1[0], v1[1] * g1[1]); w.w = pk2(v1[2] * g1[2], v1[3] * g1[3]);
                    *(u32x4*)(Hraw + o) = w; }
                sq += __shfl_xor(sq, 16); sq += __shfl_xor(sq, 32);
                if (fq == 0) atomicAdd(ss + row, sq); }
        }
    }
};
struct EpiScaleRowsBf16 {
    bf16_t* O; int ldc; const float* ss;
    __device__ __forceinline__ void operator()(const f32x4 (&acc)[2][2][4][2], const pg8::Unit& u, int wr, int wc, int fr, int fq) const {
        float rs[2][4];
#pragma unroll
        for (int ai = 0; ai < 2; ++ai)
#pragma unroll
            for (int m = 0; m < 4; ++m) rs[ai][m] = ss[u.pm * 256 + ai * 128 + wr * 64 + m * 16 + fr];
#pragma unroll
        for (int ai = 0; ai < 2; ++ai)
#pragma unroll
            for (int m = 0; m < 4; ++m) rs[ai][m] = __builtin_amdgcn_rsqf(rs[ai][m] * (1.f / D) + 1e-6f);
        EPI_LOOP { const int row = EPI_ROW(u); const f32x4 v0 = acc[ai][bj][m][0] * rs[ai][m], v1 = acc[ai][bj][m][1] * rs[ai][m];
            u32x4 w; w.x = pk2(v0[0], v0[1]); w.y = pk2(v0[2], v0[3]); w.z = pk2(v1[0], v1[1]); w.w = pk2(v1[2], v1[3]);
            *(u32x4*)(O + (size_t)row * ldc + EPI_COL(u)) = w; }
    }
};
struct EpiSwiglu {
    bf16_t* O; const float* bias;
    __device__ __forceinline__ void operator()(const f32x4 (&acc)[2][2][4][2], const pg8::Unit& u, int wr, int wc, int fr, int fq) const {
        const float* bg = bias + (size_t)u.aux * 2048 + u.pn * 128 + wc * 32 + fq * 8; const float* bu = bg + 1024;
        float bgv[8], buv[8];
#pragma unroll
        for (int j = 0; j < 8; ++j) { bgv[j] = bg[j]; buv[j] = bu[j]; }
#pragma unroll
        for (int ai = 0; ai < 2; ++ai)
#pragma unroll
            for (int m = 0; m < 4; ++m) {
                const int row = u.pm * 256 + ai * 128 + wr * 64 + m * 16 + fr;
                float r[8];
#pragma unroll
                for (int j = 0; j < 8; ++j) { float gt = acc[ai][0][m][j >> 2][j & 3] + bgv[j], up = acc[ai][1][m][j >> 2][j & 3] + buv[j];
                    gt = fminf(gt, 7.f); up = fminf(fmaxf(up, -7.f), 7.f); r[j] = gt * sigmoidf_(gt * 1.702f) * (up + 1.f); }
                u32x4 w; w.x = pk2(r[0], r[1]); w.y = pk2(r[2], r[3]); w.z = pk2(r[4], r[5]); w.w = pk2(r[6], r[7]);
                *(u32x4*)(O + (size_t)row * D + u.pn * 128 + wc * 32 + fq * 8) = w; }
    }
};
struct EpiDown {
    bf16_t* O; const float* bias; const float* rowgate;
    __device__ __forceinline__ void operator()(const f32x4 (&acc)[2][2][4][2], const pg8::Unit& u, int wr, int wc, int fr, int fq) const {
        float gt[2][4]; f32x4 bb[2][2];
#pragma unroll
        for (int ai = 0; ai < 2; ++ai)
#pragma unroll
            for (int m = 0; m < 4; ++m) gt[ai][m] = rowgate[u.pm * 256 + ai * 128 + wr * 64 + m * 16 + fr];
#pragma unroll
        for (int bj = 0; bj < 2; ++bj) { const float* bp = bias + (size_t)u.aux * D + u.pn * 256 + bj * 128 + wc * 32 + fq * 8; bb[bj][0] = *(const f32x4*)bp; bb[bj][1] = *(const f32x4*)(bp + 4); }
        EPI_LOOP { const int row = EPI_ROW(u), col = EPI_COL(u);
            const f32x4 v0 = (acc[ai][bj][m][0] + bb[bj][0]) * gt[ai][m], v1 = (acc[ai][bj][m][1] + bb[bj][1]) * gt[ai][m];
            u32x4 w; w.x = pk2(v0[0], v0[1]); w.y = pk2(v0[2], v0[3]); w.z = pk2(v1[0], v1[1]); w.w = pk2(v1[2], v1[3]);
            *(u32x4*)(O + (size_t)row * D + col) = w; }
    }
};
struct MoeOrder {
    int G, c, NPN; const LAS int* cum; const char* A; const char* Bt; size_t estepB; const int* rowtok;
    __device__ bool next(int i, pg8::Unit& u) const {
        const int nrb = cum[NE];
        int rb, pn;
        if ((G & 7) == 0 && (G / 8) % NPN == 0) { const int per = G / NPN, rpx = per / 8, xcd = c & 7, j = c >> 3; rb = i * per + xcd * rpx + j / NPN; pn = j % NPN; if (rb >= nrb) return false; }
        else { const int L = i * G + c; if (L >= nrb * NPN) return false; rb = L / NPN; pn = L % NPN; }
        int e = 0;
#pragma unroll 1
        for (int k = 1; k < NE; ++k) e += (rb >= cum[k]) ? 1 : 0;
        u.pm = rb; u.pn = pn; u.aux = e; u.rows = rowtok ? rowtok + rb * 256 : nullptr; u.a = rowtok ? A : A + (size_t)rb * 256 * D * 2; u.b = Bt + (size_t)e * estepB + (size_t)pn * 256 * D * 2; return true;
    }
};

struct TrItem { const float* W; bf16_t* WT; int K, N, ldw, dst_row0, k0, n0; };
__device__ __forceinline__ void tr_load(const TrItem& t, float (&v)[32], int lane) {
    const int n = t.n0 + (lane & 31); const bool ok = n < t.N; const float* src = t.W + (size_t)(t.k0 + (lane >> 5)) * t.ldw + (ok ? n : 0);
#pragma unroll
    for (int i = 0; i < 32; ++i) { const float x = src[(size_t)(2 * i) * t.ldw]; v[i] = ok ? x : 0.f; }
}
__device__ __forceinline__ void tr_lds_write(const float (&v)[32], LAS float* scr, int lane) {
#pragma unroll
    for (int i = 0; i < 32; ++i) scr[(2 * i + (lane >> 5)) * 33 + (lane & 31)] = v[i];
    LDS_FENCE();
}
__device__ __forceinline__ void tr_store(const TrItem& t, LAS float* scr, int lane) {
    const int c = lane & 7;
#pragma unroll
    for (int j = 0; j < 4; ++j) { const int nn = (lane >> 3) + 8 * j; const LAS float* sp = scr + (8 * c) * 33 + nn;
        u32x4 o; o.x = pk2(sp[0 * 33], sp[1 * 33]); o.y = pk2(sp[2 * 33], sp[3 * 33]); o.z = pk2(sp[4 * 33], sp[5 * 33]); o.w = pk2(sp[6 * 33], sp[7 * 33]);
        *(u32x4*)(t.WT + (size_t)(t.dst_row0 + nn) * t.K + t.k0 + 8 * c) = o; }
    LDS_FENCE();
}
__device__ __forceinline__ float rms_row_to_bf16(const float* xrow, const float* __restrict__ gain, bf16_t* orow, int lane) {
    const f32x4* xr = (const f32x4*)xrow + lane; const f32x4* gr = (const f32x4*)gain + lane;
    f32x4 v[4]; float s = 0.f;
#pragma unroll
    for (int j = 0; j < 4; ++j) { v[j] = xr[64 * j]; s += (v[j].x * v[j].x + v[j].y * v[j].y) + (v[j].z * v[j].z + v[j].w * v[j].w); }
    const float rstd = __builtin_amdgcn_rsqf(wave_sum(s) * (1.f / D) + 1e-6f);
    u32x2* o8 = (u32x2*)orow + lane;
#pragma unroll
    for (int j = 0; j < 4; ++j) { const f32x4 gg = gr[64 * j]; u32x2 w; w.x = pk2(v[j].x * rstd * gg.x, v[j].y * rstd * gg.y); w.y = pk2(v[j].z * rstd * gg.z, v[j].w * rstd * gg.w); o8[64 * j] = w; }
    return rstd;
}

__device__ __forceinline__ void rms_rows2_to_bf16(const float* xa, const float* xb, const float* __restrict__ gain, bf16_t* oa, bf16_t* ob, bool hasb, int lane) {
    const f32x4* ra = (const f32x4*)xa + lane; const f32x4* rb = (const f32x4*)xb + lane; const f32x4* gr = (const f32x4*)gain + lane;
    f32x4 va[4], vb[4], gg[4]; float sa = 0.f, sb = 0.f;
#pragma unroll
    for (int j = 0; j < 4; ++j) { va[j] = ra[64 * j]; vb[j] = rb[64 * j]; gg[j] = gr[64 * j]; }
    asm volatile("" ::: "memory");
#pragma unroll
    for (int j = 0; j < 4; ++j) { sa += (va[j].x * va[j].x + va[j].y * va[j].y) + (va[j].z * va[j].z + va[j].w * va[j].w); sb += (vb[j].x * vb[j].x + vb[j].y * vb[j].y) + (vb[j].z * vb[j].z + vb[j].w * vb[j].w); }
    const float rsa = __builtin_amdgcn_rsqf(wave_sum(sa) * (1.f / D) + 1e-6f), rsb = __builtin_amdgcn_rsqf(wave_sum(sb) * (1.f / D) + 1e-6f);
    u32x2* o8a = (u32x2*)oa + lane; u32x2* o8b = (u32x2*)ob + lane;
#pragma unroll
    for (int j = 0; j < 4; ++j) { u32x2 w; w.x = pk2(va[j].x * rsa * gg[j].x, va[j].y * rsa * gg[j].y); w.y = pk2(va[j].z * rsa * gg[j].z, va[j].w * rsa * gg[j].w); o8a[64 * j] = w;
        if (hasb) { u32x2 u; u.x = pk2(vb[j].x * rsb * gg[j].x, vb[j].y * rsb * gg[j].y); u.y = pk2(vb[j].z * rsb * gg[j].z, vb[j].w * rsb * gg[j].w); o8b[64 * j] = u; } }
}

template <int R> struct AttnState { float m[R], l[R], o[R][2]; };
template <int R> __device__ __forceinline__ void attn_init(AttnState<R>& st) {
#pragma unroll
    for (int h = 0; h < R; ++h) { st.m[h] = -1e30f; st.l[h] = 0.f; st.o[h][0] = 0.f; st.o[h][1] = 0.f; }
}
template <int R> __device__ __forceinline__ void attn_block(AttnState<R>& st, const LAS float* q, LAS float* pbuf, const bf16_t* krow, bool valid,
                                                           const bf16_t* vbase, int vstride, int jlo, int jhi, int lane, float scale, float* sraw) {
    float s[R];
#pragma unroll
    for (int h = 0; h < R; ++h) s[h] = 0.f;
    if (valid) {
        const u32x4* kp = (const u32x4*)krow;
#pragma unroll 4
        for (int c = 0; c < 16; ++c) {
            const u32x4 kv = kp[c];
            const float k0 = bflo(kv.x), k1 = bfhi(kv.x), k2 = bflo(kv.y), k3 = bfhi(kv.y), k4 = bflo(kv.z), k5 = bfhi(kv.z), k6 = bflo(kv.w), k7 = bfhi(kv.w);
#pragma unroll
            for (int h = 0; h < R; ++h) { const f32x4 qa = *(const LAS f32x4*)(q + h * 128 + c * 8), qb = *(const LAS f32x4*)(q + h * 128 + c * 8 + 4);
                s[h] += (k0 * qa.x + k1 * qa.y) + (k2 * qa.z + k3 * qa.w) + (k4 * qb.x + k5 * qb.y) + (k6 * qb.z + k7 * qb.w); }
        }
    }
    float alpha[R];
#pragma unroll
    for (int h = 0; h < R; ++h) {
        const float sv = valid ? s[h] * scale : -1e30f; if (sraw) sraw[h] = sv;
        const float bm = wave_max(sv), mn = fmaxf(st.m[h], bm); alpha[h] = __expf(st.m[h] - mn);
        const float p = valid ? __expf(sv - mn) : 0.f;
        st.l[h] = st.l[h] * alpha[h] + wave_sum(p); st.m[h] = mn; st.o[h][0] *= alpha[h]; st.o[h][1] *= alpha[h];
        pbuf[h * 64 + lane] = p;
    }
    LDS_FENCE();
    const bf16_t* vp = vbase + (size_t)jlo * vstride + 2 * lane;
#pragma unroll 4
    for (int j = jlo; j < jhi; ++j) {
        const unsigned vv = *(const unsigned*)vp; vp += vstride; const float v0 = bflo(vv), v1 = bfhi(vv);
#pragma unroll
        for (int h = 0; h < R; ++h) { const float p = pbuf[h * 64 + j]; st.o[h][0] += p * v0; st.o[h][1] += p * v1; }
    }
    LDS_FENCE();
}


#define MFMA16(a, b, c) __builtin_amdgcn_mfma_f32_16x16x32_bf16((a), (b), (c), 0, 0, 0)
#define FRAG(base, pitch, row, kcol) (*(const LAS bf16x8*)((base) + (row) * (pitch) + (kcol)))
__device__ __forceinline__ u32x2 pk4(const f32x4 v) { u32x2 w; w.x = pk2(v[0], v[1]); w.y = pk2(v[2], v[3]); return w; }
__device__ __forceinline__ u32x4 pk8(const f32x4 a, const f32x4 b) { u32x4 w; w.x = pk2(a[0], a[1]); w.y = pk2(a[2], a[3]); w.z = pk2(b[0], b[1]); w.w = pk2(b[2], b[3]); return w; }
constexpr int PK = 136, PC = 72;

__device__ __forceinline__ void gdn_chunk_item(const Params& p, unsigned char* ws, LAS unsigned char* lds, int item, int tid, int lane, int wave) {
    const int n = item & 127, bh = item >> 7, h = bh & 7, b = bh >> 3;
    const int tok0 = b * T + n * 64;
    const bf16_t* PROJ = (const bf16_t*)(ws + WS_PROJ);
    LAS bf16_t* K_RM = (LAS bf16_t*)(lds); LAS bf16_t* KB_RM = (LAS bf16_t*)(lds + 17408); LAS bf16_t* Q_RM = (LAS bf16_t*)(lds + 34816);
    LAS bf16_t* KT_RM = (LAS bf16_t*)(lds + 52224); LAS bf16_t* KBGT = (LAS bf16_t*)(lds + 70656); LAS bf16_t* VBT = (LAS bf16_t*)(lds + 89088);
    LAS float* sc = (LAS float*)(lds + 107520);
    unsigned char* chk = ws + WS_CHK + (size_t)item * CH_BYTES;
    const int fr = lane & 15, fq = lane >> 4, ksw = wave >> 2, ct = wave & 3;
    LAS float* cwl = (LAS float*)(lds + 108544);
    __syncthreads();
    for (int idx = tid; idx < 3 * 4 * 128; idx += NTHREADS) { const int w = idx >> 9, j = (idx >> 7) & 3, c = idx & 127; cwl[idx] = p.in[4][j * 3072 + w * 1024 + h * 128 + c]; }
    __syncthreads();
    {
        float kbv[16];
        const int r = tid >> 3, cg = tid & 7, t = n * 64 + r;
        const float gb = bf2f(PROJ[(size_t)(tok0 + r) * DINP + C_GB + h]), ga = bf2f(PROJ[(size_t)(tok0 + r) * DINP + C_GA + h]);
        const float beta = sigmoidf_(gb); const float xx = ga + p.in[6][h]; const float sp = xx > 20.f ? xx : log1pf(__expf(xx));
        if (cg == 0) sc[r] = -__expf(p.in[5][h]) * sp;
        u32x4 xr[3][4][2];
#define CONV_LOAD(w) do { _Pragma("unroll") for (int j = 0; j < 4; ++j) { const bool inb = (t - 3 + j >= 0); const u32x4* xp = (const u32x4*)(PROJ + (size_t)(inb ? tok0 + r - 3 + j : tok0) * DINP + (w) * 1024 + h * 128 + cg * 16); \
            xr[w][j][0] = xp[0]; xr[w][j][1] = xp[1]; } asm volatile("" ::: "memory"); } while (0)
        CONV_LOAD(0);
#pragma unroll
        for (int w = 0; w < 3; ++w) {
            if (w > 0) CONV_LOAD(w);
            const int ch0 = w * 1024 + h * 128 + cg * 16; (void)ch0;
            float a[16];
#pragma unroll
            for (int e = 0; e < 16; ++e) a[e] = 0.f;
#pragma unroll
            for (int j = 0; j < 4; ++j) {
                {
                    const bool inb = (t - 3 + j >= 0);
                    u32x4 x0 = xr[w][j][0], x1 = xr[w][j][1];
                    if (!inb) { x0 = (u32x4){0u, 0u, 0u, 0u}; x1 = x0; }
                    const LAS f32x4* wp = (const LAS f32x4*)(cwl + (w * 4 + j) * 128 + cg * 16); const f32x4 w0 = wp[0], w1 = wp[1], w2 = wp[2], w3 = wp[3];
                    a[0] += bflo(x0.x) * w0.x; a[1] += bfhi(x0.x) * w0.y; a[2] += bflo(x0.y) * w0.z; a[3] += bfhi(x0.y) * w0.w;
                    a[4] += bflo(x0.z) * w1.x; a[5] += bfhi(x0.z) * w1.y; a[6] += bflo(x0.w) * w1.z; a[7] += bfhi(x0.w) * w1.w;
                    a[8] += bflo(x1.x) * w2.x; a[9] += bfhi(x1.x) * w2.y; a[10] += bflo(x1.y) * w2.z; a[11] += bfhi(x1.y) * w2.w;
                    a[12] += bflo(x1.z) * w3.x; a[13] += bfhi(x1.z) * w3.y; a[14] += bflo(x1.w) * w3.z; a[15] += bfhi(x1.w) * w3.w;
                }
            }
            float ss = 0.f;
#pragma unroll
            for (int e = 0; e < 16; ++e) { a[e] = siluf_(a[e]); ss += a[e] * a[e]; }
            if (w < 2) { ss += __shfl_xor(ss, 1); ss += __shfl_xor(ss, 2); ss += __shfl_xor(ss, 4); const float rn = __builtin_amdgcn_rsqf(ss + 1e-6f) * (w == 0 ? 0.08838834764831845f : 1.f);
#pragma unroll
                for (int e = 0; e < 16; ++e) a[e] *= rn; }
            if (w == 0) { u32x4 o0, o1;
                o0.x = pk2(a[0], a[1]); o0.y = pk2(a[2], a[3]); o0.z = pk2(a[4], a[5]); o0.w = pk2(a[6], a[7]); o1.x = pk2(a[8], a[9]); o1.y = pk2(a[10], a[11]); o1.z = pk2(a[12], a[13]); o1.w = pk2(a[14], a[15]);
                *(LAS u32x4*)(Q_RM + r * PK + cg * 16) = o0; *(LAS u32x4*)(Q_RM + r * PK + cg * 16 + 8) = o1; }
            else if (w == 1) { u32x4 o0, o1;
                o0.x = pk2(a[0], a[1]); o0.y = pk2(a[2], a[3]); o0.z = pk2(a[4], a[5]); o0.w = pk2(a[6], a[7]); o1.x = pk2(a[8], a[9]); o1.y = pk2(a[10], a[11]); o1.z = pk2(a[12], a[13]); o1.w = pk2(a[14], a[15]);
                *(LAS u32x4*)(K_RM + r * PK + cg * 16) = o0; *(LAS u32x4*)(K_RM + r * PK + cg * 16 + 8) = o1;
#pragma unroll
                for (int e = 0; e < 16; ++e) { KT_RM[(cg * 16 + e) * PC + r] = (bf16_t)f2bf(a[e]); kbv[e] = a[e] * beta; }
                o0.x = pk2(kbv[0], kbv[1]); o0.y = pk2(kbv[2], kbv[3]); o0.z = pk2(kbv[4], kbv[5]); o0.w = pk2(kbv[6], kbv[7]); o1.x = pk2(kbv[8], kbv[9]); o1.y = pk2(kbv[10], kbv[11]); o1.z = pk2(kbv[12], kbv[13]); o1.w = pk2(kbv[14], kbv[15]);
                *(LAS u32x4*)(KB_RM + r * PK + cg * 16) = o0; *(LAS u32x4*)(KB_RM + r * PK + cg * 16 + 8) = o1; }
            else {
#pragma unroll
                for (int e = 0; e < 16; ++e) VBT[(cg * 16 + e) * PC + r] = (bf16_t)f2bf(a[e] * beta); }
        }
    }
    __syncthreads();
    if (wave == 0) { float v = sc[lane];
#pragma unroll
        for (int o = 1; o < 64; o <<= 1) { const float u = __shfl_up(v, o); if (lane >= o) v += u; }
        const float gl = __shfl(v, 63); sc[64 + lane] = v; sc[128 + lane] = __expf(v); sc[192 + lane] = __expf(gl - v);
        if (lane == 63) ((float*)(ws + WS_GL))[item] = __expf(v); }
    __syncthreads();
    { const int r = tid >> 3, cg = tid & 7; const float eg = sc[128 + r];
        const u32x4 k0 = *(const LAS u32x4*)(KB_RM + r * PK + cg * 16), k1 = *(const LAS u32x4*)(KB_RM + r * PK + cg * 16 + 8);
        const unsigned kw[8] = {k0.x, k0.y, k0.z, k0.w, k1.x, k1.y, k1.z, k1.w};
#pragma unroll
        for (int e = 0; e < 8; ++e) { KBGT[(cg * 16 + 2 * e) * PC + r] = (bf16_t)f2bf(bflo(kw[e]) * eg); KBGT[(cg * 16 + 2 * e + 1) * PC + r] = (bf16_t)f2bf(bfhi(kw[e]) * eg); } }
    f32x4 d1[2], d2[2], d3[2];
#pragma unroll
    for (int ti = 0; ti < 2; ++ti) { d1[ti] = (f32x4){0.f, 0.f, 0.f, 0.f}; d2[ti] = d1[ti]; d3[ti] = d1[ti]; }
#pragma unroll
    for (int kk = 0; kk < 4; ++kk) {
        const bf16x8 k_b = FRAG(K_RM, PK, 16 * ct + fr, 32 * kk + 8 * fq), kb_b = FRAG(KB_RM, PK, 16 * ct + fr, 32 * kk + 8 * fq), q_b = FRAG(Q_RM, PK, 16 * ct + fr, 32 * kk + 8 * fq);
#pragma unroll
        for (int ti = 0; ti < 2; ++ti) { const int row = 16 * (2 * ksw + ti) + fr;
            const bf16x8 kb_a = FRAG(KB_RM, PK, row, 32 * kk + 8 * fq), k_a = FRAG(K_RM, PK, row, 32 * kk + 8 * fq);
            d1[ti] = MFMA16(kb_a, k_b, d1[ti]); d2[ti] = MFMA16(k_a, kb_b, d2[ti]); d3[ti] = MFMA16(k_a, q_b, d3[ti]); }
    }
#pragma unroll
    for (int q = 0; q < 2; ++q) { const int idx = 2 * wave + q;
        { const int mt = idx >> 2, ks = idx & 3, c = 16 * mt + fr, i0 = 32 * ks + 4 * fq; const float eg = sc[128 + c];
            const u32x2 a = *(const LAS u32x2*)(Q_RM + c * PK + i0), bq = *(const LAS u32x2*)(Q_RM + c * PK + i0 + 16);
            u32x4 o; o.x = pk2(bflo(a.x) * eg, bfhi(a.x) * eg); o.y = pk2(bflo(a.y) * eg, bfhi(a.y) * eg); o.z = pk2(bflo(bq.x) * eg, bfhi(bq.x) * eg); o.w = pk2(bflo(bq.y) * eg, bfhi(bq.y) * eg);
            *(u32x4*)(chk + CH_QD + (idx * 64 + lane) * 16) = o; }
        { const int it = idx >> 1, ks = idx & 1, i = 16 * it + fr, c0 = 32 * ks + 4 * fq;
            const u32x2 a = *(const LAS u32x2*)(KT_RM + i * PC + c0), bq = *(const LAS u32x2*)(KT_RM + i * PC + c0 + 16);
            const f32x4 e0 = *(const LAS f32x4*)(sc + 192 + c0), e1 = *(const LAS f32x4*)(sc + 192 + c0 + 16);
            u32x4 o; o.x = pk2(bflo(a.x) * e0.x, bfhi(a.x) * e0.y); o.y = pk2(bflo(a.y) * e0.z, bfhi(a.y) * e0.w); o.z = pk2(bflo(bq.x) * e1.x, bfhi(bq.x) * e1.y); o.w = pk2(bflo(bq.y) * e1.z, bfhi(bq.y) * e1.w);
            *(u32x4*)(chk + CH_KDT + (idx * 64 + lane) * 16) = o; }
    }
    __syncthreads();
    LAS bf16_t* Xb0 = (LAS bf16_t*)(lds); LAS bf16_t* Xb1 = (LAS bf16_t*)(lds + 9216); LAS bf16_t* XTb0 = (LAS bf16_t*)(lds + 18432); LAS bf16_t* XTb1 = (LAS bf16_t*)(lds + 27648);
    LAS bf16_t* Pb0 = (LAS bf16_t*)(lds + 36864); LAS bf16_t* Pb1 = (LAS bf16_t*)(lds + 46080);
    f32x4 accP[2];
    {
        const int cidx = 16 * ct + fr; const float gc = sc[64 + cidx];
        f32x4 qk[2];
#pragma unroll
        for (int ti = 0; ti < 2; ++ti) { const int r0 = 16 * (2 * ksw + ti) + 4 * fq; const f32x4 gr = *(const LAS f32x4*)(sc + 64 + r0);
            f32x4 xt, xx;
#pragma unroll
            for (int r = 0; r < 4; ++r) { const int rr = r0 + r;
                xt[r] = (rr > cidx) ? -(d1[ti][r] * __expf(gr[r] - gc)) : 0.f;
                xx[r] = (cidx > rr) ? -(d2[ti][r] * __expf(gc - gr[r])) : 0.f;
                qk[ti][r] = (rr <= cidx) ? d3[ti][r] * __expf(gc - gr[r]) : 0.f;
                accP[ti][r] = xx[r] + (rr == cidx ? 1.f : 0.f); }
            *(LAS u32x2*)(XTb0 + cidx * PC + r0) = pk4(xt); *(LAS u32x2*)(Xb0 + cidx * PC + r0) = pk4(xx); *(LAS u32x2*)(Pb0 + cidx * PC + r0) = pk4(accP[ti]); }
        *(u32x4*)(chk + CH_QK + ((ct * 2 + ksw) * 64 + lane) * 16) = pk8(qk[0], qk[1]);
    }
    __syncthreads();
#pragma unroll
    for (int itn = 0; itn < 5; ++itn) {
        LAS bf16_t* Xc = (itn & 1) ? Xb1 : Xb0; LAS bf16_t* Xn = (itn & 1) ? Xb0 : Xb1; LAS bf16_t* XTc = (itn & 1) ? XTb1 : XTb0; LAS bf16_t* XTn = (itn & 1) ? XTb0 : XTb1;
        LAS bf16_t* Pc = (itn & 1) ? Pb1 : Pb0; LAS bf16_t* Pn = (itn & 1) ? Pb0 : Pb1;
        f32x4 e1[2], e2[2];
#pragma unroll
        for (int ti = 0; ti < 2; ++ti) { e1[ti] = (f32x4){0.f, 0.f, 0.f, 0.f}; e2[ti] = e1[ti]; }
#pragma unroll
        for (int kk = 0; kk < 2; ++kk) {
            const bf16x8 bxt = FRAG(XTc, PC, 16 * ct + fr, 32 * kk + 8 * fq), bx = FRAG(Xc, PC, 16 * ct + fr, 32 * kk + 8 * fq);
#pragma unroll
            for (int ti = 0; ti < 2; ++ti) { const int row = 16 * (2 * ksw + ti) + fr;
                e1[ti] = MFMA16(FRAG(Xc, PC, row, 32 * kk + 8 * fq), bxt, e1[ti]);
                if (itn < 4) e2[ti] = MFMA16(FRAG(XTc, PC, row, 32 * kk + 8 * fq), bx, e2[ti]); }
        }
#pragma unroll
        for (int ti = 0; ti < 2; ++ti) { const int r0 = 16 * (2 * ksw + ti) + 4 * fq;
            *(LAS u32x2*)(XTn + (16 * ct + fr) * PC + r0) = pk4(e1[ti]); if (itn < 4) *(LAS u32x2*)(Xn + (16 * ct + fr) * PC + r0) = pk4(e2[ti]); }
        __syncthreads();
#pragma unroll
        for (int kk = 0; kk < 2; ++kk) { const bf16x8 bp = FRAG(Pc, PC, 16 * ct + fr, 32 * kk + 8 * fq);
#pragma unroll
            for (int ti = 0; ti < 2; ++ti) accP[ti] = MFMA16(FRAG(XTn, PC, 16 * (2 * ksw + ti) + fr, 32 * kk + 8 * fq), bp, accP[ti]); }
#pragma unroll
        for (int ti = 0; ti < 2; ++ti) *(LAS u32x2*)(Pn + (16 * ct + fr) * PC + 16 * (2 * ksw + ti) + 4 * fq) = pk4(accP[ti]);
        __syncthreads();
    }
    LAS bf16_t* Tm = Pb1;
    {
        f32x4 u[4];
#pragma unroll
        for (int rt = 0; rt < 4; ++rt) u[rt] = (f32x4){0.f, 0.f, 0.f, 0.f};
#pragma unroll
        for (int kk = 0; kk < 2; ++kk) { const bf16x8 bv = FRAG(VBT, PC, 16 * wave + fr, 32 * kk + 8 * fq);
#pragma unroll
            for (int rt = 0; rt < 4; ++rt) u[rt] = MFMA16(FRAG(Tm, PC, 16 * rt + fr, 32 * kk + 8 * fq), bv, u[rt]); }
        f32x4* U = (f32x4*)(ws + WS_U) + ((size_t)(item * 8 + wave) * 4) * 64 + lane;
#pragma unroll
        for (int rt = 0; rt < 4; ++rt) U[rt * 64] = u[rt];
#pragma unroll
        for (int q = 0; q < 2; ++q) { const int ks2 = ksw + 2 * q;
            f32x4 w2[2] = {(f32x4){0.f, 0.f, 0.f, 0.f}, (f32x4){0.f, 0.f, 0.f, 0.f}};
#pragma unroll
            for (int kk = 0; kk < 2; ++kk) { const bf16x8 bt = FRAG(Tm, PC, 16 * ct + fr, 32 * kk + 8 * fq);
#pragma unroll
                for (int ti = 0; ti < 2; ++ti) w2[ti] = MFMA16(FRAG(KBGT, PC, 16 * (2 * ks2 + ti) + fr, 32 * kk + 8 * fq), bt, w2[ti]); }
            *(u32x4*)(chk + CH_NEGW + ((ct * 4 + ks2) * 64 + lane) * 16) = pk8(-w2[0], -w2[1]); }
    }
}

__device__ __forceinline__ void gdn_scan(unsigned char* ws, LAS unsigned char* lds, int sblk, int tid, int lane, int wave) {
    const int bh = sblk >> 1, half = sblk & 1, b = bh >> 3, h = bh & 7, sl = half * 4 + wave;
    const int fr = lane & 15, fq = lane >> 4;
    const unsigned char* chunks = ws + WS_CHK + (size_t)bh * 128 * CH_BYTES;
    const float* GL = (const float*)(ws + WS_GL) + bh * 128;
    float* GO = (float*)(ws + WS_GO);
#define GDN_STAGE(nn, buf) do { const unsigned char* _src = chunks + (size_t)(nn) * CH_BYTES; _Pragma("unroll") for (int _i = 0; _i < 7; ++_i) \
        __builtin_amdgcn_global_load_lds((const unsigned*)(_src + (_i * 512 + tid) * 16), (LAS unsigned*)(lds + (buf) * CH_BYTES + (_i * 512 + wave * 64) * 16), 16, 0, 0); } while (0)
    __syncthreads();
    GDN_STAGE(0, 0);
    f32x4 S[8]; bf16x8 Sb[4]; f32x4 ucur[4];
#pragma unroll
    for (int i = 0; i < 8; ++i) S[i] = (f32x4){0.f, 0.f, 0.f, 0.f};
#pragma unroll
    for (int i = 0; i < 4; ++i) Sb[i] = (bf16x8){0, 0, 0, 0, 0, 0, 0, 0};
    const f32x4* Ubase = (const f32x4*)(ws + WS_U) + ((size_t)(bh * 128) * 8 + sl) * 256 + lane;
    if (wave < 4) {
#pragma unroll
        for (int rt = 0; rt < 4; ++rt) ucur[rt] = Ubase[rt * 64];
    }
    asm volatile("s_waitcnt vmcnt(0)" ::: "memory");
    __syncthreads();
#pragma unroll 1
    for (int n = 0; n < 128; ++n) {
        const int buf = n & 1;
        if (n + 1 < 128) GDN_STAGE(n + 1, buf ^ 1);
        if (wave < 4) {
            const LAS unsigned char* L = lds + buf * CH_BYTES + lane * 16;
            f32x4 unext[4];
            if (n + 1 < 128) {
#pragma unroll
                for (int rt = 0; rt < 4; ++rt) unext[rt] = Ubase[(size_t)(n + 1) * 2048 + rt * 64];
            }
            const float gl = GL[n];
            f32x4 vn[4], o[4];
#pragma unroll
            for (int rt = 0; rt < 4; ++rt) { vn[rt] = ucur[rt]; o[rt] = (f32x4){0.f, 0.f, 0.f, 0.f}; }
#pragma unroll
            for (int ks = 0; ks < 4; ++ks)
#pragma unroll
                for (int rt = 0; rt < 4; ++rt) {
                    vn[rt] = MFMA16(*(const LAS bf16x8*)(L + CH_NEGW + (rt * 4 + ks) * 1024), Sb[ks], vn[rt]);
                    o[rt] = MFMA16(*(const LAS bf16x8*)(L + CH_QD + (rt * 4 + ks) * 1024), Sb[ks], o[rt]); }
            bf16x8 vb[2];
            vb[0] = __builtin_bit_cast(bf16x8, pk8(vn[0], vn[1])); vb[1] = __builtin_bit_cast(bf16x8, pk8(vn[2], vn[3]));
#pragma unroll
            for (int ks = 0; ks < 2; ++ks)
#pragma unroll
                for (int rt = 0; rt < 4; ++rt) o[rt] = MFMA16(*(const LAS bf16x8*)(L + CH_QK + (rt * 2 + ks) * 1024), vb[ks], o[rt]);
#pragma unroll
            for (int it = 0; it < 8; ++it) S[it] = S[it] * gl;
#pragma unroll
            for (int ks = 0; ks < 2; ++ks)
#pragma unroll
                for (int it = 0; it < 8; ++it) S[it] = MFMA16(*(const LAS bf16x8*)(L + CH_KDT + (it * 2 + ks) * 1024), vb[ks], S[it]);
#pragma unroll
            for (int ks = 0; ks < 4; ++ks) Sb[ks] = __builtin_bit_cast(bf16x8, pk8(S[2 * ks], S[2 * ks + 1]));
            float* go = GO + (size_t)(b * T + n * 64 + 4 * fq) * D + h * 128 + sl * 16 + fr;
#pragma unroll
            for (int rt = 0; rt < 4; ++rt)
#pragma unroll
                for (int r = 0; r < 4; ++r) go[(size_t)(16 * rt + r) * D] = o[rt][r];
            if (n + 1 < 128) {
#pragma unroll
                for (int rt = 0; rt < 4; ++rt) ucur[rt] = unext[rt];
            }
        }
        asm volatile("s_waitcnt vmcnt(0)" ::: "memory");
        __syncthreads();
    }
#undef GDN_STAGE
}


#define MFMA32(a, b, c) __builtin_amdgcn_mfma_f32_32x32x16_bf16((a), (b), (c), 0, 0, 0)
typedef float f32x16 __attribute__((ext_vector_type(16)));
typedef float f32x2v __attribute__((ext_vector_type(2)));
constexpr int NL_RING = 32768;
constexpr int NL_IMP = 65536, NL_Q = 98304, NL_QF = 65536, NL_SELM = 131072;
constexpr float NSA_C = 0.08838834764831845f * 1.4426950408889634f;
__device__ __forceinline__ int vperm16(int off) { return ((off >> 2) & 1) * 8 + (off >> 3) * 4 + (off & 3); }

__device__ __forceinline__ float xor32f(float x) { const unsigned u = __builtin_bit_cast(unsigned, x); auto r = __builtin_amdgcn_permlane32_swap(u, u, false, false);
    return __builtin_bit_cast(float, (threadIdx.x & 32) ? r[0] : r[1]); }
__device__ __forceinline__ float qxor1f(float x) { return __builtin_bit_cast(float, __builtin_amdgcn_update_dpp(0, __builtin_bit_cast(int, x), 0xB1, 0xF, 0xF, false)); }
__device__ __forceinline__ float qxor2f(float x) { return __builtin_bit_cast(float, __builtin_amdgcn_update_dpp(0, __builtin_bit_cast(int, x), 0x4E, 0xF, 0xF, false)); }
__device__ __forceinline__ int kimg_off(int key, int d) { return (((d >> 3) * 64 + key) << 3) + (d & 7); }
__device__ __forceinline__ int vimg_off(int dv, int kpos) { return (((kpos >> 3) * 128 + dv) << 3) + (kpos & 7); }
__device__ __forceinline__ void nsa_stage(LAS unsigned char* lds, int buf, const unsigned char* kimg, const unsigned char* vimg, bool withv, int tid, int wave) {
#pragma unroll
    for (int i = 0; i < 2; ++i) __builtin_amdgcn_global_load_lds((const unsigned*)(kimg + (i * 512 + tid) * 16), (LAS unsigned*)(lds + buf * NL_RING + (i * 512 + wave * 64) * 16), 16, 0, 0);
    if (withv) {
#pragma unroll
        for (int i = 0; i < 2; ++i) __builtin_amdgcn_global_load_lds((const unsigned*)(vimg + (i * 512 + tid) * 16), (LAS unsigned*)(lds + buf * NL_RING + 16384 + (i * 512 + wave * 64) * 16), 16, 0, 0);
    }
}
#define NSA_SYNC(N) do { asm volatile("s_waitcnt vmcnt(" #N ")" ::: "memory"); __builtin_amdgcn_s_barrier(); asm volatile("" ::: "memory"); } while (0)
template <int MODE, int KIND>
__device__ __forceinline__ void nsa_tile(const LAS unsigned char* kb, const LAS unsigned char* vb, int kt, const LAS unsigned char* qlds, const bf16x8 (&Qh)[4], f32x16 (&O)[4], float& m, float& l,
                                         bool colok, int tl, int lim, float il, LAS float* imp_row, int sidx0, int r32, int hi) {
    f32x16 acc;
#pragma unroll
    for (int i = 0; i < 16; ++i) acc[i] = 0.f;
    { const LAS unsigned char* kr = kb + hi * 1024 + (32 * kt + r32) * 16;
        bf16x8 kf[4], qf[4];
#pragma unroll
        for (int ks = 0; ks < 4; ++ks) { kf[ks] = *(const LAS bf16x8*)(kr + ks * 2048); qf[ks] = *(const LAS bf16x8*)(qlds + ks * 1024); }
#pragma unroll
        for (int ks = 0; ks < 4; ++ks) acc = MFMA32(kf[ks], qf[ks], acc);
#pragma unroll
        for (int ks = 0; ks < 4; ++ks) kf[ks] = *(const LAS bf16x8*)(kr + (4 + ks) * 2048);
#pragma unroll
        for (int ks = 0; ks < 4; ++ks) acc = MFMA32(kf[ks], Qh[ks], acc);
        __builtin_amdgcn_sched_group_barrier(0x100, 8, 0);
        __builtin_amdgcn_sched_group_barrier(0x008, 1, 0); __builtin_amdgcn_sched_group_barrier(0x100, 1, 0);
        __builtin_amdgcn_sched_group_barrier(0x008, 1, 0); __builtin_amdgcn_sched_group_barrier(0x100, 1, 0);
        __builtin_amdgcn_sched_group_barrier(0x008, 1, 0); __builtin_amdgcn_sched_group_barrier(0x100, 1, 0);
        __builtin_amdgcn_sched_group_barrier(0x008, 1, 0); __builtin_amdgcn_sched_group_barrier(0x100, 1, 0);
        __builtin_amdgcn_sched_group_barrier(0x008, 4, 0); }
    if (!(KIND == 2 && MODE == 0)) {
#pragma unroll
        for (int reg = 0; reg < 16; ++reg) { const int koff = (reg & 3) + 8 * (reg >> 2) + 4 * hi; bool ok;
            if (MODE == 0) ok = colok; else if (MODE == 1) ok = colok && (32 * kt + koff <= tl); else if (MODE == 2) ok = colok && (32 * kt + koff >= tl + 1); else ok = koff < lim;
            acc[reg] = ok ? acc[reg] : -3e38f; }
    }
    float p[16];
    if (KIND == 0) {
        float tmax = acc[0];
#pragma unroll
        for (int reg = 1; reg < 16; ++reg) tmax = fmaxf(tmax, acc[reg]);
        tmax = fmaxf(tmax, xor32f(tmax));
        const float mnew = fmaxf(m, tmax); l *= __builtin_amdgcn_exp2f((m - mnew) * NSA_C); m = mnew;
        const float mref = fmaxf(m, -1e30f) * NSA_C; float ps = 0.f;
#pragma unroll
        for (int reg = 0; reg < 16; ++reg) ps += __builtin_amdgcn_exp2f(__builtin_fmaf(acc[reg], NSA_C, -mref));
        l += ps + xor32f(ps);
    } else if (KIND == 2) {
        if (__any(m < -1e37f)) {
            float tmax = acc[0];
#pragma unroll
            for (int reg = 1; reg < 16; ++reg) tmax = fmaxf(tmax, acc[reg]);
            tmax = fmaxf(tmax, xor32f(tmax));
            if (MODE == 0) tmax = colok ? tmax : -3e38f;
            m = (m < -1e37f) ? tmax : m;
        }
        float mref = (m < -1e37f) ? 3e38f : m * NSA_C;
        if (MODE == 0) mref = colok ? mref : 3e38f;
        f32x2v ps2 = {0.f, 0.f};
#pragma unroll
        for (int reg = 0; reg < 16; reg += 2) { p[reg] = __builtin_amdgcn_exp2f(fminf(__builtin_fmaf(acc[reg], NSA_C, -mref), 100.f)); p[reg + 1] = __builtin_amdgcn_exp2f(fminf(__builtin_fmaf(acc[reg + 1], NSA_C, -mref), 100.f));
            ps2 += (f32x2v){p[reg], p[reg + 1]}; }
        const float ps = ps2.x + ps2.y;
        l += ps + xor32f(ps);
    } else {
        const float mref = fmaxf(m, -1e30f) * NSA_C;
#pragma unroll
        for (int reg = 0; reg < 16; ++reg) p[reg] = __builtin_amdgcn_exp2f(__builtin_fmaf(acc[reg], NSA_C, -mref)) * il;
#pragma unroll
        for (int q = 0; q < 4; ++q) { float gsum = 2.f * (p[4 * q] + p[4 * q + 1] + p[4 * q + 2]) + p[4 * q + 3], ls = p[4 * q + 3];
            gsum += qxor1f(gsum); ls += qxor1f(ls); gsum += qxor2f(gsum); ls += qxor2f(ls);
            if ((r32 & 3) == 0) { const int sidx = sidx0 + 2 * q + hi;
                __hip_atomic_fetch_add(imp_row + sidx, gsum, __ATOMIC_RELAXED, __HIP_MEMORY_SCOPE_WORKGROUP);
                if (sidx + 1 < NSEL) __hip_atomic_fetch_add(imp_row + sidx + 1, ls, __ATOMIC_RELAXED, __HIP_MEMORY_SCOPE_WORKGROUP); } }
    }
    if (KIND != 0) {
        bf16x8 pb[2];
#pragma unroll
        for (int s2 = 0; s2 < 2; ++s2) { u32x4 w; w.x = pk2(p[8 * s2], p[8 * s2 + 1]); w.y = pk2(p[8 * s2 + 2], p[8 * s2 + 3]); w.z = pk2(p[8 * s2 + 4], p[8 * s2 + 5]); w.w = pk2(p[8 * s2 + 6], p[8 * s2 + 7]); pb[s2] = __builtin_bit_cast(bf16x8, w); }
#pragma unroll
        for (int mt = 0; mt < 4; ++mt) { const LAS unsigned char* vr = vb + hi * 2048 + (32 * mt + r32) * 16;
#pragma unroll
            for (int s2 = 0; s2 < 2; ++s2) O[mt] = MFMA32(*(const LAS bf16x8*)(vr + (2 * kt + s2) * 4096), pb[s2], O[mt]); }
        __builtin_amdgcn_sched_group_barrier(0x100, 8, 1);
        __builtin_amdgcn_sched_group_barrier(0x008, 8, 1);
    }
}

template <int MODE>
__device__ __forceinline__ void nsa_block_fast(const LAS unsigned char* slot, const LAS unsigned char* qf, f32x16 (&O)[4], float m, float& l, bool colok, int tl, int r32, int hi) {
    const LAS unsigned char* kr = slot + hi * 1024 + r32 * 16;
    const LAS unsigned char* vb = slot + 16384 + hi * 2048 + r32 * 16;
    float mref = m * NSA_C;
    if (MODE == 0) mref = colok ? mref : 3e38f;
    f32x16 a0, a1;
#pragma unroll
    for (int i = 0; i < 16; ++i) { a0[i] = 0.f; a1[i] = 0.f; }
    bf16x8 vv[8];
    {
        bf16x8 qv[8], kv[8];
#pragma unroll
        for (int ks = 0; ks < 8; ++ks) { qv[ks] = *(const LAS bf16x8*)(qf + ks * 1024); kv[ks] = *(const LAS bf16x8*)(kr + ks * 2048); }
#pragma unroll
        for (int ks = 0; ks < 8; ++ks) a0 = MFMA32(kv[ks], qv[ks], a0);
#pragma unroll
        for (int ks = 0; ks < 8; ++ks) kv[ks] = *(const LAS bf16x8*)(kr + 512 + ks * 2048);
#pragma unroll
        for (int ks = 0; ks < 8; ++ks) a1 = MFMA32(kv[ks], qv[ks], a1);
    }
#pragma unroll
    for (int mt = 0; mt < 4; ++mt)
#pragma unroll
        for (int s2 = 0; s2 < 2; ++s2) vv[mt * 2 + s2] = *(const LAS bf16x8*)(vb + mt * 512 + s2 * 4096);
    f32x2v ps2 = {0.f, 0.f};
    bf16x8 pb[2];
#pragma unroll
    for (int reg = 0; reg < 16; reg += 2) { float x0 = a0[reg], x1 = a0[reg + 1];
        if (MODE != 0) { const int k0 = (reg & 3) + 8 * (reg >> 2) + 4 * hi, k1 = k0 + 1; const bool o0 = colok && (MODE == 1 ? (k0 <= tl) : (k0 >= tl + 1)), o1 = colok && (MODE == 1 ? (k1 <= tl) : (k1 >= tl + 1)); x0 = o0 ? x0 : -3e38f; x1 = o1 ? x1 : -3e38f; }
        x0 = __builtin_amdgcn_exp2f(fminf(__builtin_fmaf(x0, NSA_C, -mref), 100.f)); x1 = __builtin_amdgcn_exp2f(fminf(__builtin_fmaf(x1, NSA_C, -mref), 100.f));
        ps2 += (f32x2v){x0, x1}; a0[reg] = x0; a0[reg + 1] = x1; }
#pragma unroll
    for (int s2 = 0; s2 < 2; ++s2) { u32x4 w; w.x = pk2(a0[8 * s2], a0[8 * s2 + 1]); w.y = pk2(a0[8 * s2 + 2], a0[8 * s2 + 3]); w.z = pk2(a0[8 * s2 + 4], a0[8 * s2 + 5]); w.w = pk2(a0[8 * s2 + 6], a0[8 * s2 + 7]); pb[s2] = __builtin_bit_cast(bf16x8, w); }
#pragma unroll
    for (int mt = 0; mt < 4; ++mt)
#pragma unroll
        for (int s2 = 0; s2 < 2; ++s2) O[mt] = MFMA32(vv[mt * 2 + s2], pb[s2], O[mt]);
#pragma unroll
    for (int mt = 0; mt < 4; ++mt)
#pragma unroll
        for (int s2 = 0; s2 < 2; ++s2) vv[mt * 2 + s2] = *(const LAS bf16x8*)(vb + mt * 512 + (2 + s2) * 4096);
#pragma unroll
    for (int reg = 0; reg < 16; reg += 2) { float x0 = a1[reg], x1 = a1[reg + 1];
        if (MODE != 0) { const int k0 = 32 + (reg & 3) + 8 * (reg >> 2) + 4 * hi, k1 = k0 + 1; const bool o0 = colok && (MODE == 1 ? (k0 <= tl) : (k0 >= tl + 1)), o1 = colok && (MODE == 1 ? (k1 <= tl) : (k1 >= tl + 1)); x0 = o0 ? x0 : -3e38f; x1 = o1 ? x1 : -3e38f; }
        x0 = __builtin_amdgcn_exp2f(fminf(__builtin_fmaf(x0, NSA_C, -mref), 100.f)); x1 = __builtin_amdgcn_exp2f(fminf(__builtin_fmaf(x1, NSA_C, -mref), 100.f));
        ps2 += (f32x2v){x0, x1}; a1[reg] = x0; a1[reg + 1] = x1; }
#pragma unroll
    for (int s2 = 0; s2 < 2; ++s2) { u32x4 w; w.x = pk2(a1[8 * s2], a1[8 * s2 + 1]); w.y = pk2(a1[8 * s2 + 2], a1[8 * s2 + 3]); w.z = pk2(a1[8 * s2 + 4], a1[8 * s2 + 5]); w.w = pk2(a1[8 * s2 + 6], a1[8 * s2 + 7]); pb[s2] = __builtin_bit_cast(bf16x8, w); }
#pragma unroll
    for (int mt = 0; mt < 4; ++mt)
#pragma unroll
        for (int s2 = 0; s2 < 2; ++s2) O[mt] = MFMA32(vv[mt * 2 + s2], pb[s2], O[mt]);
    const float ps = ps2.x + ps2.y;
    l += ps + xor32f(ps);
}
template <int MODE>
__device__ __forceinline__ void nsa_block(const LAS unsigned char* slot, const LAS unsigned char* qf, f32x16 (&O)[4], float& m, float& l, bool colok, int tl, int r32, int hi) {
    if (__any(m < -1e37f)) {
        bf16x8 Qh[4];
#pragma unroll
        for (int ks = 0; ks < 4; ++ks) Qh[ks] = *(const LAS bf16x8*)(qf + (4 + ks) * 1024);
#pragma unroll 1
        for (int kt = 0; kt < 2; ++kt) nsa_tile<MODE, 2>(slot, slot + 16384, kt, qf, Qh, O, m, l, colok, tl, 0, 0.f, (LAS float*)slot, 0, r32, hi);
    } else nsa_block_fast<MODE>(slot, qf, O, m, l, colok, tl, r32, hi);
}

__device__ __forceinline__ void nsa_item(const Params& p, unsigned char* ws, LAS unsigned char* lds, int item, int tid, int lane, int wave) {
    const int tile = 127 - (item >> 2), bg = item & 3, b = bg >> 1, g = bg & 1, t0 = tile * 64, cur = tile;
    const int r32 = lane & 31, hi = lane >> 5, tl = 8 * wave + (r32 >> 2), head = g * 4 + (r32 & 3), t = t0 + tl, tok = b * T + t;
    const bf16_t* PROJ = (const bf16_t*)(ws + WS_PROJ);
    LAS float* IMP = (LAS float*)(lds + NL_IMP); LAS unsigned* SELM = (LAS unsigned*)(lds + NL_SELM);
    __syncthreads();
    nsa_stage(lds, 0, ws + WS_KC + (size_t)(bg * 8) * 16384, ws + WS_VC, false, tid, wave);
    for (int idx = tid; idx < 64 * NSEL; idx += NTHREADS) IMP[idx] = 0.f;
    LAS unsigned char* const qlds = lds + NL_Q + wave * 4096 + hi * 512 + r32 * 16;
    bf16x8 Qh[4];
#pragma unroll
    for (int ks = 0; ks < 4; ++ks) { *(LAS bf16x8*)(qlds + ks * 1024) = *(const bf16x8*)(PROJ + (size_t)tok * DINP + C_NQ + head * 128 + 16 * ks + 8 * hi);
        Qh[ks] = *(const bf16x8*)(PROJ + (size_t)tok * DINP + C_NQ + head * 128 + 16 * (4 + ks) + 8 * hi); }
    f32x16 O[4];
    float m, l;
#define OB_PTR() bf16_t* ob; { int tk_ = tok; asm volatile("" : "+v"(tk_)); ob = (bf16_t*)(ws + WS_OB) + (size_t)tk_ * D + head * 128 + 4 * hi; }
#define O_ZERO() do { _Pragma("unroll") for (int mt = 0; mt < 4; ++mt) _Pragma("unroll") for (int i = 0; i < 16; ++i) O[mt][i] = 0.f; } while (0)
#define RING_LOOP(NBLK, NOPS, STAGE, ...) do { const int nblk_ = (NBLK); \
        { const int sb_ = 0, slot_ = 0; STAGE; } if (nblk_ > 1) { const int sb_ = 1, slot_ = 1; STAGE; NSA_SYNC(NOPS); } else { NSA_SYNC(0); } \
        int cs_ = 0; \
        _Pragma("unroll 1") for (int st_ = 0; st_ < 2 * nblk_; ++st_) { \
            const int s = st_ >> 1, kt = st_ & 1; const bool more_ = (s + 2 < nblk_); \
            if (kt == 0 && more_) { const int sb_ = s + 2, slot_ = (cs_ == 0 ? 2 : cs_ - 1); STAGE; } \
            { const LAS unsigned char* slotp = lds + cs_ * NL_RING; __VA_ARGS__; } \
            if (kt == 1) { if (more_) { NSA_SYNC(NOPS); } else { NSA_SYNC(0); } cs_ = (cs_ == 2 ? 0 : cs_ + 1); } } } while (0)
#define RING_LOOPB(NBLK, NOPS, STAGE, ...) do { const int nblk_ = (NBLK); \
        { const int sb_ = 0, slot_ = 0; STAGE; } if (nblk_ > 1) { const int sb_ = 1, slot_ = 1; STAGE; NSA_SYNC(NOPS); } else { NSA_SYNC(0); } \
        int cs_ = 0; \
        _Pragma("unroll 1") for (int s = 0; s < nblk_; ++s) { const bool more_ = (s + 2 < nblk_); \
            if (more_) { const int sb_ = s + 2, slot_ = (cs_ == 0 ? 2 : cs_ - 1); STAGE; } \
            { const LAS unsigned char* slotp = lds + cs_ * NL_RING; __VA_ARGS__; } \
            if (more_) { NSA_SYNC(NOPS); } else { NSA_SYNC(0); } cs_ = (cs_ == 2 ? 0 : cs_ + 1); } } while (0)
#define RING_LOOP2(NBLK, NOPS, STAGE, ...) do { const int nblk_ = (NBLK); \
        NSA_SYNC(0);   \
        _Pragma("unroll 1") for (int st_ = 0; st_ < 2 * nblk_; ++st_) { \
            const int s = st_ >> 1, kt = st_ & 1; \
            if (kt == 0 && s + 1 < nblk_) { const int sb_ = s + 1, slot_ = (s + 1) & 1; STAGE; } \
            { const LAS unsigned char* slotp = lds + (s & 1) * NL_RING; __VA_ARGS__; } \
            if (kt == 1) { NSA_SYNC(0); } } } while (0)
#define RING_LOOPB2(NBLK, STAGE, ...) do { const int nblk_ = (NBLK); \
        NSA_SYNC(0);   \
        _Pragma("unroll 1") for (int s = 0; s < nblk_; ++s) { \
            if (s + 1 < nblk_) { const int sb_ = s + 1, slot_ = (s + 1) & 1; STAGE; } \
            { const LAS unsigned char* slotp = lds + (s & 1) * NL_RING; __VA_ARGS__; } \
            NSA_SYNC(0); } } while (0)
#define RING_LOOP4(NBLK, STAGE, ...) do { const int nblk_ = (NBLK); \
        { const int sb_ = 0, slot_ = 0; STAGE; } if (nblk_ > 1) { const int sb_ = 1, slot_ = 1; STAGE; } if (nblk_ > 2) { const int sb_ = 2, slot_ = 2; STAGE; } \
        if (nblk_ > 2) { NSA_SYNC(8); } else if (nblk_ > 1) { NSA_SYNC(4); } else { NSA_SYNC(0); } \
        int cs_ = 0; \
        _Pragma("unroll 1") for (int st_ = 0; st_ < 2 * nblk_; ++st_) { \
            const int s = st_ >> 1, kt = st_ & 1; \
            if (kt == 0 && s + 3 < nblk_) { const int sb_ = s + 3, slot_ = (cs_ + 3) & 3; STAGE; } \
            { const LAS unsigned char* slotp = lds + cs_ * NL_RING; __VA_ARGS__; } \
            if (kt == 1) { if (s + 3 < nblk_) { NSA_SYNC(8); } else if (s + 2 < nblk_) { NSA_SYNC(4); } else { NSA_SYNC(0); } cs_ = (cs_ + 1) & 3; } } } while (0)
    const int nvis = t >= 31 ? min((t - 31) / 16 + 1, NCMP) : 0;
    const int nbc = (min(4 * tile + 3, NCMP) + 63) >> 6;
    const unsigned char* kcb = ws + WS_KC + (size_t)(b * 2 + g) * 8 * 16384; const unsigned char* vcb = ws + WS_VC + (size_t)(b * 2 + g) * 8 * 16384;
    m = -3e38f; l = 0.f;
    RING_LOOP2(nbc, 2, nsa_stage(lds, slot_, kcb + (size_t)sb_ * 16384, vcb, false, tid, wave),
              (nsa_tile<3, 0>(slotp, slotp + 16384, kt, qlds, Qh, O, m, l, true, tl, nvis - 64 * s - 32 * kt, 0.f, IMP, 0, r32, hi)));
    nsa_stage(lds, 0, kcb, vcb, true, tid, wave);
    {
        const float il = 1.f / fmaxf(l, 1e-30f);
        O_ZERO();
        RING_LOOP2(nbc, 4, nsa_stage(lds, slot_, kcb + (size_t)sb_ * 16384, vcb + (size_t)sb_ * 16384, true, tid, wave),
                  (nsa_tile<3, 1>(slotp, slotp + 16384, kt, qlds, Qh, O, m, l, true, tl, nvis - 64 * s - 32 * kt, il, IMP + tl * NSEL, 16 * s + 8 * kt, r32, hi)));
        nsa_stage(lds, 0, ws + WS_KSR + (size_t)(bg * 128) * 16384, ws + WS_VST + (size_t)(bg * 128) * 16384, true, tid, wave);
        const float gt = sigmoidf_(bf2f(PROJ[(size_t)tok * DINP + C_NG + head * 3 + 0]));
        OB_PTR();
#pragma unroll
        for (int mt = 0; mt < 4; ++mt)
#pragma unroll
            for (int q = 0; q < 4; ++q) { u32x2 w; w.x = pk2(O[mt][4 * q] * gt, O[mt][4 * q + 1] * gt); w.y = pk2(O[mt][4 * q + 2] * gt, O[mt][4 * q + 3] * gt); *(u32x2*)(ob + 32 * mt + 8 * q) = w; }
    }
    {
#pragma unroll 1
        for (int tt = 0; tt < 8; ++tt) { const int tokl = 8 * wave + tt; const LAS float* ip = IMP + tokl * NSEL;
            unsigned key0 = 0u, key1 = 0u;
            { const int s0 = lane, s1 = lane + 64;
                if (s0 <= cur) { const bool forced = (s0 == 0) || (s0 == cur) || (s0 == cur - 1); key0 = ((__builtin_bit_cast(unsigned, ip[s0] + (forced ? 1e4f : 0.f)) | 0x80u) & ~0x7Fu) | (unsigned)(127 - s0); }
                if (s1 <= cur) { const bool forced = (s1 == cur) || (s1 == cur - 1); key1 = ((__builtin_bit_cast(unsigned, ip[s1] + (forced ? 1e4f : 0.f)) | 0x80u) & ~0x7Fu) | (unsigned)(127 - s1); } }
            unsigned thr = 0u;
#pragma unroll 4
            for (int bit = 31; bit >= 0; --bit) { const unsigned trial = thr | (1u << bit);
                const int cnt = __popcll(__ballot(key0 >= trial)) + __popcll(__ballot(key1 >= trial));
                thr = (cnt >= TOPN) ? trial : thr; }
            const unsigned long long b0 = __ballot(key0 != 0u && key0 >= thr), b1 = __ballot(key1 != 0u && key1 >= thr);
            if (lane == 0) { SELM[tokl * 4 + 0] = (unsigned)b0; SELM[tokl * 4 + 1] = (unsigned)(b0 >> 32); SELM[tokl * 4 + 2] = (unsigned)b1; SELM[tokl * 4 + 3] = (unsigned)(b1 >> 32); }
        }
        LDS_FENCE();
    }
    __syncthreads();
    LAS unsigned char* const qf = lds + NL_QF + wave * 8192 + hi * 512 + r32 * 16;
    { int tk_ = tok; asm volatile("" : "+v"(tk_)); const bf16_t* qr = (const bf16_t*)(ws + WS_QR) + (size_t)tk_ * D + head * 128 + 8 * hi;
#pragma unroll
        for (int ks = 0; ks < 8; ++ks) *(LAS bf16x8*)(qf + ks * 1024) = *(const bf16x8*)(qr + 16 * ks); }
    {
        const unsigned char* kb0 = ws + WS_KSR + (size_t)(b * 2 + g) * 128 * 16384; const unsigned char* vb0 = ws + WS_VST + (size_t)(b * 2 + g) * 128 * 16384;
        m = -3e38f; l = 0.f; O_ZERO();
        RING_LOOPB2(cur + 1, nsa_stage(lds, slot_, kb0 + (size_t)sb_ * 16384, vb0 + (size_t)sb_ * 16384, true, tid, wave),
                  { const bool colok = (SELM[tl * 4 + (s >> 5)] >> (s & 31)) & 1u;
                    if (__any(colok)) { if (s == cur) nsa_block<1>(slotp, qf, O, m, l, colok, tl, r32, hi); else nsa_block<0>(slotp, qf, O, m, l, colok, tl, r32, hi); } });
        { const int slo_ = cur >= 8 ? cur - 8 : 0; nsa_stage(lds, 0, ws + WS_KWR + (size_t)(bg * 128 + slo_) * 16384, ws + WS_VWT + (size_t)(bg * 128 + slo_) * 16384, true, tid, wave); }
        const float gt = sigmoidf_(bf2f(PROJ[(size_t)tok * DINP + C_NG + head * 3 + 1])) / fmaxf(l, 1e-30f);
        OB_PTR();
        u32x2 ow[16];
#pragma unroll
        for (int i = 0; i < 16; ++i) ow[i] = *(const u32x2*)(ob + 32 * (i >> 2) + 8 * (i & 3));
        asm volatile("" ::: "memory");
#pragma unroll
        for (int mt = 0; mt < 4; ++mt)
#pragma unroll
            for (int q = 0; q < 4; ++q) { u32x2 w = ow[mt * 4 + q];
                w.x = pk2(bflo(w.x) + O[mt][4 * q] * gt, bfhi(w.x) + O[mt][4 * q + 1] * gt); w.y = pk2(bflo(w.y) + O[mt][4 * q + 2] * gt, bfhi(w.y) + O[mt][4 * q + 3] * gt); *(u32x2*)(ob + 32 * mt + 8 * q) = w; }
    }
    {
        const int slo = cur >= 8 ? cur - 8 : 0;
        const unsigned char* kb0 = ws + WS_KWR + (size_t)((b * 2 + g) * 128 + slo) * 16384; const unsigned char* vb0 = ws + WS_VWT + (size_t)((b * 2 + g) * 128 + slo) * 16384;
        m = -3e38f; l = 0.f; O_ZERO();
        RING_LOOPB2(cur - slo + 1, nsa_stage(lds, slot_, kb0 + (size_t)sb_ * 16384, vb0 + (size_t)sb_ * 16384, true, tid, wave),
                  { const int sa = slo + s; if (sa == cur) nsa_block<1>(slotp, qf, O, m, l, true, tl, r32, hi);
                    else if (sa == cur - 8) nsa_block<2>(slotp, qf, O, m, l, true, tl, r32, hi);
                    else nsa_block<0>(slotp, qf, O, m, l, true, tl, r32, hi); });
        const float gt = sigmoidf_(bf2f(PROJ[(size_t)tok * DINP + C_NG + head * 3 + 2])) / fmaxf(l, 1e-30f);
        OB_PTR();
        u32x2 ow[16];
#pragma unroll
        for (int i = 0; i < 16; ++i) ow[i] = *(const u32x2*)(ob + 32 * (i >> 2) + 8 * (i & 3));
        asm volatile("" ::: "memory");
#pragma unroll
        for (int mt = 0; mt < 4; ++mt)
#pragma unroll
            for (int q = 0; q < 4; ++q) { u32x2 w = ow[mt * 4 + q];
                w.x = pk2(bflo(w.x) + O[mt][4 * q] * gt, bfhi(w.x) + O[mt][4 * q + 1] * gt); w.y = pk2(bflo(w.y) + O[mt][4 * q + 2] * gt, bfhi(w.y) + O[mt][4 * q + 3] * gt); *(u32x2*)(ob + 32 * mt + 8 * q) = w; }
    }
    asm volatile("s_waitcnt vmcnt(0)" ::: "memory");
#undef OB_PTR
#undef O_ZERO
}

__device__ __forceinline__ void cmp_item(const Params& p, unsigned char* ws, LAS unsigned char* lds, int item, int tid, int lane, int wave) {
    const int which = item >> 6, b = (item >> 5) & 1, g = (item >> 4) & 1, n0 = (item & 15) * 32;
    const bf16_t* PROJ = (const bf16_t*)(ws + WS_PROJ);
    const int ccol = (which ? C_NVC : C_NKC) + g * 128;
    const float* pe = p.in[which ? 11 : 8];
    const unsigned char* w1t = ws + WS_W1T + (size_t)which * 128 * 4096 * 2;
    const int fr = lane & 15, fq = lane >> 4;
    LAS unsigned char* LA = lds; LAS unsigned char* LB = lds + 16384; LAS bf16_t* HID = (LAS bf16_t*)(lds + 81920); LAS bf16_t* W2L = (LAS bf16_t*)(lds + 90624);
    __syncthreads();
    { const bf16_t* w2t = (const bf16_t*)(ws + WS_W2T) + which * 128 * 128;
        for (int idx = tid; idx < 128 * 16; idx += NTHREADS) { const int rr = idx >> 4, c = idx & 15; *(LAS u32x4*)(W2L + rr * PK + c * 8) = *(const u32x4*)(w2t + rr * 128 + c * 8); } }
    const int arow = tid >> 4, ach = tid & 15;
    auto stageB = [&](int pp, int buf) {
#pragma unroll
        for (int i = 0; i < 4; ++i) { const int pi = tid + 512 * i, row = pi >> 4, ch = (pi & 15) ^ (row & 15);
            __builtin_amdgcn_global_load_lds((const unsigned*)(w1t + (size_t)row * 8192 + pp * 256 + ch * 16), (LAS unsigned*)(LB + buf * 32768 + (i * 512 + wave * 64) * 16), 16, 0, 0); } };
    auto loadA = [&](int pp) -> u32x4 { const int tkn = 16 * (n0 + arow) + pp;
        if (tkn >= T) return (u32x4){0u, 0u, 0u, 0u};
        const u32x4 x = *(const u32x4*)(PROJ + (size_t)(b * T + tkn) * DINP + ccol + ach * 8); const f32x4 e0 = *(const f32x4*)(pe + pp * 128 + ach * 8), e1 = *(const f32x4*)(pe + pp * 128 + ach * 8 + 4);
        u32x4 o; o.x = pk2(bflo(x.x) + e0.x, bfhi(x.x) + e0.y); o.y = pk2(bflo(x.y) + e0.z, bfhi(x.y) + e0.w); o.z = pk2(bflo(x.z) + e1.x, bfhi(x.z) + e1.y); o.w = pk2(bflo(x.w) + e1.z, bfhi(x.w) + e1.w); return o; };
    f32x4 acc[2] = {(f32x4){0.f, 0.f, 0.f, 0.f}, (f32x4){0.f, 0.f, 0.f, 0.f}};
    stageB(0, 0); u32x4 areg = loadA(0);
    *(LAS u32x4*)(LA + arow * 256 + ((ach ^ (arow & 15)) << 4)) = areg;
    asm volatile("s_waitcnt vmcnt(0)" ::: "memory"); __syncthreads();
#pragma unroll 1
    for (int pp = 0; pp < 32; ++pp) { const int buf = pp & 1;
        if (pp + 1 < 32) { stageB(pp + 1, buf ^ 1); areg = loadA(pp + 1); }
        const LAS unsigned char* Ab = LA + buf * 8192; const LAS unsigned char* Bb = LB + buf * 32768;
#pragma unroll
        for (int kk = 0; kk < 4; ++kk) { const int wrow = 16 * wave + fr;
            const bf16x8 wf = *(const LAS bf16x8*)(Bb + wrow * 256 + (((4 * kk + fq) ^ (wrow & 15)) << 4));
#pragma unroll
            for (int nt = 0; nt < 2; ++nt) { const int nrow = 16 * nt + fr;
                acc[nt] = MFMA16(wf, *(const LAS bf16x8*)(Ab + nrow * 256 + (((4 * kk + fq) ^ (nrow & 15)) << 4)), acc[nt]); } }
        if (pp + 1 < 32) *(LAS u32x4*)(LA + (buf ^ 1) * 8192 + arow * 256 + ((ach ^ (arow & 15)) << 4)) = areg;
        asm volatile("s_waitcnt vmcnt(0)" ::: "memory"); __syncthreads();
    }
#pragma unroll
    for (int nt = 0; nt < 2; ++nt) { f32x4 hv;
#pragma unroll
        for (int r = 0; r < 4; ++r) hv[r] = siluf_(acc[nt][r]);
        *(LAS u32x2*)(HID + (16 * nt + fr) * PK + 16 * wave + 4 * fq) = pk4(hv); }
    __syncthreads();
    if (which == 0) {
        f32x4 o[2] = {(f32x4){0.f, 0.f, 0.f, 0.f}, (f32x4){0.f, 0.f, 0.f, 0.f}};
#pragma unroll
        for (int kk = 0; kk < 4; ++kk) { const bf16x8 af = FRAG(W2L, PK, 16 * wave + fr, 32 * kk + 8 * fq);
#pragma unroll
            for (int nt = 0; nt < 2; ++nt) o[nt] = MFMA16(af, FRAG(HID, PK, 16 * nt + fr, 32 * kk + 8 * fq), o[nt]); }
#pragma unroll
        for (int nt = 0; nt < 2; ++nt) { const int n = n0 + 16 * nt + fr; const f32x4 z = {0.f, 0.f, 0.f, 0.f};
            *(u32x2*)((bf16_t*)(ws + WS_KC) + ((size_t)((b * 2 + g) * 8 + (n >> 6)) << 13) + kimg_off(n & 63, 16 * wave + 4 * fq)) = pk4(n < NCMP ? o[nt] : z); }
    } else {
        f32x4 o[2] = {(f32x4){0.f, 0.f, 0.f, 0.f}, (f32x4){0.f, 0.f, 0.f, 0.f}};
#pragma unroll
        for (int kk = 0; kk < 4; ++kk) { const bf16x8 bfw = FRAG(W2L, PK, 16 * wave + fr, 32 * kk + 8 * fq);
#pragma unroll
            for (int nt = 0; nt < 2; ++nt) o[nt] = MFMA16(FRAG(HID, PK, 16 * nt + fr, 32 * kk + 8 * fq), bfw, o[nt]); }
#pragma unroll
        for (int nt = 0; nt < 2; ++nt) { f32x4 v = o[nt]; if (n0 + 16 * nt + 4 * fq + 3 >= NCMP) { if (n0 + 16 * nt + 4 * fq + 3 == NCMP) v[3] = 0.f; }
            { const int nb = n0 + 16 * nt; *(u32x2*)((bf16_t*)(ws + WS_VC) + ((size_t)((b * 2 + g) * 8 + (nb >> 6)) << 13) + vimg_off(16 * wave + fr, (nb & 63) + (fq & 1) * 8 + (fq >> 1) * 4)) = pk4(v); } }
    }
}

__device__ __forceinline__ void xattn_item(unsigned char* ws, LAS unsigned char* lds, int item, int tid, int lane, int wave) {
    const int b = item >> 7, h = (item >> 5) & 3, t0 = (item & 31) * 256;
    const int r32 = lane & 31, hi = lane >> 5, tok = b * T + t0 + 32 * wave + r32;
    LAS unsigned char* const qf = lds + NL_QF + wave * 8192 + hi * 512 + r32 * 16;
    __syncthreads();
#pragma unroll
    for (int ks = 0; ks < 8; ++ks) *(LAS bf16x8*)(qf + ks * 1024) = *(const bf16x8*)((const bf16_t*)(ws + WS_QX) + (size_t)tok * XD + h * 128 + 16 * ks + 8 * hi);
    f32x16 O[4]; float m = -3e38f, l = 0.f;
#pragma unroll
    for (int mt = 0; mt < 4; ++mt)
#pragma unroll
        for (int i = 0; i < 16; ++i) O[mt][i] = 0.f;
    const unsigned char* kb0 = ws + WS_XVT + 524288 + (size_t)(b * 4 + h) * 4 * 16384; const unsigned char* vb0 = ws + WS_XVT + (size_t)(b * 4 + h) * 4 * 16384;
    __syncthreads();
    nsa_stage(lds, 0, kb0, vb0, true, tid, wave);
    RING_LOOPB2(4, nsa_stage(lds, slot_, kb0 + (size_t)sb_ * 16384, vb0 + (size_t)sb_ * 16384, true, tid, wave),
              (nsa_block<0>(slotp, qf, O, m, l, true, 0, r32, hi)));
    const float il = 1.f / l;
    bf16_t* ox = (bf16_t*)(ws + WS_OX) + (size_t)tok * XD + h * 128 + 4 * hi;
#pragma unroll
    for (int mt = 0; mt < 4; ++mt)
#pragma unroll
        for (int q = 0; q < 4; ++q) { u32x2 w; w.x = pk2(O[mt][4 * q] * il, O[mt][4 * q + 1] * il); w.y = pk2(O[mt][4 * q + 2] * il, O[mt][4 * q + 3] * il); *(u32x2*)(ox + 32 * mt + 8 * q) = w; }
}


#define XB_TMO      128
#define XB_XCNT(j)  (256  + 64 * (j))
#define XB_XSUB(j)  (1280 + 64 * (j))
#define XB_XGEN(j)  (2304 + 64 * (j))
#define XB_TOP      3328
#define XB_TOPGEN   3392
#define XCD_BAR_WORDS 3456
#define XB_SPIN_CAP (1u << 18)
__device__ __forceinline__ unsigned xb_ld(unsigned* p)              { return __hip_atomic_load(p, __ATOMIC_RELAXED, __HIP_MEMORY_SCOPE_AGENT); }
__device__ __forceinline__ unsigned xb_add(unsigned* p, unsigned v) { return __hip_atomic_fetch_add(p, v, __ATOMIC_RELAXED, __HIP_MEMORY_SCOPE_AGENT); }
__device__ __forceinline__ unsigned xb_xcc_id() { return (unsigned)__builtin_amdgcn_s_getreg((3 << 11) | 20) & 0xFu; }
#define XB_SPIN(cond, bar) do { unsigned _sp = 0; while (cond) { __builtin_amdgcn_s_sleep(1); \
    if ((++_sp & 255u) == 0u) { if (xb_ld(&(bar)[XB_TMO])) break; if (_sp > XB_SPIN_CAP) { atomicAdd(&(bar)[XB_TMO], 1u); break; } } } } while (0)
struct XcdBarrier { unsigned* bar; unsigned x; volatile LAS unsigned* st; };
__device__ __forceinline__ XcdBarrier xcd_barrier_post(unsigned* bar, volatile LAS unsigned* st) {
    XcdBarrier b; b.bar = bar; b.x = xb_xcc_id(); b.st = st;
    if (threadIdx.x == 0) (void)xb_add(&bar[XB_XCNT(b.x)], 1u);
    return b;
}
__device__ __forceinline__ void xcd_barrier_complete(unsigned* bar, unsigned x, unsigned& nloc, unsigned& nx) {
    const unsigned G = gridDim.x * gridDim.y * gridDim.z;
    unsigned sum, cnt, mine, sp = 0u;
    for (;;) {
        sum = 0u; cnt = 0u; mine = 0u;
#pragma unroll
        for (unsigned j = 0; j < 16; ++j) { const unsigned c = xb_ld(&bar[XB_XCNT(j)]); sum += c; cnt += (c > 0u) ? 1u : 0u; mine = (j == x) ? c : mine; }
        if (sum == G) break;
        __builtin_amdgcn_s_sleep(1);
        if ((++sp & 255u) == 0u) { if (xb_ld(&bar[XB_TMO])) break; if (sp > XB_SPIN_CAP) { atomicAdd(&bar[XB_TMO], 1u); break; } }
    }
    nloc = mine > 0u ? mine : 1u; nx = cnt > 0u ? cnt : 1u;
}
__device__ __forceinline__ void xcd_barrier(const XcdBarrier& b) {
    asm volatile("s_waitcnt vmcnt(0)" ::: "memory");
    __syncthreads();
    if (threadIdx.x == 0) {
        unsigned* bar = b.bar;
        __builtin_amdgcn_s_waitcnt(0);
        unsigned nloc = b.st[0], nx = b.st[1];
        if (nloc == 0u) { xcd_barrier_complete(bar, b.x, nloc, nx); b.st[0] = nloc; b.st[1] = nx; }
        const unsigned old = xb_add(&bar[XB_XSUB(b.x)], 1u);
        const unsigned gen = old / nloc;
        if (old + 1u == (gen + 1u) * nloc) {
            __builtin_amdgcn_fence(__ATOMIC_RELEASE, "agent");
            asm volatile("s_waitcnt vmcnt(0)" ::: "memory");
            const unsigned og = xb_add(&bar[XB_TOP], 1u);
            const unsigned tg = og / nx;
            if (og + 1u == (tg + 1u) * nx) xb_add(&bar[XB_TOPGEN], 1u);
            else XB_SPIN(xb_ld(&bar[XB_TOPGEN]) == tg, bar);
            __builtin_amdgcn_fence(__ATOMIC_ACQUIRE, "agent");
            xb_add(&bar[XB_XGEN(b.x)], 1u);
            asm volatile("s_waitcnt vmcnt(0)" ::: "memory");
        } else {
            XB_SPIN(xb_ld(&bar[XB_XGEN(b.x)]) == gen, bar);
            __builtin_amdgcn_fence(__ATOMIC_ACQUIRE, "agent");
            asm volatile("s_waitcnt vmcnt(0)" ::: "memory");
        }
    }
    __syncthreads();
}

__global__ void __launch_bounds__(NTHREADS) mega(Params p) {
    extern __shared__ __attribute__((aligned(16))) unsigned char smem[];
    LAS unsigned char* lds = (LAS unsigned char*)smem;
    cg::grid_group grid = cg::this_grid();
    const int tid = threadIdx.x, lane = tid & 63, wave = __builtin_amdgcn_readfirstlane(tid >> 6);
    const int G = gridDim.x, bx = blockIdx.x;
    const int gw = bx * NWAVES + wave, NGW = G * NWAVES;
    unsigned char* ws = p.ws;
    const float* x = p.in[0];
    bf16_t* PROJ = (bf16_t*)(ws + WS_PROJ); bf16_t* Hb = (bf16_t*)(ws + WS_H);
    unsigned* ctl = (unsigned*)(ws + WS_CTL);
    const int lo = p.ph_lo, hi = p.ph_hi;
#define IN(k) (lo <= (k) && (k) < hi)
#ifndef PROBE_MASK
#define PROBE_MASK 0
#endif
#define PH(k) if (IN(k)) for (int rep_ = 0; rep_ < (((PROBE_MASK >> (k)) & 1) ? 2 : 1); ++rep_)
    volatile LAS unsigned* xst = (volatile LAS unsigned*)(lds + 131072 + 14336);
    if (tid < 2) xst[tid] = 0u;
    __syncthreads();
    const XcdBarrier xbar = xcd_barrier_post(ctl + CW_BAR, xst);
#define SEAM(k) do { if (IN(k) && IN((k) + 1)) { if ((k) == 0) grid.sync(); else xcd_barrier(xbar); } } while (0)

    PH(0) {
        LAS float* scr = (LAS float*)(lds + wave * 16384);
        constexpr int I_IN = 16 * (DINP / 32), I_SQ = 16 * 32, I_XQ = 16 * 16, I_XKV = 16 * 32, I_XO = 8 * 32, I_GU = NE * 16 * 64, I_DN = NE * 16 * 32, I_W1 = 64 * 4, I_W2 = 2 * 4;
        constexpr int NITEMS = I_IN + 3 * I_SQ + I_XQ + I_XKV + I_XO + 2 * I_W1 + 2 * I_W2 + I_GU + I_DN;
        auto decode = [&](int it) -> TrItem {
            int r = it;
            if (r < I_IN) { const int nb = r % (DINP / 32), kb = r / (DINP / 32); return TrItem{p.in[3], (bf16_t*)(ws + WS_WIN_T), D, DIN, DIN, nb * 32, kb * 64, nb * 32}; } r -= I_IN;
            if (r < I_SQ) { const int nb = r % 32, kb = r / 32; return TrItem{p.in[14], (bf16_t*)(ws + WS_WA_T), D, D, D, nb * 32, kb * 64, nb * 32}; } r -= I_SQ;
            if (r < I_SQ) { const int nb = r % 32, kb = r / 32; return TrItem{p.in[15], (bf16_t*)(ws + WS_WB_T), D, D, D, nb * 32, kb * 64, nb * 32}; } r -= I_SQ;
            if (r < I_SQ) { const int nb = r % 32, kb = r / 32; return TrItem{p.in[16], (bf16_t*)(ws + WS_WMIX_T), D, D, D, nb * 32, kb * 64, nb * 32}; } r -= I_SQ;
            if (r < I_XQ) { const int nb = r % 16, kb = r / 16; return TrItem{p.in[19], (bf16_t*)(ws + WS_WXQ_T), D, XD, XD, nb * 32, kb * 64, nb * 32}; } r -= I_XQ;
            if (r < I_XKV) { const int nb = r % 32, kb = r / 32; return TrItem{p.in[20], (bf16_t*)(ws + WS_WXKV_T), D, 2 * XD, 2 * XD, nb * 32, kb * 64, nb * 32}; } r -= I_XKV;
            if (r < I_XO) { const int nb = r % 32, kb = r / 32; return TrItem{p.in[21], (bf16_t*)(ws + WS_WXO_T), XD, D, D, nb * 32, kb * 64, nb * 32}; } r -= I_XO;
            if (r < I_W1) { const int nb = r % 4, kb = r / 4; return TrItem{p.in[9], (bf16_t*)(ws + WS_W1T), 4096, 128, 128, nb * 32, kb * 64, nb * 32}; } r -= I_W1;
            if (r < I_W1) { const int nb = r % 4, kb = r / 4; return TrItem{p.in[12], (bf16_t*)(ws + WS_W1T) + 128 * 4096, 4096, 128, 128, nb * 32, kb * 64, nb * 32}; } r -= I_W1;
            if (r < I_W2) { const int nb = r % 4, kb = r / 4; return TrItem{p.in[10], (bf16_t*)(ws + WS_W2T), 128, 128, 128, nb * 32, kb * 64, nb * 32}; } r -= I_W2;
            if (r < I_W2) { const int nb = r % 4, kb = r / 4; return TrItem{p.in[13], (bf16_t*)(ws + WS_W2T) + 128 * 128, 128, 128, 128, nb * 32, kb * 64, nb * 32}; } r -= I_W2;
            if (r < I_GU) { const int e = r / (16 * 64), q = r % (16 * 64), nb = q % 64, kb = q / 64; const int c0 = nb * 32, bj = c0 / 1024, cc = c0 % 1024;
                return TrItem{p.in[25] + (size_t)e * D * 2048, (bf16_t*)(ws + WS_WGU_T) + (size_t)e * 2048 * D, D, 2048, 2048, (cc / 128) * 256 + bj * 128 + (cc % 128), kb * 64, c0}; } r -= I_GU;
            { const int e = r / (16 * 32), q = r % (16 * 32), nb = q % 32, kb = q / 32;
                return TrItem{p.in[27] + (size_t)e * D * D, (bf16_t*)(ws + WS_WDN_T) + (size_t)e * D * D, D, D, D, nb * 32, kb * 64, nb * 32}; }
        };
        if (gw < NITEMS) {
            float v[32]; TrItem cur = decode(gw); tr_load(cur, v, lane);
            for (int it = gw; it < NITEMS; it += NGW) {
                tr_lds_write(v, scr, lane);
                const bool has = it + NGW < NITEMS; TrItem nxt = cur;
                if (has) { nxt = decode(it + NGW); tr_load(nxt, v, lane); }
                asm volatile("" ::: "memory");
                tr_store(cur, scr, lane);
                cur = nxt;
            }
        }
        for (int m = gw; m < NT; m += 2 * NGW) { const int m2 = m + NGW; const bool hb = m2 < NT; const int mb = hb ? m2 : m;
            rms_rows2_to_bf16(x + (size_t)m * D, x + (size_t)mb * D, p.in[2], Hb + (size_t)m * D, Hb + (size_t)mb * D, hb, lane); }
        for (int m = gw; m < BATCH * MEM; m += NGW) rms_row_to_bf16(p.in[1] + (size_t)m * D, p.in[18], (bf16_t*)(ws + WS_MEMN) + (size_t)m * D, lane);
    }
    SEAM(0);

    PH(1) {
        { pg8::Gemm g{D, D, D}; pg8::DenseOrder S; S.init(NT, DINP, G, bx, Hb, D, ws + WS_WIN_T, D); EpiStoreBf16 E{PROJ, DINP}; pg8::gemm_phase(lds, g, S, E); }
        { pg8::Gemm g{D, D, D}; pg8::DenseOrder S; S.init(BATCH * MEM, 2 * XD, G, (bx + 8) % G, ws + WS_MEMN, D, ws + WS_WXKV_T, D); EpiStoreBf16 E{(bf16_t*)(ws + WS_KVM), 2 * XD}; pg8::gemm_phase(lds, g, S, E); }
    }
    SEAM(1);

    PH(2) {
        { LAS int* qslot = (LAS int*)(lds + 131072 + 12288);
            for (;;) {
                __syncthreads();
                if (tid == 0) *qslot = (int)atomicAdd(ctl + CW_QUEUE + 8 + rep_, 1u);
                __syncthreads();
                const int it = *qslot;
                if (it >= 128 + BATCH * 8 * 128) break;
                if (it < 128) cmp_item(p, ws, lds, it, tid, lane, wave); else gdn_chunk_item(p, ws, lds, it - 128, tid, lane, wave);
            }
        }
        __syncthreads();
        {
            bf16_t* QR = (bf16_t*)(ws + WS_QR); bf16_t* KSR = (bf16_t*)(ws + WS_KSR); bf16_t* KWR = (bf16_t*)(ws + WS_KWR);
            for (int tok = gw; tok < NT; tok += NGW) {
                const int t = tok & (T - 1);
                const int dd = 2 * lane; float c0 = 1.f, s0 = 0.f, c1 = 1.f, s1 = 0.f;
                if (lane < 16) { const int i0 = dd & 15, i1 = i0 + 1;
                    const double f0 = exp2(-18.931568569324174 * (double)i0 / 16.0), f1 = exp2(-18.931568569324174 * (double)i1 / 16.0);
                    double r0 = (double)t * f0 * 0.15915494309189535, r1 = (double)t * f1 * 0.15915494309189535; r0 -= floor(r0); r1 -= floor(r1);
                    const float a0 = (float)(r0 * 6.283185307179586), a1 = (float)(r1 * 6.283185307179586);
                    c0 = __cosf(a0); s0 = __sinf(a0); c1 = __cosf(a1); s1 = __sinf(a1); }
                unsigned vin[12];
#pragma unroll
                for (int hh = 0; hh < 12; ++hh) vin[hh] = *(const unsigned*)(PROJ + (size_t)tok * DINP + (hh < 8 ? C_NQ + hh * 128 : (hh < 10 ? C_NKS + (hh - 8) * 128 : C_NKW + (hh - 10) * 128)) + dd);
                asm volatile("" ::: "memory");
#pragma unroll
                for (int hh = 0; hh < 12; ++hh) {
                    bf16_t* dst = hh < 8 ? QR + (size_t)tok * D + hh * 128 + dd : ((hh < 10 ? KSR : KWR) + ((size_t)(((tok >> 13) * 2 + (hh & 1)) * 128 + (t >> 6)) << 13) + kimg_off(t & 63, dd));
                    const unsigned v = vin[hh]; float v0 = bflo(v), v1 = bfhi(v);
                    const float p0 = __shfl_xor(v0, 8), p1 = __shfl_xor(v1, 8);
                    if (lane < 8) { v0 = v0 * c0 - p0 * s0; v1 = v1 * c1 - p1 * s1; } else if (lane < 16) { v0 = v0 * c0 + p0 * s0; v1 = v1 * c1 + p1 * s1; }
                    *(unsigned*)dst = pk2(v0, v1);
                }
            }
        }
        {
            LAS bf16_t* tt = (LAS bf16_t*)lds;
            for (int it = bx; it < 2 * BATCH * 2 * 128; it += G) {
                const int which = it >> 9, b = (it >> 8) & 1, g = (it >> 7) & 1, blk = it & 127;
                __syncthreads();
                { const int tk = tid >> 3, c = tid & 7; const bf16_t* src = PROJ + (size_t)(b * T + blk * 64 + tk) * DINP + (which ? C_NVW : C_NVS) + g * 128 + c * 16;
                    const u32x4 x0 = *(const u32x4*)src, x1 = *(const u32x4*)(src + 8); const int pos = (tk & ~15) + vperm16(tk & 15);
                    const unsigned xs[8] = {x0.x, x0.y, x0.z, x0.w, x1.x, x1.y, x1.z, x1.w};
#pragma unroll
                    for (int e = 0; e < 8; ++e) { tt[(c * 16 + 2 * e) * 72 + pos] = (bf16_t)(xs[e] & 0xffffu); tt[(c * 16 + 2 * e + 1) * 72 + pos] = (bf16_t)(xs[e] >> 16); } }
                __syncthreads();
                { const int dv = tid >> 2, pc = tid & 3; const LAS u32x4* sp = (const LAS u32x4*)(tt + dv * 72 + pc * 16);
                    bf16_t* dst = (bf16_t*)(ws + (which ? WS_VWT : WS_VST)) + ((size_t)((b * 2 + g) * 128 + blk) << 13);
                    *(u32x4*)(dst + vimg_off(dv, pc * 16)) = sp[0]; *(u32x4*)(dst + vimg_off(dv, pc * 16 + 8)) = sp[1]; }
            }
            __syncthreads();
        }
        {
            LAS bf16_t* tt = (LAS bf16_t*)lds;
            for (int it = bx; it < BATCH * 4 * 4; it += G) {
                const int b = it >> 4, h = (it >> 2) & 3, blk = it & 3;
                __syncthreads();
                { const int tk = tid >> 3, c = tid & 7; const bf16_t* src = (const bf16_t*)(ws + WS_KVM) + (size_t)(b * MEM + blk * 64 + tk) * 1024 + 512 + h * 128 + c * 16;
                    const u32x4 x0 = *(const u32x4*)src, x1 = *(const u32x4*)(src + 8); const int pos = (tk & ~15) + vperm16(tk & 15);
                    const unsigned xs[8] = {x0.x, x0.y, x0.z, x0.w, x1.x, x1.y, x1.z, x1.w};
#pragma unroll
                    for (int e = 0; e < 8; ++e) { tt[(c * 16 + 2 * e) * 72 + pos] = (bf16_t)(xs[e] & 0xffffu); tt[(c * 16 + 2 * e + 1) * 72 + pos] = (bf16_t)(xs[e] >> 16); } }
                __syncthreads();
                { const int dv = tid >> 2, pc = tid & 3; const LAS u32x4* sp = (const LAS u32x4*)(tt + dv * 72 + pc * 16);
                    bf16_t* dst = (bf16_t*)(ws + WS_XVT) + ((size_t)((b * 4 + h) * 4 + blk) << 13);
                    *(u32x4*)(dst + vimg_off(dv, pc * 16)) = sp[0]; *(u32x4*)(dst + vimg_off(dv, pc * 16 + 8)) = sp[1]; }
                { const int tk = tid >> 3, c = tid & 7; const bf16_t* src = (const bf16_t*)(ws + WS_KVM) + (size_t)(b * MEM + blk * 64 + tk) * 1024 + h * 128 + c * 16;
                    bf16_t* dst = (bf16_t*)(ws + WS_XVT + 524288) + ((size_t)((b * 4 + h) * 4 + blk) << 13);
                    *(u32x4*)(dst + kimg_off(tk, c * 16)) = *(const u32x4*)src; *(u32x4*)(dst + kimg_off(tk, c * 16 + 8)) = *(const u32x4*)(src + 8); }
            }
            __syncthreads();
        }
    }
    SEAM(2);

    if (IN(3)) {
        if (bx < 32) { gdn_scan(ws, lds, bx, tid, lane, wave);
            if (tid == 0) { __builtin_amdgcn_fence(__ATOMIC_RELEASE, "agent"); asm volatile("s_waitcnt vmcnt(0)" ::: "memory"); __hip_atomic_fetch_add(ctl + CW_SCANDONE, 1u, __ATOMIC_RELAXED, __HIP_MEMORY_SCOPE_AGENT); } }
        {
            LAS int* qslot = (LAS int*)(lds + 131072 + 12288);
            for (;;) {
                __syncthreads();
                if (tid == 0) *qslot = (int)atomicAdd(ctl + CW_QUEUE, 1u);
                __syncthreads();
                const int it = *qslot;
                if (it >= 512) break;
                nsa_item(p, ws, lds, it, tid, lane, wave);
            }
        }
        {
            LAS int* qslot = (LAS int*)(lds + 131072 + 12288);
            if (tid == 0) { unsigned sp = 0; while (__hip_atomic_load(ctl + CW_SCANDONE, __ATOMIC_RELAXED, __HIP_MEMORY_SCOPE_AGENT) < 32u) { __builtin_amdgcn_s_sleep(2); if (++sp > (1u << 22)) break; }
                __builtin_amdgcn_fence(__ATOMIC_ACQUIRE, "agent"); asm volatile("s_waitcnt vmcnt(0)" ::: "memory"); }
            __syncthreads();
            const float* GO = (const float*)(ws + WS_GO); bf16_t* OA = (bf16_t*)(ws + WS_OA);
            for (;;) {
                __syncthreads();
                if (tid == 0) *qslot = (int)atomicAdd(ctl + CW_P4Q, 1u);
                __syncthreads();
                const int it0 = *qslot; if (it0 >= NT / 64) break;
                const float gn0 = p.in[7][2 * lane], gn1 = p.in[7][2 * lane + 1];
#pragma unroll 1
                for (int q0 = wave * 8; q0 < 512; q0 += NWAVES * 8) {
                    float v0[8], v1[8]; unsigned z[8];
#pragma unroll
                    for (int i = 0; i < 8; ++i) { const int q = q0 + i, tok = it0 * 64 + (q >> 3), h = q & 7; const size_t o = (size_t)tok * D + h * 128 + 2 * lane;
                        const f32x2v g2 = *(const f32x2v*)(GO + o); v0[i] = g2.x; v1[i] = g2.y; z[i] = *(const unsigned*)(PROJ + (size_t)tok * DINP + C_GZ + h * 128 + 2 * lane); }
                    asm volatile("" ::: "memory");
#pragma unroll
                    for (int i = 0; i < 8; ++i) { const int q = q0 + i, tok = it0 * 64 + (q >> 3), h = q & 7; const size_t o = (size_t)tok * D + h * 128 + 2 * lane;
                        const float r = __builtin_amdgcn_rsqf(wave_sum(v0[i] * v0[i] + v1[i] * v1[i]) * (1.f / 128.f) + 1e-6f);
                        *(unsigned*)(OA + o) = pk2(v0[i] * r * gn0 * siluf_(bflo(z[i])), v1[i] * r * gn1 * siluf_(bfhi(z[i]))); }
                }
            }
        }
    }
    SEAM(3);


    PH(5) {
        bf16_t* MIXED = (bf16_t*)(ws + WS_MIXED);
        { pg8::Gemm g{D, D, D}; pg8::DenseOrder S; S.init(NT, D, G, bx, ws + WS_OA, D, ws + WS_WA_T, D); EpiGate E{MIXED, PROJ, C_MA, 0}; pg8::gemm_phase(lds, g, S, E); }
        { pg8::Gemm g{D, D, D}; pg8::DenseOrder S; S.init(NT, D, G, bx, ws + WS_OB, D, ws + WS_WB_T, D); EpiGate E{MIXED, PROJ, C_MB, 1}; pg8::gemm_phase(lds, g, S, E); }
    }
    SEAM(5);

    PH(6) { pg8::Gemm g{D, D, D}; pg8::DenseOrder S; S.init(NT, D, G, bx, ws + WS_MIXED, D, ws + WS_WMIX_T, D);
        EpiResidualNorm E{(float*)(ws + WS_X1), x, Hb, p.in[17], (float*)(ctl + CW_SS1)}; pg8::gemm_phase(lds, g, S, E); }
    SEAM(6);
    PH(8) { pg8::Gemm g{D, D, D}; pg8::DenseOrder S; S.init(NT, XD, G, bx, Hb, D, ws + WS_WXQ_T, D); EpiScaleRowsBf16 E{(bf16_t*)(ws + WS_QX), XD, (const float*)(ctl + CW_SS1)}; pg8::gemm_phase(lds, g, S, E); }
    SEAM(8);
    PH(9) { for (int it = bx; it < BATCH * 4 * 32; it += G) xattn_item(ws, lds, it, tid, lane, wave); __syncthreads(); }
    SEAM(9);
    if (IN(10)) { pg8::Gemm g{XD, XD, XD}; pg8::DenseOrder S; S.init(NT, D, G, bx, ws + WS_OX, XD, ws + WS_WXO_T, XD); EpiResidualSS E{(float*)(ws + WS_X1), (const float*)(ws + WS_X1), (float*)(ctl + CW_SS2)}; pg8::gemm_phase(lds, g, S, E); }
    SEAM(10);
    PH(11) {
        LAS float* wl = (LAS float*)lds;
        LAS float* xch = (LAS float*)(lds + 131072);
        LAS int* lcnt = (LAS int*)(lds + 131072 + 8192);
        if (tid < 32) lcnt[tid] = 0;
        const float* X2 = (const float*)(ws + WS_X1); int* TOPE = (int*)(ws + WS_TOPE); float* TOPG = (float*)(ws + WS_TOPG);
        const int pr = wave >> 1, kh = wave & 1, tok0 = bx * 64 + pr * 16, li = lane & 15, kk = lane >> 4;
        const f32x4* xr = (const f32x4*)(X2 + (size_t)(tok0 + li) * D + kh * 512) + 2 * kk;
        f32x4 xv[32];
#pragma unroll
        for (int sc = 0; sc < 16; ++sc) { xv[2 * sc] = xr[8 * sc]; xv[2 * sc + 1] = xr[8 * sc + 1]; }
        const float rstd = __builtin_amdgcn_rsqf(((const float*)(ctl + CW_SS2))[tok0 + li] * (1.f / D) + 1e-6f);
        {
            const float* rwg = p.in[23];
#pragma unroll 1
            for (int b = 0; b < 16; b += 4) { float t[4][4];
#pragma unroll
                for (int q = 0; q < 4; ++q) { const int idx = (b + q) * 512 + tid, k4 = idx >> 5, e = idx & 31;
#pragma unroll
                    for (int s2 = 0; s2 < 4; ++s2) t[q][s2] = rwg[(4 * k4 + s2) * 32 + e]; }
#pragma unroll
                for (int q = 0; q < 4; ++q) { const int idx = (b + q) * 512 + tid; *(LAS f32x4*)(wl + idx * 4) = (f32x4){t[q][0], t[q][1], t[q][2], t[q][3]}; } }
        }
        __syncthreads();
        f32x4 acc0 = {0.f, 0.f, 0.f, 0.f}, acc1 = {0.f, 0.f, 0.f, 0.f};
        const f32x4* gr = (const f32x4*)(p.in[22] + kh * 512) + 2 * kk;
        u32x4* o8 = (u32x4*)(Hb + (size_t)(tok0 + li) * D + kh * 512) + kk;
        LAS const f32x4* wb = (LAS const f32x4*)wl + (kh * 128 + 2 * kk) * 32 + li;
#pragma unroll
        for (int sc = 0; sc < 16; ++sc) {
            const f32x4 g0 = gr[8 * sc], g1 = gr[8 * sc + 1];
            const f32x4 h0 = xv[2 * sc] * rstd * g0, h1 = xv[2 * sc + 1] * rstd * g1;
            u32x4 w; w.x = pk2(h0[0], h0[1]); w.y = pk2(h0[2], h0[3]); w.z = pk2(h1[0], h1[1]); w.w = pk2(h1[2], h1[3]);
            o8[4 * sc] = w;
            const f32x4 b00 = wb[(8 * sc) * 32], b01 = wb[(8 * sc) * 32 + 16], b10 = wb[(8 * sc + 1) * 32], b11 = wb[(8 * sc + 1) * 32 + 16];
#pragma unroll
            for (int s2 = 0; s2 < 4; ++s2) { acc0 = __builtin_amdgcn_mfma_f32_16x16x4f32(h0[s2], b00[s2], acc0, 0, 0, 0); acc1 = __builtin_amdgcn_mfma_f32_16x16x4f32(h0[s2], b01[s2], acc1, 0, 0, 0); }
#pragma unroll
            for (int s2 = 0; s2 < 4; ++s2) { acc0 = __builtin_amdgcn_mfma_f32_16x16x4f32(h1[s2], b10[s2], acc0, 0, 0, 0); acc1 = __builtin_amdgcn_mfma_f32_16x16x4f32(h1[s2], b11[s2], acc1, 0, 0, 0); }
        }
        if (kh == 1) {
#pragma unroll
            for (int r = 0; r < 4; ++r) { xch[pr * 512 + (4 * kk + r) * 32 + li] = acc0[r]; xch[pr * 512 + (4 * kk + r) * 32 + 16 + li] = acc1[r]; } }
        __syncthreads();
        if (kh == 0) {
            const float bias0 = p.in[24][li], bias1 = p.in[24][16 + li];
#pragma unroll
            for (int r = 0; r < 4; ++r) {
                float v0 = acc0[r] + xch[pr * 512 + (4 * kk + r) * 32 + li] + bias0, v1 = acc1[r] + xch[pr * 512 + (4 * kk + r) * 32 + 16 + li] + bias1;
                float tv[4]; int ti[4];
#pragma unroll
                for (int rk = 0; rk < 4; ++rk) { float bv; int bi; if (v0 >= v1) { bv = v0; bi = li; } else { bv = v1; bi = 16 + li; }
#pragma unroll
                    for (int o = 1; o < 16; o <<= 1) { const float ov = __shfl_xor(bv, o); const int oi = __shfl_xor(bi, o); if (ov > bv || (ov == bv && oi < bi)) { bv = ov; bi = oi; } }
                    tv[rk] = bv; ti[rk] = bi; if (bi == li) v0 = -3e38f; if (bi == 16 + li) v1 = -3e38f; }
                if (li == r) { const int tok = tok0 + 4 * kk + r;
                    const float e1 = __expf(tv[1] - tv[0]), e2 = __expf(tv[2] - tv[0]), e3 = __expf(tv[3] - tv[0]), inv = 1.f / (1.f + e1 + e2 + e3);
                    *(i32x4*)(TOPE + tok * 4) = (i32x4){ti[0], ti[1], ti[2], ti[3]}; *(f32x4*)(TOPG + tok * 4) = (f32x4){inv, e1 * inv, e2 * inv, e3 * inv};
#pragma unroll
                    for (int rk = 0; rk < 4; ++rk) __hip_atomic_fetch_add(lcnt + ti[rk], 1, __ATOMIC_RELAXED, __HIP_MEMORY_SCOPE_WORKGROUP); }
            }
        }
        __syncthreads();
        if (tid < 32) ctl[CW_BLKCNT + bx * 32 + tid] = (unsigned)lcnt[tid];
        __syncthreads();
    }
    SEAM(11);
    LAS int* moe_cum = (LAS int*)(lds + 131072);
    LAS int* moe_before = moe_cum + 64;
    if (IN(12) || IN(13) || IN(14)) {
        LAS int* tmp = moe_cum + 128;
        __syncthreads();
        { const int e = tid & 31, part = tid >> 5; int tot = 0, bef = 0;
            for (int bb = part; bb < G; bb += 16) { const int c = (int)ctl[CW_BLKCNT + bb * 32 + e]; tot += c; if (bb < bx) bef += c; }
            tmp[part * 32 + e] = tot; tmp[512 + part * 32 + e] = bef; }
        __syncthreads();
        if (tid == 0) { int cumb = 0, prow = 0; moe_cum[0] = 0;
            for (int e = 0; e < NE; ++e) { int tot = 0, bef = 0; for (int q = 0; q < 16; ++q) { tot += tmp[q * 32 + e]; bef += tmp[512 + q * 32 + e]; }
                moe_before[e] = prow + bef; const int pb = (tot + MOEB - 1) / MOEB; cumb += pb; prow += pb * MOEB; moe_cum[e + 1] = cumb; } }
        __syncthreads();
    }
    PH(12) {
        LAS int* lcnt = moe_cum + 1200;
        if (tid < 32) lcnt[tid] = 0;
        __syncthreads();
        const int* TOPE = (const int*)(ws + WS_TOPE); const float* TOPG = (const float*)(ws + WS_TOPG); int* POS = (int*)(ws + WS_POS); float* RG = (float*)(ws + WS_ROWGATE);
        int* RT = (int*)(ws + WS_ROWTOK);
        if (wave < 4) {
            const int tok = bx * 64 + wave * 16 + (lane >> 2);
            const int e = TOPE[tok * 4 + (lane & 3)]; const float gte = TOPG[tok * 4 + (lane & 3)];
            const int slot = moe_before[e] + __hip_atomic_fetch_add(lcnt + e, 1, __ATOMIC_RELAXED, __HIP_MEMORY_SCOPE_WORKGROUP);
            POS[tok * 4 + (lane & 3)] = slot; RG[slot] = gte; RT[slot] = tok; }
    }
    SEAM(12);
    PH(13) { pg8::Gemm g{D, D, D}; MoeOrder S{G, bx, 8, moe_cum, (const char*)Hb, (const char*)(ws + WS_WGU_T), (size_t)2048 * D * 2, (const int*)(ws + WS_ROWTOK)};
        EpiSwiglu E{(bf16_t*)(ws + WS_ACT), p.in[26]}; pg8::gemm_phase<EpiSwiglu, MoeOrder, true>(lds, g, S, E); }
    SEAM(13);
    PH(14) { pg8::Gemm g{D, D, D}; MoeOrder S{G, bx, 4, moe_cum, (const char*)(ws + WS_ACT), (const char*)(ws + WS_WDN_T), (size_t)D * D * 2, nullptr};
        EpiDown E{(bf16_t*)(ws + WS_Y), p.in[28], (const float*)(ws + WS_ROWGATE)}; pg8::gemm_phase(lds, g, S, E); }
    SEAM(14);
    PH(15) {
        const float* X2 = (const float*)(ws + WS_X1); const int* POS = (const int*)(ws + WS_POS); const bf16_t* Y = (const bf16_t*)(ws + WS_Y);
        for (int tok = gw; tok < NT; tok += NGW) {
            const f32x4* xr = (const f32x4*)(X2 + (size_t)tok * D) + lane; f32x4 v[4];
#pragma unroll
            for (int j = 0; j < 4; ++j) v[j] = xr[64 * j];
#pragma unroll
            for (int k = 0; k < 4; ++k) { const u32x2* yr = (const u32x2*)(Y + (size_t)POS[tok * 4 + k] * D) + lane;
#pragma unroll
                for (int j = 0; j < 4; ++j) { const u32x2 w = yr[64 * j]; v[j].x += bflo(w.x); v[j].y += bfhi(w.x); v[j].z += bflo(w.y); v[j].w += bfhi(w.y); } }
            float s = 0.f;
#pragma unroll
            for (int j = 0; j < 4; ++j) s += (v[j].x * v[j].x + v[j].y * v[j].y) + (v[j].z * v[j].z + v[j].w * v[j].w);
            const float rstd = __builtin_amdgcn_rsqf(wave_sum(s) * (1.f / D) + 1e-6f);
            f32x4* orow = (f32x4*)(p.out + (size_t)tok * D) + lane; const f32x4* gr = (const f32x4*)p.in[29] + lane;
#pragma unroll
            for (int j = 0; j < 4; ++j) { const f32x4 gg = gr[64 * j]; orow[64 * j] = (f32x4){v[j].x * rstd * gg.x, v[j].y * rstd * gg.y, v[j].z * rstd * gg.z, v[j].w * rstd * gg.w}; }
        }
    }
}

constexpr int NPHASES = 16;
extern "C" void kernel_launch(void* const* d_in, const int* in_sizes, int n_in, void* d_out, int out_size, void* d_ws, size_t ws_size, hipStream_t stream) {
    static int grid = 0;
    if (grid == 0) {
        int dev = 0, cus = 0, per_cu = 0;
        (void)hipGetDevice(&dev); (void)hipDeviceGetAttribute(&cus, hipDeviceAttributeMultiprocessorCount, dev);
        (void)hipFuncSetAttribute((const void*)mega, hipFuncAttributeMaxDynamicSharedMemorySize, LDS_BYTES);
        (void)hipOccupancyMaxActiveBlocksPerMultiprocessor(&per_cu, (const void*)mega, NTHREADS, LDS_BYTES);
        if (per_cu < 1) { fprintf(stderr, "occupancy query says %d blocks/CU\n", per_cu); per_cu = 1; }
        grid = cus * 1;
        if (ws_size < WS_END) fprintf(stderr, "workspace too small: %zu < %zu\n", ws_size, (size_t)WS_END);
    }
    (void)hipMemsetAsync((char*)d_ws + WS_CTL, 0, CTL_ZERO, stream);
    (void)hipMemsetAsync((char*)d_ws + WS_ROWTOK, 0, (size_t)NROWS * 4, stream);
    Params p{};
    for (int i = 0; i < 30; ++i) p.in[i] = (const float*)d_in[i];
    p.out = (float*)d_out; p.ws = (unsigned char*)d_ws;
#if SINGLE_LAUNCH
    p.ph_lo = 0; p.ph_hi = NPHASES;
    void* args[] = {&p};
    hipError_t e = hipLaunchCooperativeKernel((const void*)mega, dim3(grid), dim3(NTHREADS), args, LDS_BYTES, stream);
    if (e != hipSuccess) fprintf(stderr, "cooperative launch failed: %s (grid %d)\n", hipGetErrorString(e), grid);
#else
    for (int ph = 0; ph < NPHASES; ++ph) { p.ph_lo = ph; p.ph_hi = ph + 1; hipLaunchKernelGGL(mega, dim3(grid), dim3(NTHREADS), LDS_BYTES, stream, p); }
#endif
}
```

```cpp
#include <hip/hip_runtime.h>
#include <hip/hip_cooperative_groups.h>
#include <cstdio>
#include <cstdint>
namespace cg = cooperative_groups;

#ifndef SINGLE_LAUNCH
#define SINGLE_LAUNCH 1
#endif

#define LAS __attribute__((address_space(3)))
typedef unsigned short bf16_t;
typedef short bf16x8 __attribute__((ext_vector_type(8)));
typedef float f32x4 __attribute__((ext_vector_type(4)));
typedef unsigned u32x4 __attribute__((ext_vector_type(4)));
typedef int i32x4 __attribute__((ext_vector_type(4)));
typedef unsigned u32x2 __attribute__((ext_vector_type(2)));

constexpr int BATCH = 2, T = 8192, NT = BATCH * T, D = 1024;
constexpr int DIN = 8744, DINP = 8960;
constexpr int C_GQ = 0, C_GK = 1024, C_GV = 2048, C_GZ = 3072, C_GB = 4096, C_GA = 4104, C_NQ = 4112, C_NKC = 5136, C_NVC = 5392,
              C_NKS = 5648, C_NVS = 5904, C_NKW = 6160, C_NVW = 6416, C_NG = 6672, C_MA = 6696, C_MB = 7720;
constexpr int NCMP = 511, NCMPP = 512, NSEL = 128, TOPN = 16, WIN = 512;
constexpr int MEM = 256, XD = 512;
constexpr int NE = 32, TOPK = 4, MOEB = 256, NROWS = NT * TOPK + NE * MOEB;
constexpr int NTHREADS = 512, NWAVES = 8;
constexpr int LDS_BYTES = 147456;

constexpr size_t MiB = 1u << 20;
constexpr size_t WS_CTL = 0, CTL_BYTES = 1 * MiB;
constexpr size_t WS_WIN_T = 1 * MiB, WS_WA_T = 19 * MiB, WS_WB_T = 21 * MiB, WS_WMIX_T = 23 * MiB, WS_WXQ_T = 25 * MiB, WS_WXKV_T = 26 * MiB,
                 WS_WXO_T = 28 * MiB, WS_WGU_T = 30 * MiB, WS_WDN_T = 158 * MiB;
constexpr size_t WS_H = 222 * MiB;
constexpr size_t WS_MEMN = 254 * MiB, WS_KVM = 255 * MiB;
constexpr size_t WS_PROJ = 256 * MiB;
constexpr size_t WS_CHK = 536 * MiB;
constexpr size_t WS_U = 648 * MiB;
constexpr size_t WS_GO = 712 * MiB;
constexpr size_t WS_XS = 256 * MiB, WS_ACT = 400 * MiB, WS_Y = 544 * MiB;
constexpr size_t WS_OA = 776 * MiB, WS_OB = 808 * MiB, WS_QR = 840 * MiB, WS_MIXED = 840 * MiB;
constexpr size_t WS_KSR = 872 * MiB, WS_KWR = 880 * MiB, WS_KC = 888 * MiB, WS_VC = 890 * MiB;
constexpr size_t WS_X1 = 892 * MiB;
constexpr size_t WS_QX = 956 * MiB, WS_OX = 972 * MiB;
constexpr size_t WS_GL = 988 * MiB;
constexpr size_t WS_TOPE = 989 * MiB, WS_TOPG = WS_TOPE + 256 * 1024, WS_POS = WS_TOPG + 256 * 1024, WS_ROWGATE = WS_POS + 256 * 1024;
constexpr size_t WS_ROWTOK = WS_ROWGATE + 512 * 1024;
constexpr size_t WS_VST = 991 * MiB, WS_VWT = 999 * MiB;
constexpr size_t WS_W1T = 1007 * MiB;
constexpr size_t WS_W2T = 1009 * MiB;
constexpr size_t WS_XVT = 1010 * MiB;
constexpr size_t WS_ROWTOK2 = 1011 * MiB;
constexpr size_t WS_ROWGATE2 = 1013 * MiB;
constexpr size_t WS_END = 1015 * MiB;
constexpr int CH_NEGW = 0, CH_QD = 16384, CH_KDT = 32768, CH_QK = 49152, CH_BYTES = 57344;
constexpr int CW_QUEUE = 0;
constexpr int CW_SCANDONE = 64;
constexpr int CW_P4Q = 65;
constexpr int CW_ECNT = 96;
constexpr int CW_BLKCNT = 1024;
constexpr int CW_BAR = 16384;
constexpr int CW_SS1 = 32768;
constexpr int CW_SS2 = 49152;
constexpr size_t CTL_ZERO = 131072 + 65536 + 65536;

struct Params {
    const float* in[30];
    float* out;
    unsigned char* ws;
    int ph_lo, ph_hi;
};

__device__ __forceinline__ unsigned f2bf(float f) { unsigned u = __builtin_bit_cast(unsigned, f); return (u + 0x7fffu + ((u >> 16) & 1u)) >> 16; }
typedef float f32x2_t __attribute__((ext_vector_type(2)));
typedef __bf16 bf16x2_t __attribute__((ext_vector_type(2)));
__device__ __forceinline__ unsigned pk2(float lo, float hi) { f32x2_t v = {lo, hi}; bf16x2_t b = __builtin_convertvector(v, bf16x2_t); return __builtin_bit_cast(unsigned, b); }
__device__ __forceinline__ float bf2f(unsigned short v) { return __builtin_bit_cast(float, (unsigned)v << 16); }
__device__ __forceinline__ float bflo(unsigned v) { return __builtin_bit_cast(float, v << 16); }
__device__ __forceinline__ float bfhi(unsigned v) { return __builtin_bit_cast(float, v & 0xffff0000u); }
__device__ __forceinline__ float wave_sum(float v) {
#pragma unroll
    for (int o = 1; o < 64; o <<= 1) v += __shfl_xor(v, o);
    return v;
}
__device__ __forceinline__ float wave_max(float v) {
#pragma unroll
    for (int o = 1; o < 64; o <<= 1) v = fmaxf(v, __shfl_xor(v, o));
    return v;
}
__device__ __forceinline__ float sigmoidf_(float x) { return __builtin_amdgcn_rcpf(1.f + __builtin_amdgcn_exp2f(x * -1.4426950408889634f)); }
__device__ __forceinline__ float siluf_(float x) { return x * __builtin_amdgcn_rcpf(1.f + __builtin_amdgcn_exp2f(x * -1.4426950408889634f)); }
#define LDS_FENCE() asm volatile("s_waitcnt lgkmcnt(0)" ::: "memory")

namespace pg8 {
constexpr int BM = 256, BK = 64, HALF = 128, HTB = HALF * BK * 2, NXCD = 8, WGM = 8;
__device__ __forceinline__ int lds_byte(int r, int c) { const int st = (r >> 4) * 2 + (c >> 5), rr = r & 15, cc = c & 31, ob = rr * 64 + cc * 2; return st * 1024 + (ob ^ (((ob >> 9) & 1) << 5)); }
__device__ __forceinline__ void stage_rc(int b, int& R, int& C) { const int st = b / 1024, sb = b % 1024, swz = sb ^ (((sb >> 9) & 1) << 5); R = (st >> 1) * 16 + swz / 64; C = (st & 1) * 32 + (swz % 64) / 2; }
__device__ __forceinline__ int perm32(int rho) { const int n = rho >> 4, i = rho & 15; return 8 * (i >> 2) + 4 * n + (i & 3); }

struct Unit { int pm, pn, aux; const char* a; const char* b; const int* rows; };
struct Gemm { int lda, ldb, K; };

template <class Epi, class Sched, bool GATHER = false>
__device__ __forceinline__ void gemm_phase(LAS unsigned char* lds, const Gemm g, const Sched& S, const Epi& E) {
    int tid_o = threadIdx.x; asm volatile("" : "+v"(tid_o));
    const int tid = tid_o, wid = __builtin_amdgcn_readfirstlane(tid >> 6), lane = tid & 63, wr = wid >> 2, wc = wid & 3, fr = lane & 15, fq = lane >> 4;
    const int K = g.K, nt = K / BK;
    unsigned voffA[2], voffB[2];
#pragma unroll
    for (int i = 0; i < 2; ++i) { int R, C; stage_rc(tid * 16 + i * 8192, R, C); const int Rb = (R & ~31) + perm32(R & 31);
        voffA[i] = (unsigned)(R * g.lda + C) * 2u; voffB[i] = (unsigned)(Rb * g.ldb + C) * 2u; }
    int gR[2], gC[2];
#pragma unroll
    for (int i = 0; i < 2; ++i) stage_rc(tid * 16 + i * 8192, gR[i], gC[i]);
    unsigned goff[2][2], gnoff[2][2];
    auto load_goff = [&](const Unit& u, unsigned (&o)[2][2]) {
#pragma unroll
        for (int h = 0; h < 2; ++h)
#pragma unroll
            for (int i = 0; i < 2; ++i) o[h][i] = ((unsigned)u.rows[h * HALF + gR[i]] * (unsigned)g.lda + (unsigned)gC[i]) * 2u; };
    const size_t kstep = (size_t)(BK * 2);
    const size_t hstepA = (size_t)HALF * g.lda * 2, hstepB = (size_t)HALF * g.ldb * 2;
    const unsigned ldsw = (unsigned)wid * 1024u;
    const int aoff = lds_byte(wr * 64 + fr, fq * 8), boff = lds_byte(wc * 32 + fr, fq * 8);
#define PG8_SA(b, h) (((b) * 2 + (h)) * HTB)
#define PG8_SB(b, h) ((4 + (b) * 2 + (h)) * HTB)
#define PG8_STAGE(bufoff, gbase, voff) do { _Pragma("unroll") for (int _i = 0; _i < 2; ++_i) \
        __builtin_amdgcn_global_load_lds((const unsigned*)((const char*)(gbase) + (voff)[_i]), (LAS unsigned*)(lds + (bufoff) + ldsw + _i * 8192), 16, 0, 0); } while (0)
#define PG8_STAGEG(bufoff, gbase, o0, o1) do { \
        __builtin_amdgcn_global_load_lds((const unsigned*)((const char*)(gbase) + (o0)), (LAS unsigned*)(lds + (bufoff) + ldsw), 16, 0, 0); \
        __builtin_amdgcn_global_load_lds((const unsigned*)((const char*)(gbase) + (o1)), (LAS unsigned*)(lds + (bufoff) + ldsw + 8192), 16, 0, 0); } while (0)
#define PG8_STAGEA(bufoff, ptr, h, nx) do { if constexpr (GATHER) { PG8_STAGEG(bufoff, ptr, (nx) ? gnoff[h][0] : goff[h][0], (nx) ? gnoff[h][1] : goff[h][1]); } else { PG8_STAGE(bufoff, (ptr) + (h) * hstepA, voffA); } } while (0)
#define PG8_LDA(dst, b, h) do { _Pragma("unroll") for (int m = 0; m < 4; ++m) _Pragma("unroll") for (int k = 0; k < 2; ++k) dst[m][k] = *(const LAS bf16x8*)(lds + PG8_SA(b, h) + aoff + m * 2048 + k * 1024); } while (0)
#define PG8_LDB(dst, b, h) do { _Pragma("unroll") for (int n = 0; n < 2; ++n) _Pragma("unroll") for (int k = 0; k < 2; ++k) dst[n][k] = *(const LAS bf16x8*)(lds + PG8_SB(b, h) + boff + n * 2048 + k * 1024); } while (0)
#define PG8_MMA(ai, bj, At, Bt) do { __builtin_amdgcn_s_setprio(1); _Pragma("unroll") for (int m = 0; m < 4; ++m) _Pragma("unroll") for (int n = 0; n < 2; ++n) _Pragma("unroll") for (int k = 0; k < 2; ++k) \
        acc[ai][bj][m][n] = __builtin_amdgcn_mfma_f32_16x16x32_bf16(Bt[n][k], At[m][k], acc[ai][bj][m][n], 0, 0, 0); __builtin_amdgcn_s_setprio(0); } while (0)
#define PG8_WAIT_V(n) asm volatile("s_waitcnt vmcnt(" #n ")" ::: "memory")
#define PG8_WAIT_L(n) asm volatile("s_waitcnt lgkmcnt(" #n ")" ::: "memory")
#define PG8_BAR __builtin_amdgcn_s_barrier()
#define PG8_SCHED __builtin_amdgcn_sched_barrier(0)
    Unit cur, nxt; int ui = 0;
    if (!S.next(0, cur)) return;
    f32x4 acc[2][2][4][2];
#pragma unroll
    for (int a = 0; a < 2; ++a)
#pragma unroll
        for (int b = 0; b < 2; ++b)
#pragma unroll
            for (int m = 0; m < 4; ++m)
#pragma unroll
                for (int n = 0; n < 2; ++n) acc[a][b][m][n] = (f32x4){0.f, 0.f, 0.f, 0.f};
    bf16x8 At[4][2], B0[2][2], B1[2][2];
    const char* cA = cur.a; const char* cB = cur.b;
    if constexpr (GATHER) load_goff(cur, goff);
    PG8_STAGE(PG8_SB(0, 0), cB, voffB); PG8_STAGE(PG8_SB(0, 1), cB + hstepB, voffB); PG8_STAGEA(PG8_SA(0, 0), cA, 0, false); PG8_STAGEA(PG8_SA(0, 1), cA, 1, false);
    if (wr == 1) PG8_BAR;
    PG8_WAIT_V(2); PG8_BAR;
    PG8_STAGE(PG8_SB(1, 0), cB + kstep, voffB); PG8_STAGEA(PG8_SA(1, 0), cA + kstep, 0, false); PG8_STAGE(PG8_SB(1, 1), cB + hstepB + kstep, voffB);
    PG8_WAIT_V(6); PG8_BAR;
    for (;;) {
        const bool has_next = S.next(ui + 1, nxt);
        const char* nA = has_next ? nxt.a : cA; const char* nB = has_next ? nxt.b : cB;
        if constexpr (GATHER) { if (has_next) load_goff(nxt, gnoff); else { _Pragma("unroll") for (int h = 0; h < 2; ++h) { gnoff[h][0] = goff[h][0]; gnoff[h][1] = goff[h][1]; } } }
        for (int t = 0; t < nt; t += 2) {
            const bool last = (t == nt - 2);
            const char* a1 = cA + (size_t)(t + 1) * kstep;
            const char* a2 = last ? nA : cA + (size_t)(t + 2) * kstep; const char* b2 = last ? nB : cB + (size_t)(t + 2) * kstep;
            const char* a3 = a2 + kstep; const char* b3 = b2 + kstep;
            PG8_LDB(B0, 0, 0); PG8_LDB(B1, 0, 1); PG8_SCHED; PG8_LDA(At, 0, 0); PG8_STAGEA(PG8_SA(1, 1), a1, 1, false);
            PG8_WAIT_V(8); PG8_WAIT_L(0); PG8_BAR; PG8_MMA(0, 0, At, B0); PG8_MMA(0, 1, At, B1); PG8_BAR; PG8_SCHED;
            PG8_LDA(At, 0, 1); PG8_STAGE(PG8_SB(0, 0), b2, voffB); PG8_STAGE(PG8_SB(0, 1), b2 + hstepB, voffB); PG8_STAGEA(PG8_SA(0, 0), a2, 0, last);
            PG8_WAIT_V(8); PG8_WAIT_L(0); PG8_BAR; PG8_MMA(1, 0, At, B0); PG8_MMA(1, 1, At, B1); PG8_BAR; PG8_SCHED;
            PG8_LDB(B0, 1, 0); PG8_LDB(B1, 1, 1); PG8_SCHED; PG8_LDA(At, 1, 0); PG8_STAGEA(PG8_SA(0, 1), a2, 1, last);
            PG8_WAIT_V(8); PG8_WAIT_L(0); PG8_BAR; PG8_MMA(0, 0, At, B0); PG8_MMA(0, 1, At, B1); PG8_BAR; PG8_SCHED;
            PG8_LDA(At, 1, 1); PG8_STAGE(PG8_SB(1, 0), b3, voffB); PG8_STAGE(PG8_SB(1, 1), b3 + hstepB, voffB); PG8_STAGEA(PG8_SA(1, 0), a3, 0, last);
            PG8_WAIT_V(8); PG8_WAIT_L(0); PG8_BAR; PG8_MMA(1, 0, At, B0); PG8_MMA(1, 1, At, B1); PG8_BAR; PG8_SCHED;
        }
        if (wr == 0) PG8_BAR;
        E(acc, cur, wr, wc, fr, fq);
        if (!has_next) break;
#pragma unroll
        for (int a = 0; a < 2; ++a)
#pragma unroll
            for (int b = 0; b < 2; ++b)
#pragma unroll
                for (int m = 0; m < 4; ++m)
#pragma unroll
                    for (int n = 0; n < 2; ++n) acc[a][b][m][n] = (f32x4){0.f, 0.f, 0.f, 0.f};
        cur = nxt; cA = nA; cB = nB; ++ui;
        if constexpr (GATHER) { _Pragma("unroll") for (int h = 0; h < 2; ++h) { goff[h][0] = gnoff[h][0]; goff[h][1] = gnoff[h][1]; } }
        if (wr == 1) PG8_BAR;
    }
    PG8_WAIT_V(0);
    PG8_BAR;
#undef PG8_SA
#undef PG8_SB
#undef PG8_STAGE
#undef PG8_STAGEG
#undef PG8_STAGEA
#undef PG8_LDA
#undef PG8_LDB
#undef PG8_MMA
#undef PG8_WAIT_V
#undef PG8_WAIT_L
#undef PG8_BAR
#undef PG8_SCHED
}

struct DenseOrder {
    int nM, nN, nwg, G, c; const char* A; const char* Bt; size_t tstepA, tstepB;
    __device__ void init(int M, int N, int G_, int c_, const void* A_, int lda, const void* Bt_, int ldb) {
        nM = M / BM; nN = N / BM; nwg = nM * nN; G = G_; c = c_; A = (const char*)A_; Bt = (const char*)Bt_; tstepA = (size_t)BM * lda * 2; tstepB = (size_t)BM * ldb * 2; }
    __device__ bool next(int i, Unit& u) const {
        const long L = (long)i * G + c; if (L >= nwg) return false;
        int wgid = (int)L; { const int q = nwg / NXCD, r = nwg % NXCD, xcd = wgid % NXCD, off = wgid / NXCD; wgid = (xcd < r ? xcd * (q + 1) : r * (q + 1) + (xcd - r) * q) + off; }
        const int nig = WGM * nN, gid = wgid / nig, fm = gid * WGM, gsz = (nM - fm) < WGM ? (nM - fm) : WGM;
        u.pm = fm + ((wgid % nig) % gsz); u.pn = (wgid % nig) / gsz; u.aux = 0; u.rows = nullptr;
        u.a = A + (size_t)u.pm * tstepA; u.b = Bt + (size_t)u.pn * tstepB; return true;
    }
};
}

#define EPI_LOOP _Pragma("unroll") for (int ai = 0; ai < 2; ++ai) _Pragma("unroll") for (int m = 0; m < 4; ++m) _Pragma("unroll") for (int bj = 0; bj < 2; ++bj)
#define EPI_ROW(u) ((u).pm * 256 + ai * 128 + wr * 64 + m * 16 + fr)
#define EPI_COL(u) ((u).pn * 256 + bj * 128 + wc * 32 + fq * 8)

struct EpiStoreBf16 {
    bf16_t* O; int ldc;
    __device__ __forceinline__ void operator()(const f32x4 (&acc)[2][2][4][2], const pg8::Unit& u, int wr, int wc, int fr, int fq) const {
        EPI_LOOP { const f32x4 v0 = acc[ai][bj][m][0], v1 = acc[ai][bj][m][1];
            u32x4 w; w.x = pk2(v0[0], v0[1]); w.y = pk2(v0[2], v0[3]); w.z = pk2(v1[0], v1[1]); w.w = pk2(v1[2], v1[3]);
            *(u32x4*)(O + (size_t)EPI_ROW(u) * ldc + EPI_COL(u)) = w; }
    }
};
struct EpiGate {
    bf16_t* O; const bf16_t* proj; int gcol; int add;
    __device__ __forceinline__ void operator()(const f32x4 (&acc)[2][2][4][2], const pg8::Unit& u, int wr, int wc, int fr, int fq) const {
#pragma unroll
        for (int ai = 0; ai < 2; ++ai) {
            u32x4 gv[4][2], pv[4][2];
#pragma unroll
            for (int m = 0; m < 4; ++m)
#pragma unroll
                for (int bj = 0; bj < 2; ++bj) { const int row = EPI_ROW(u), col = EPI_COL(u);
                    gv[m][bj] = *(const u32x4*)(proj + (size_t)row * DINP + gcol + col);
                    pv[m][bj] = add ? *(const u32x4*)(O + (size_t)row * D + col) : (u32x4){0u, 0u, 0u, 0u}; }
            asm volatile("" ::: "memory");
#pragma unroll
            for (int m = 0; m < 4; ++m)
#pragma unroll
                for (int bj = 0; bj < 2; ++bj) { const int row = EPI_ROW(u), col = EPI_COL(u); const u32x4 g = gv[m][bj], q = pv[m][bj];
                    float r[8]; const f32x4 v0 = acc[ai][bj][m][0], v1 = acc[ai][bj][m][1];
                    r[0] = v0[0] * sigmoidf_(bflo(g.x)); r[1] = v0[1] * sigmoidf_(bfhi(g.x)); r[2] = v0[2] * sigmoidf_(bflo(g.y)); r[3] = v0[3] * sigmoidf_(bfhi(g.y));
                    r[4] = v1[0] * sigmoidf_(bflo(g.z)); r[5] = v1[1] * sigmoidf_(bfhi(g.z)); r[6] = v1[2] * sigmoidf_(bflo(g.w)); r[7] = v1[3] * sigmoidf_(bfhi(g.w));
                    if (add) { r[0] += bflo(q.x); r[1] += bfhi(q.x); r[2] += bflo(q.y); r[3] += bfhi(q.y); r[4] += bflo(q.z); r[5] += bfhi(q.z); r[6] += bflo(q.w); r[7] += bfhi(q.w); }
                    u32x4 w; w.x = pk2(r[0], r[1]); w.y = pk2(r[2], r[3]); w.z = pk2(r[4], r[5]); w.w = pk2(r[6], r[7]); *(u32x4*)(O + (size_t)row * D + col) = w; }
        }
    }
};
struct EpiResidual {
    float* O; const float* R;
    __device__ __forceinline__ void operator()(const f32x4 (&acc)[2][2][4][2], const pg8::Unit& u, int wr, int wc, int fr, int fq) const {
#pragma unroll
        for (int ai = 0; ai < 2; ++ai) {
            f32x4 rv[4][2][2];
#pragma unroll
            for (int m = 0; m < 4; ++m)
#pragma unroll
                for (int bj = 0; bj < 2; ++bj) { const size_t o = (size_t)EPI_ROW(u) * D + EPI_COL(u); rv[m][bj][0] = *(const f32x4*)(R + o); rv[m][bj][1] = *(const f32x4*)(R + o + 4); }
            asm volatile("" ::: "memory");
#pragma unroll
            for (int m = 0; m < 4; ++m)
#pragma unroll
                for (int bj = 0; bj < 2; ++bj) { const size_t o = (size_t)EPI_ROW(u) * D + EPI_COL(u);
                    *(f32x4*)(O + o) = rv[m][bj][0] + acc[ai][bj][m][0]; *(f32x4*)(O + o + 4) = rv[m][bj][1] + acc[ai][bj][m][1]; }
        }
    }
};
struct EpiResidualSS {
    float* O; const float* R; float* ss;
    __device__ __forceinline__ void operator()(const f32x4 (&acc)[2][2][4][2], const pg8::Unit& u, int wr, int wc, int fr, int fq) const {
#pragma unroll
        for (int ai = 0; ai < 2; ++ai) {
            f32x4 rv[4][2][2];
#pragma unroll
            for (int m = 0; m < 4; ++m)
#pragma unroll
                for (int bj = 0; bj < 2; ++bj) { const size_t o = (size_t)EPI_ROW(u) * D + EPI_COL(u); rv[m][bj][0] = *(const f32x4*)(R + o); rv[m][bj][1] = *(const f32x4*)(R + o + 4); }
            asm volatile("" ::: "memory");
#pragma unroll
            for (int m = 0; m < 4; ++m) { float sq = 0.f;
#pragma unroll
                for (int bj = 0; bj < 2; ++bj) { const size_t o = (size_t)EPI_ROW(u) * D + EPI_COL(u);
                    const f32x4 v0 = rv[m][bj][0] + acc[ai][bj][m][0], v1 = rv[m][bj][1] + acc[ai][bj][m][1];
                    *(f32x4*)(O + o) = v0; *(f32x4*)(O + o + 4) = v1;
                    sq += (v0[0] * v0[0] + v0[1] * v0[1]) + (v0[2] * v0[2] + v0[3] * v0[3]) + (v1[0] * v1[0] + v1[1] * v1[1]) + (v1[2] * v1[2] + v1[3] * v1[3]); }
                sq += __shfl_xor(sq, 16); sq += __shfl_xor(sq, 32);
                if (fq == 0) atomicAdd(ss + u.pm * 256 + ai * 128 + wr * 64 + m * 16 + fr, sq); }
        }
    }
};
struct EpiResidualNorm {
    float* O; const float* R; bf16_t* Hraw; const float* gain; float* ss;
    __device__ __forceinline__ void operator()(const f32x4 (&acc)[2][2][4][2], const pg8::Unit& u, int wr, int wc, int fr, int fq) const {
        f32x4 gn[2][2];
#pragma unroll
        for (int bj = 0; bj < 2; ++bj) { const int col = u.pn * 256 + bj * 128 + wc * 32 + fq * 8; gn[bj][0] = *(const f32x4*)(gain + col); gn[bj][1] = *(const f32x4*)(gain + col + 4); }
#pragma unroll
        for (int ai = 0; ai < 2; ++ai) {
            f32x4 rv[4][2][2];
#pragma unroll
            for (int m = 0; m < 4; ++m)
#pragma unroll
                for (int bj = 0; bj < 2; ++bj) { const size_t o = (size_t)EPI_ROW(u) * D + EPI_COL(u); rv[m][bj][0] = *(const f32x4*)(R + o); rv[m][bj][1] = *(const f32x4*)(R + o + 4); }
            asm volatile("" ::: "memory");
#pragma unroll
            for (int m = 0; m < 4; ++m) { const int row = u.pm * 256 + ai * 128 + wr * 64 + m * 16 + fr; float sq = 0.f;
#pragma unroll
                for (int bj = 0; bj < 2; ++bj) { const int col = u.pn * 256 + bj * 128 + wc * 32 + fq * 8; const size_t o = (size_t)row * D + col;
                    const f32x4 v0 = rv[m][bj][0] + acc[ai][bj][m][0], v1 = rv[m][bj][1] + acc[ai][bj][m][1];
                    *(f32x4*)(O + o) = v0; *(f32x4*)(O + o + 4) = v1;
                    sq += (v0[0] * v0[0] + v0[1] * v0[1]) + (v0[2] * v0[2] + v0[3] * v0[3]) + (v1[0] * v1[0] + v1[1] * v1[1]) + (v1[2] * v1[2] + v1[3] * v1[3]);
                    const f32x4 g0 = gn[bj][0], g1 = gn[bj][1];
                    u32x4 w; w.x = pk2(v0[0] * g0[0], v0[1] * g0[1]); w.y = pk2(v0[2] * g0[2], v0[3] * g0[3]); w.z = pk2(v1[0] * g1[0], v1[1] * g1[1]); w.w = pk2(v1[2] * g1[2], v1[3] * g1[3]);
                    *(u32x4*)(Hraw + o) = w; }
                sq += __shfl_xor(sq, 16); sq += __shfl_xor(sq, 32);
                if (fq == 0) atomicAdd(ss + row, sq); }
        }
    }
};
struct EpiScaleRowsBf16 {
    bf16_t* O; int ldc; const float* ss;
    __device__ __forceinline__ void operator()(const f32x4 (&acc)[2][2][4][2], const pg8::Unit& u, int wr, int wc, int fr, int fq) const {
        float rs[2][4];
#pragma unroll
        for (int ai = 0; ai < 2; ++ai)
#pragma unroll
            for (int m = 0; m < 4; ++m) rs[ai][m] = ss[u.pm * 256 + ai * 128 + wr * 64 + m * 16 + fr];
#pragma unroll
        for (int ai = 0; ai < 2; ++ai)
#pragma unroll
            for (int m = 0; m < 4; ++m) rs[ai][m] = __builtin_amdgcn_rsqf(rs[ai][m] * (1.f / D) + 1e-6f);
        EPI_LOOP { const int row = EPI_ROW(u); const f32x4 v0 = acc[ai][bj][m][0] * rs[ai][m], v1 = acc[ai][bj][m][1] * rs[ai][m];
            u32x4 w; w.x = pk2(v0[0], v0[1]); w.y = pk2(v0[2], v0[3]); w.z = pk2(v1[0], v1[1]); w.w = pk2(v1[2], v1[3]);
            *(u32x4*)(O + (size_t)row * ldc + EPI_COL(u)) = w; }
    }
};
struct EpiSwiglu {
    bf16_t* O; const float* bias;
    __device__ __forceinline__ void operator()(const f32x4 (&acc)[2][2][4][2], const pg8::Unit& u, int wr, int wc, int fr, int fq) const {
        const float* bg = bias + (size_t)u.aux * 2048 + u.pn * 128 + wc * 32 + fq * 8; const float* bu = bg + 1024;
        float bgv[8], buv[8];
#pragma unroll
        for (int j = 0; j < 8; ++j) { bgv[j] = bg[j]; buv[j] = bu[j]; }
#pragma unroll
        for (int ai = 0; ai < 2; ++ai)
#pragma unroll
            for (int m = 0; m < 4; ++m) {
                const int row = u.pm * 256 + ai * 128 + wr * 64 + m * 16 + fr;
                float r[8];
#pragma unroll
                for (int j = 0; j < 8; ++j) { float gt = acc[ai][0][m][j >> 2][j & 3] + bgv[j], up = acc[ai][1][m][j >> 2][j & 3] + buv[j];
                    gt = fminf(gt, 7.f); up = fminf(fmaxf(up, -7.f), 7.f); r[j] = gt * sigmoidf_(gt * 1.702f) * (up + 1.f); }
                u32x4 w; w.x = pk2(r[0], r[1]); w.y = pk2(r[2], r[3]); w.z = pk2(r[4], r[5]); w.w = pk2(r[6], r[7]);
                *(u32x4*)(O + (size_t)row * D + u.pn * 128 + wc * 32 + fq * 8) = w; }
    }
};
struct EpiDown {
    bf16_t* O; const float* bias;
    __device__ __forceinline__ void operator()(const f32x4 (&acc)[2][2][4][2], const pg8::Unit& u, int wr, int wc, int fr, int fq) const {
        float gt[2][4]; f32x4 bb[2][2];
#pragma unroll
        for (int ai = 0; ai < 2; ++ai)
#pragma unroll
            for (int m = 0; m < 4; ++m) gt[ai][m] = ((const float*)u.rows)[ai * 128 + wr * 64 + m * 16 + fr];
#pragma unroll
        for (int bj = 0; bj < 2; ++bj) { const float* bp = bias + (size_t)u.aux * D + u.pn * 256 + bj * 128 + wc * 32 + fq * 8; bb[bj][0] = *(const f32x4*)bp; bb[bj][1] = *(const f32x4*)(bp + 4); }
        EPI_LOOP { const int row = EPI_ROW(u), col = EPI_COL(u);
            const f32x4 v0 = (acc[ai][bj][m][0] + bb[bj][0]) * gt[ai][m], v1 = (acc[ai][bj][m][1] + bb[bj][1]) * gt[ai][m];
            u32x4 w; w.x = pk2(v0[0], v0[1]); w.y = pk2(v0[2], v0[3]); w.z = pk2(v1[0], v1[1]); w.w = pk2(v1[2], v1[3]);
            *(u32x4*)(O + (size_t)row * D + col) = w; }
    }
};
struct MoeOrder {
    int G, c, NPN; const LAS int* cum; const char* A; const char* Bt; size_t estepB; const int* rowtab; int gather;
    __device__ bool next(int i, pg8::Unit& u) const {
        const int nrb = cum[NE];
        int rb, pn;
        if ((G & 7) == 0 && (G / 8) % NPN == 0) { const int per = G / NPN, rpx = per / 8, xcd = c & 7, j = c >> 3; rb = i * per + xcd * rpx + j / NPN; pn = j % NPN; if (rb >= nrb) return false; }
        else { const int L = i * G + c; if (L >= nrb * NPN) return false; rb = L / NPN; pn = L % NPN; }
        int e = 0;
#pragma unroll 1
        for (int k = 1; k < NE; ++k) e += (rb >= cum[k]) ? 1 : 0;
        u.pm = rb; u.pn = pn; u.aux = e; u.rows = rowtab + e * NT + (rb - cum[e]) * 256; u.a = gather ? A : A + (size_t)rb * 256 * D * 2; u.b = Bt + (size_t)e * estepB + (size_t)pn * 256 * D * 2; return true;
    }
};

struct TrItem { const float* W; bf16_t* WT; int K, N, ldw, dst_row0, k0, n0; };
__device__ __forceinline__ void tr_load(const TrItem& t, float (&v)[32], int lane) {
    const int n = t.n0 + (lane & 31); const bool ok = n < t.N; const float* src = t.W + (size_t)(t.k0 + (lane >> 5)) * t.ldw + (ok ? n : 0);
#pragma unroll
    for (int i = 0; i < 32; ++i) { const float x = src[(size_t)(2 * i) * t.ldw]; v[i] = ok ? x : 0.f; }
}
__device__ __forceinline__ void tr_lds_write(const float (&v)[32], LAS float* scr, int lane) {
#pragma unroll
    for (int i = 0; i < 32; ++i) scr[(2 * i + (lane >> 5)) * 33 + (lane & 31)] = v[i];
    LDS_FENCE();
}
__device__ __forceinline__ void tr_store(const TrItem& t, LAS float* scr, int lane) {
    const int c = lane & 7;
#pragma unroll
    for (int j = 0; j < 4; ++j) { const int nn = (lane >> 3) + 8 * j; const LAS float* sp = scr + (8 * c) * 33 + nn;
        u32x4 o; o.x = pk2(sp[0 * 33], sp[1 * 33]); o.y = pk2(sp[2 * 33], sp[3 * 33]); o.z = pk2(sp[4 * 33], sp[5 * 33]); o.w = pk2(sp[6 * 33], sp[7 * 33]);
        *(u32x4*)(t.WT + (size_t)(t.dst_row0 + nn) * t.K + t.k0 + 8 * c) = o; }
    LDS_FENCE();
}
__device__ __forceinline__ float rms_row_to_bf16(const float* xrow, const float* __restrict__ gain, bf16_t* orow, int lane) {
    const f32x4* xr = (const f32x4*)xrow + lane; const f32x4* gr = (const f32x4*)gain + lane;
    f32x4 v[4]; float s = 0.f;
#pragma unroll
    for (int j = 0; j < 4; ++j) { v[j] = xr[64 * j]; s += (v[j].x * v[j].x + v[j].y * v[j].y) + (v[j].z * v[j].z + v[j].w * v[j].w); }
    const float rstd = __builtin_amdgcn_rsqf(wave_sum(s) * (1.f / D) + 1e-6f);
    u32x2* o8 = (u32x2*)orow + lane;
#pragma unroll
    for (int j = 0; j < 4; ++j) { const f32x4 gg = gr[64 * j]; u32x2 w; w.x = pk2(v[j].x * rstd * gg.x, v[j].y * rstd * gg.y); w.y = pk2(v[j].z * rstd * gg.z, v[j].w * rstd * gg.w); o8[64 * j] = w; }
    return rstd;
}

__device__ __forceinline__ void rms_rows2_to_bf16(const float* xa, const float* xb, const float* __restrict__ gain, bf16_t* oa, bf16_t* ob, bool hasb, int lane) {
    const f32x4* ra = (const f32x4*)xa + lane; const f32x4* rb = (const f32x4*)xb + lane; const f32x4* gr = (const f32x4*)gain + lane;
    f32x4 va[4], vb[4], gg[4]; float sa = 0.f, sb = 0.f;
#pragma unroll
    for (int j = 0; j < 4; ++j) { va[j] = ra[64 * j]; vb[j] = rb[64 * j]; gg[j] = gr[64 * j]; }
    asm volatile("" ::: "memory");
#pragma unroll
    for (int j = 0; j < 4; ++j) { sa += (va[j].x * va[j].x + va[j].y * va[j].y) + (va[j].z * va[j].z + va[j].w * va[j].w); sb += (vb[j].x * vb[j].x + vb[j].y * vb[j].y) + (vb[j].z * vb[j].z + vb[j].w * vb[j].w); }
    const float rsa = __builtin_amdgcn_rsqf(wave_sum(sa) * (1.f / D) + 1e-6f), rsb = __builtin_amdgcn_rsqf(wave_sum(sb) * (1.f / D) + 1e-6f);
    u32x2* o8a = (u32x2*)oa + lane; u32x2* o8b = (u32x2*)ob + lane;
#pragma unroll
    for (int j = 0; j < 4; ++j) { u32x2 w; w.x = pk2(va[j].x * rsa * gg[j].x, va[j].y * rsa * gg[j].y); w.y = pk2(va[j].z * rsa * gg[j].z, va[j].w * rsa * gg[j].w); o8a[64 * j] = w;
        if (hasb) { u32x2 u; u.x = pk2(vb[j].x * rsb * gg[j].x, vb[j].y * rsb * gg[j].y); u.y = pk2(vb[j].z * rsb * gg[j].z, vb[j].w * rsb * gg[j].w); o8b[64 * j] = u; } }
}

template <int R> struct AttnState { float m[R], l[R], o[R][2]; };
template <int R> __device__ __forceinline__ void attn_init(AttnState<R>& st) {
#pragma unroll
    for (int h = 0; h < R; ++h) { st.m[h] = -1e30f; st.l[h] = 0.f; st.o[h][0] = 0.f; st.o[h][1] = 0.f; }
}
template <int R> __device__ __forceinline__ void attn_block(AttnState<R>& st, const LAS float* q, LAS float* pbuf, const bf16_t* krow, bool valid,
                                                           const bf16_t* vbase, int vstride, int jlo, int jhi, int lane, float scale, float* sraw) {
    float s[R];
#pragma unroll
    for (int h = 0; h < R; ++h) s[h] = 0.f;
    if (valid) {
        const u32x4* kp = (const u32x4*)krow;
#pragma unroll 4
        for (int c = 0; c < 16; ++c) {
            const u32x4 kv = kp[c];
            const float k0 = bflo(kv.x), k1 = bfhi(kv.x), k2 = bflo(kv.y), k3 = bfhi(kv.y), k4 = bflo(kv.z), k5 = bfhi(kv.z), k6 = bflo(kv.w), k7 = bfhi(kv.w);
#pragma unroll
            for (int h = 0; h < R; ++h) { const f32x4 qa = *(const LAS f32x4*)(q + h * 128 + c * 8), qb = *(const LAS f32x4*)(q + h * 128 + c * 8 + 4);
                s[h] += (k0 * qa.x + k1 * qa.y) + (k2 * qa.z + k3 * qa.w) + (k4 * qb.x + k5 * qb.y) + (k6 * qb.z + k7 * qb.w); }
        }
    }
    float alpha[R];
#pragma unroll
    for (int h = 0; h < R; ++h) {
        const float sv = valid ? s[h] * scale : -1e30f; if (sraw) sraw[h] = sv;
        const float bm = wave_max(sv), mn = fmaxf(st.m[h], bm); alpha[h] = __expf(st.m[h] - mn);
        const float p = valid ? __expf(sv - mn) : 0.f;
        st.l[h] = st.l[h] * alpha[h] + wave_sum(p); st.m[h] = mn; st.o[h][0] *= alpha[h]; st.o[h][1] *= alpha[h];
        pbuf[h * 64 + lane] = p;
    }
    LDS_FENCE();
    const bf16_t* vp = vbase + (size_t)jlo * vstride + 2 * lane;
#pragma unroll 4
    for (int j = jlo; j < jhi; ++j) {
        const unsigned vv = *(const unsigned*)vp; vp += vstride; const float v0 = bflo(vv), v1 = bfhi(vv);
#pragma unroll
        for (int h = 0; h < R; ++h) { const float p = pbuf[h * 64 + j]; st.o[h][0] += p * v0; st.o[h][1] += p * v1; }
    }
    LDS_FENCE();
}


#define MFMA16(a, b, c) __builtin_amdgcn_mfma_f32_16x16x32_bf16((a), (b), (c), 0, 0, 0)
#define FRAG(base, pitch, row, kcol) (*(const LAS bf16x8*)((base) + (row) * (pitch) + (kcol)))
__device__ __forceinline__ u32x2 pk4(const f32x4 v) { u32x2 w; w.x = pk2(v[0], v[1]); w.y = pk2(v[2], v[3]); return w; }
__device__ __forceinline__ u32x4 pk8(const f32x4 a, const f32x4 b) { u32x4 w; w.x = pk2(a[0], a[1]); w.y = pk2(a[2], a[3]); w.z = pk2(b[0], b[1]); w.w = pk2(b[2], b[3]); return w; }
constexpr int PK = 136, PC = 72;

__device__ __forceinline__ void gdn_chunk_item(const Params& p, unsigned char* ws, LAS unsigned char* lds, int item, int tid, int lane, int wave) {
    const int n = item & 127, bh = item >> 7, h = bh & 7, b = bh >> 3;
    const int tok0 = b * T + n * 64;
    const bf16_t* PROJ = (const bf16_t*)(ws + WS_PROJ);
    LAS bf16_t* K_RM = (LAS bf16_t*)(lds); LAS bf16_t* KB_RM = (LAS bf16_t*)(lds + 17408); LAS bf16_t* Q_RM = (LAS bf16_t*)(lds + 34816);
    LAS bf16_t* KT_RM = (LAS bf16_t*)(lds + 52224); LAS bf16_t* KBGT = (LAS bf16_t*)(lds + 70656); LAS bf16_t* VBT = (LAS bf16_t*)(lds + 89088);
    LAS float* sc = (LAS float*)(lds + 107520);
    unsigned char* chk = ws + WS_CHK + (size_t)item * CH_BYTES;
    const int fr = lane & 15, fq = lane >> 4, ksw = wave >> 2, ct = wave & 3;
    LAS float* cwl = (LAS float*)(lds + 108544);
    __syncthreads();
    for (int idx = tid; idx < 3 * 4 * 128; idx += NTHREADS) { const int w = idx >> 9, j = (idx >> 7) & 3, c = idx & 127; cwl[idx] = p.in[4][j * 3072 + w * 1024 + h * 128 + c]; }
    __syncthreads();
    {
        float kbv[16];
        const int r = tid >> 3, cg = tid & 7, t = n * 64 + r;
        const float gb = bf2f(PROJ[(size_t)(tok0 + r) * DINP + C_GB + h]), ga = bf2f(PROJ[(size_t)(tok0 + r) * DINP + C_GA + h]);
        const float beta = sigmoidf_(gb); const float xx = ga + p.in[6][h]; const float sp = xx > 20.f ? xx : log1pf(__expf(xx));
        if (cg == 0) sc[r] = -__expf(p.in[5][h]) * sp;
        u32x4 xr[3][4][2];
#define CONV_LOAD(w) do { _Pragma("unroll") for (int j = 0; j < 4; ++j) { const bool inb = (t - 3 + j >= 0); const u32x4* xp = (const u32x4*)(PROJ + (size_t)(inb ? tok0 + r - 3 + j : tok0) * DINP + (w) * 1024 + h * 128 + cg * 16); \
            xr[w][j][0] = xp[0]; xr[w][j][1] = xp[1]; } asm volatile("" ::: "memory"); } while (0)
        CONV_LOAD(0);
#pragma unroll
        for (int w = 0; w < 3; ++w) {
            if (w > 0) CONV_LOAD(w);
            const int ch0 = w * 1024 + h * 128 + cg * 16; (void)ch0;
            float a[16];
#pragma unroll
            for (int e = 0; e < 16; ++e) a[e] = 0.f;
#pragma unroll
            for (int j = 0; j < 4; ++j) {
                {
                    const bool inb = (t - 3 + j >= 0);
                    u32x4 x0 = xr[w][j][0], x1 = xr[w][j][1];
                    if (!inb) { x0 = (u32x4){0u, 0u, 0u, 0u}; x1 = x0; }
                    const LAS f32x4* wp = (const LAS f32x4*)(cwl + (w * 4 + j) * 128 + cg * 16); const f32x4 w0 = wp[0], w1 = wp[1], w2 = wp[2], w3 = wp[3];
                    a[0] += bflo(x0.x) * w0.x; a[1] += bfhi(x0.x) * w0.y; a[2] += bflo(x0.y) * w0.z; a[3] += bfhi(x0.y) * w0.w;
                    a[4] += bflo(x0.z) * w1.x; a[5] += bfhi(x0.z) * w1.y; a[6] += bflo(x0.w) * w1.z; a[7] += bfhi(x0.w) * w1.w;
                    a[8] += bflo(x1.x) * w2.x; a[9] += bfhi(x1.x) * w2.y; a[10] += bflo(x1.y) * w2.z; a[11] += bfhi(x1.y) * w2.w;
                    a[12] += bflo(x1.z) * w3.x; a[13] += bfhi(x1.z) * w3.y; a[14] += bflo(x1.w) * w3.z; a[15] += bfhi(x1.w) * w3.w;
                }
            }
            float ss = 0.f;
#pragma unroll
            for (int e = 0; e < 16; ++e) { a[e] = siluf_(a[e]); ss += a[e] * a[e]; }
            if (w < 2) { ss += __shfl_xor(ss, 1); ss += __shfl_xor(ss, 2); ss += __shfl_xor(ss, 4); const float rn = __builtin_amdgcn_rsqf(ss + 1e-6f) * (w == 0 ? 0.08838834764831845f : 1.f);
#pragma unroll
                for (int e = 0; e < 16; ++e) a[e] *= rn; }
            if (w == 0) { u32x4 o0, o1;
                o0.x = pk2(a[0], a[1]); o0.y = pk2(a[2], a[3]); o0.z = pk2(a[4], a[5]); o0.w = pk2(a[6], a[7]); o1.x = pk2(a[8], a[9]); o1.y = pk2(a[10], a[11]); o1.z = pk2(a[12], a[13]); o1.w = pk2(a[14], a[15]);
                *(LAS u32x4*)(Q_RM + r * PK + cg * 16) = o0; *(LAS u32x4*)(Q_RM + r * PK + cg * 16 + 8) = o1; }
            else if (w == 1) { u32x4 o0, o1;
                o0.x = pk2(a[0], a[1]); o0.y = pk2(a[2], a[3]); o0.z = pk2(a[4], a[5]); o0.w = pk2(a[6], a[7]); o1.x = pk2(a[8], a[9]); o1.y = pk2(a[10], a[11]); o1.z = pk2(a[12], a[13]); o1.w = pk2(a[14], a[15]);
                *(LAS u32x4*)(K_RM + r * PK + cg * 16) = o0; *(LAS u32x4*)(K_RM + r * PK + cg * 16 + 8) = o1;
#pragma unroll
                for (int e = 0; e < 16; ++e) { KT_RM[(cg * 16 + e) * PC + r] = (bf16_t)f2bf(a[e]); kbv[e] = a[e] * beta; }
                o0.x = pk2(kbv[0], kbv[1]); o0.y = pk2(kbv[2], kbv[3]); o0.z = pk2(kbv[4], kbv[5]); o0.w = pk2(kbv[6], kbv[7]); o1.x = pk2(kbv[8], kbv[9]); o1.y = pk2(kbv[10], kbv[11]); o1.z = pk2(kbv[12], kbv[13]); o1.w = pk2(kbv[14], kbv[15]);
                *(LAS u32x4*)(KB_RM + r * PK + cg * 16) = o0; *(LAS u32x4*)(KB_RM + r * PK + cg * 16 + 8) = o1; }
            else {
#pragma unroll
                for (int e = 0; e < 16; ++e) VBT[(cg * 16 + e) * PC + r] = (bf16_t)f2bf(a[e] * beta); }
        }
    }
    __syncthreads();
    if (wave == 0) { float v = sc[lane];
#pragma unroll
        for (int o = 1; o < 64; o <<= 1) { const float u = __shfl_up(v, o); if (lane >= o) v += u; }
        const float gl = __shfl(v, 63); sc[64 + lane] = v; sc[128 + lane] = __expf(v); sc[192 + lane] = __expf(gl - v);
        if (lane == 63) ((float*)(ws + WS_GL))[item] = __expf(v); }
    __syncthreads();
    { const int r = tid >> 3, cg = tid & 7; const float eg = sc[128 + r];
        const u32x4 k0 = *(const LAS u32x4*)(KB_RM + r * PK + cg * 16), k1 = *(const LAS u32x4*)(KB_RM + r * PK + cg * 16 + 8);
        const unsigned kw[8] = {k0.x, k0.y, k0.z, k0.w, k1.x, k1.y, k1.z, k1.w};
#pragma unroll
        for (int e = 0; e < 8; ++e) { KBGT[(cg * 16 + 2 * e) * PC + r] = (bf16_t)f2bf(bflo(kw[e]) * eg); KBGT[(cg * 16 + 2 * e + 1) * PC + r] = (bf16_t)f2bf(bfhi(kw[e]) * eg); } }
    f32x4 d1[2], d2[2], d3[2];
#pragma unroll
    for (int ti = 0; ti < 2; ++ti) { d1[ti] = (f32x4){0.f, 0.f, 0.f, 0.f}; d2[ti] = d1[ti]; d3[ti] = d1[ti]; }
#pragma unroll
    for (int kk = 0; kk < 4; ++kk) {
        const bf16x8 k_b = FRAG(K_RM, PK, 16 * ct + fr, 32 * kk + 8 * fq), kb_b = FRAG(KB_RM, PK, 16 * ct + fr, 32 * kk + 8 * fq), q_b = FRAG(Q_RM, PK, 16 * ct + fr, 32 * kk + 8 * fq);
#pragma unroll
        for (int ti = 0; ti < 2; ++ti) { const int row = 16 * (2 * ksw + ti) + fr;
            const bf16x8 kb_a = FRAG(KB_RM, PK, row, 32 * kk + 8 * fq), k_a = FRAG(K_RM, PK, row, 32 * kk + 8 * fq);
            d1[ti] = MFMA16(kb_a, k_b, d1[ti]); d2[ti] = MFMA16(k_a, kb_b, d2[ti]); d3[ti] = MFMA16(k_a, q_b, d3[ti]); }
    }
#pragma unroll
    for (int q = 0; q < 2; ++q) { const int idx = 2 * wave + q;
        { const int mt = idx >> 2, ks = idx & 3, c = 16 * mt + fr, i0 = 32 * ks + 4 * fq; const float eg = sc[128 + c];
            const u32x2 a = *(const LAS u32x2*)(Q_RM + c * PK + i0), bq = *(const LAS u32x2*)(Q_RM + c * PK + i0 + 16);
            u32x4 o; o.x = pk2(bflo(a.x) * eg, bfhi(a.x) * eg); o.y = pk2(bflo(a.y) * eg, bfhi(a.y) * eg); o.z = pk2(bflo(bq.x) * eg, bfhi(bq.x) * eg); o.w = pk2(bflo(bq.y) * eg, bfhi(bq.y) * eg);
            *(u32x4*)(chk + CH_QD + (idx * 64 + lane) * 16) = o; }
        { const int it = idx >> 1, ks = idx & 1, i = 16 * it + fr, c0 = 32 * ks + 4 * fq;
            const u32x2 a = *(const LAS u32x2*)(KT_RM + i * PC + c0), bq = *(const LAS u32x2*)(KT_RM + i * PC + c0 + 16);
            const f32x4 e0 = *(const LAS f32x4*)(sc + 192 + c0), e1 = *(const LAS f32x4*)(sc + 192 + c0 + 16);
            u32x4 o; o.x = pk2(bflo(a.x) * e0.x, bfhi(a.x) * e0.y); o.y = pk2(bflo(a.y) * e0.z, bfhi(a.y) * e0.w); o.z = pk2(bflo(bq.x) * e1.x, bfhi(bq.x) * e1.y); o.w = pk2(bflo(bq.y) * e1.z, bfhi(bq.y) * e1.w);
            *(u32x4*)(chk + CH_KDT + (idx * 64 + lane) * 16) = o; }
    }
    __syncthreads();
    LAS bf16_t* Xb0 = (LAS bf16_t*)(lds); LAS bf16_t* Xb1 = (LAS bf16_t*)(lds + 9216); LAS bf16_t* XTb0 = (LAS bf16_t*)(lds + 18432); LAS bf16_t* XTb1 = (LAS bf16_t*)(lds + 27648);
    LAS bf16_t* Pb0 = (LAS bf16_t*)(lds + 36864); LAS bf16_t* Pb1 = (LAS bf16_t*)(lds + 46080);
    f32x4 accP[2];
    {
        const int cidx = 16 * ct + fr; const float gc = sc[64 + cidx];
        f32x4 qk[2];
#pragma unroll
        for (int ti = 0; ti < 2; ++ti) { const int r0 = 16 * (2 * ksw + ti) + 4 * fq; const f32x4 gr = *(const LAS f32x4*)(sc + 64 + r0);
            f32x4 xt, xx;
#pragma unroll
            for (int r = 0; r < 4; ++r) { const int rr = r0 + r;
                xt[r] = (rr > cidx) ? -(d1[ti][r] * __expf(gr[r] - gc)) : 0.f;
                xx[r] = (cidx > rr) ? -(d2[ti][r] * __expf(gc - gr[r])) : 0.f;
                qk[ti][r] = (rr <= cidx) ? d3[ti][r] * __expf(gc - gr[r]) : 0.f;
                accP[ti][r] = xx[r] + (rr == cidx ? 1.f : 0.f); }
            *(LAS u32x2*)(XTb0 + cidx * PC + r0) = pk4(xt); *(LAS u32x2*)(Xb0 + cidx * PC + r0) = pk4(xx); *(LAS u32x2*)(Pb0 + cidx * PC + r0) = pk4(accP[ti]); }
        *(u32x4*)(chk + CH_QK + ((ct * 2 + ksw) * 64 + lane) * 16) = pk8(qk[0], qk[1]);
    }
    __syncthreads();
#pragma unroll
    for (int itn = 0; itn < 5; ++itn) {
        LAS bf16_t* Xc = (itn & 1) ? Xb1 : Xb0; LAS bf16_t* Xn = (itn & 1) ? Xb0 : Xb1; LAS bf16_t* XTc = (itn & 1) ? XTb1 : XTb0; LAS bf16_t* XTn = (itn & 1) ? XTb0 : XTb1;
        LAS bf16_t* Pc = (itn & 1) ? Pb1 : Pb0; LAS bf16_t* Pn = (itn & 1) ? Pb0 : Pb1;
        f32x4 e1[2], e2[2];
#pragma unroll
        for (int ti = 0; ti < 2; ++ti) { e1[ti] = (f32x4){0.f, 0.f, 0.f, 0.f}; e2[ti] = e1[ti]; }
#pragma unroll
        for (int kk = 0; kk < 2; ++kk) {
            const bf16x8 bxt = FRAG(XTc, PC, 16 * ct + fr, 32 * kk + 8 * fq), bx = FRAG(Xc, PC, 16 * ct + fr, 32 * kk + 8 * fq);
#pragma unroll
            for (int ti = 0; ti < 2; ++ti) { const int row = 16 * (2 * ksw + ti) + fr;
                e1[ti] = MFMA16(FRAG(Xc, PC, row, 32 * kk + 8 * fq), bxt, e1[ti]);
                if (itn < 4) e2[ti] = MFMA16(FRAG(XTc, PC, row, 32 * kk + 8 * fq), bx, e2[ti]); }
        }
#pragma unroll
        for (int ti = 0; ti < 2; ++ti) { const int r0 = 16 * (2 * ksw + ti) + 4 * fq;
            *(LAS u32x2*)(XTn + (16 * ct + fr) * PC + r0) = pk4(e1[ti]); if (itn < 4) *(LAS u32x2*)(Xn + (16 * ct + fr) * PC + r0) = pk4(e2[ti]); }
        __syncthreads();
#pragma unroll
        for (int kk = 0; kk < 2; ++kk) { const bf16x8 bp = FRAG(Pc, PC, 16 * ct + fr, 32 * kk + 8 * fq);
#pragma unroll
            for (int ti = 0; ti < 2; ++ti) accP[ti] = MFMA16(FRAG(XTn, PC, 16 * (2 * ksw + ti) + fr, 32 * kk + 8 * fq), bp, accP[ti]); }
#pragma unroll
        for (int ti = 0; ti < 2; ++ti) *(LAS u32x2*)(Pn + (16 * ct + fr) * PC + 16 * (2 * ksw + ti) + 4 * fq) = pk4(accP[ti]);
        __syncthreads();
    }
    LAS bf16_t* Tm = Pb1;
    {
        f32x4 u[4];
#pragma unroll
        for (int rt = 0; rt < 4; ++rt) u[rt] = (f32x4){0.f, 0.f, 0.f, 0.f};
#pragma unroll
        for (int kk = 0; kk < 2; ++kk) { const bf16x8 bv = FRAG(VBT, PC, 16 * wave + fr, 32 * kk + 8 * fq);
#pragma unroll
            for (int rt = 0; rt < 4; ++rt) u[rt] = MFMA16(FRAG(Tm, PC, 16 * rt + fr, 32 * kk + 8 * fq), bv, u[rt]); }
        f32x4* U = (f32x4*)(ws + WS_U) + ((size_t)(item * 8 + wave) * 4) * 64 + lane;
#pragma unroll
        for (int rt = 0; rt < 4; ++rt) U[rt * 64] = u[rt];
#pragma unroll
        for (int q = 0; q < 2; ++q) { const int ks2 = ksw + 2 * q;
            f32x4 w2[2] = {(f32x4){0.f, 0.f, 0.f, 0.f}, (f32x4){0.f, 0.f, 0.f, 0.f}};
#pragma unroll
            for (int kk = 0; kk < 2; ++kk) { const bf16x8 bt = FRAG(Tm, PC, 16 * ct + fr, 32 * kk + 8 * fq);
#pragma unroll
                for (int ti = 0; ti < 2; ++ti) w2[ti] = MFMA16(FRAG(KBGT, PC, 16 * (2 * ks2 + ti) + fr, 32 * kk + 8 * fq), bt, w2[ti]); }
            *(u32x4*)(chk + CH_NEGW + ((ct * 4 + ks2) * 64 + lane) * 16) = pk8(-w2[0], -w2[1]); }
    }
}

__device__ __forceinline__ void gdn_scan(unsigned char* ws, LAS unsigned char* lds, int sblk, int tid, int lane, int wave) {
    const int bh = sblk >> 1, half = sblk & 1, b = bh >> 3, h = bh & 7, sl = half * 4 + wave;
    const int fr = lane & 15, fq = lane >> 4;
    const unsigned char* chunks = ws + WS_CHK + (size_t)bh * 128 * CH_BYTES;
    const float* GL = (const float*)(ws + WS_GL) + bh * 128;
    float* GO = (float*)(ws + WS_GO);
#define GDN_STAGE(nn, buf) do { const unsigned char* _src = chunks + (size_t)(nn) * CH_BYTES; _Pragma("unroll") for (int _i = 0; _i < 7; ++_i) \
        __builtin_amdgcn_global_load_lds((const unsigned*)(_src + (_i * 512 + tid) * 16), (LAS unsigned*)(lds + (buf) * CH_BYTES + (_i * 512 + wave * 64) * 16), 16, 0, 0); } while (0)
    __syncthreads();
    GDN_STAGE(0, 0);
    f32x4 S[8]; bf16x8 Sb[4]; f32x4 ucur[4];
#pragma unroll
    for (int i = 0; i < 8; ++i) S[i] = (f32x4){0.f, 0.f, 0.f, 0.f};
#pragma unroll
    for (int i = 0; i < 4; ++i) Sb[i] = (bf16x8){0, 0, 0, 0, 0, 0, 0, 0};
    const f32x4* Ubase = (const f32x4*)(ws + WS_U) + ((size_t)(bh * 128) * 8 + sl) * 256 + lane;
    if (wave < 4) {
#pragma unroll
        for (int rt = 0; rt < 4; ++rt) ucur[rt] = Ubase[rt * 64];
    }
    asm volatile("s_waitcnt vmcnt(0)" ::: "memory");
    __syncthreads();
#pragma unroll 1
    for (int n = 0; n < 128; ++n) {
        const int buf = n & 1;
        if (n + 1 < 128) GDN_STAGE(n + 1, buf ^ 1);
        if (wave < 4) {
            const LAS unsigned char* L = lds + buf * CH_BYTES + lane * 16;
            f32x4 unext[4];
            if (n + 1 < 128) {
#pragma unroll
                for (int rt = 0; rt < 4; ++rt) unext[rt] = Ubase[(size_t)(n + 1) * 2048 + rt * 64];
            }
            const float gl = GL[n];
            f32x4 vn[4], o[4];
#pragma unroll
            for (int rt = 0; rt < 4; ++rt) { vn[rt] = ucur[rt]; o[rt] = (f32x4){0.f, 0.f, 0.f, 0.f}; }
#pragma unroll
            for (int ks = 0; ks < 4; ++ks)
#pragma unroll
                for (int rt = 0; rt < 4; ++rt) {
                    vn[rt] = MFMA16(*(const LAS bf16x8*)(L + CH_NEGW + (rt * 4 + ks) * 1024), Sb[ks], vn[rt]);
                    o[rt] = MFMA16(*(const LAS bf16x8*)(L + CH_QD + (rt * 4 + ks) * 1024), Sb[ks], o[rt]); }
            bf16x8 vb[2];
            vb[0] = __builtin_bit_cast(bf16x8, pk8(vn[0], vn[1])); vb[1] = __builtin_bit_cast(bf16x8, pk8(vn[2], vn[3]));
#pragma unroll
            for (int ks = 0; ks < 2; ++ks)
#pragma unroll
                for (int rt = 0; rt < 4; ++rt) o[rt] = MFMA16(*(const LAS bf16x8*)(L + CH_QK + (rt * 2 + ks) * 1024), vb[ks], o[rt]);
#pragma unroll
            for (int it = 0; it < 8; ++it) S[it] = S[it] * gl;
#pragma unroll
            for (int ks = 0; ks < 2; ++ks)
#pragma unroll
                for (int it = 0; it < 8; ++it) S[it] = MFMA16(*(const LAS bf16x8*)(L + CH_KDT + (it * 2 + ks) * 1024), vb[ks], S[it]);
#pragma unroll
            for (int ks = 0; ks < 4; ++ks) Sb[ks] = __builtin_bit_cast(bf16x8, pk8(S[2 * ks], S[2 * ks + 1]));
            float* go = GO + (size_t)(b * T + n * 64 + 4 * fq) * D + h * 128 + sl * 16 + fr;
#pragma unroll
            for (int rt = 0; rt < 4; ++rt)
#pragma unroll
                for (int r = 0; r < 4; ++r) go[(size_t)(16 * rt + r) * D] = o[rt][r];
            if (n + 1 < 128) {
#pragma unroll
                for (int rt = 0; rt < 4; ++rt) ucur[rt] = unext[rt];
            }
        }
        asm volatile("s_waitcnt vmcnt(0)" ::: "memory");
        __syncthreads();
    }
#undef GDN_STAGE
}


#define MFMA32(a, b, c) __builtin_amdgcn_mfma_f32_32x32x16_bf16((a), (b), (c), 0, 0, 0)
typedef float f32x16 __attribute__((ext_vector_type(16)));
typedef float f32x2v __attribute__((ext_vector_type(2)));
constexpr int NL_RING = 32768;
constexpr int NL_IMP = 65536, NL_Q = 98304, NL_QF = 65536, NL_SELM = 131072;
constexpr float NSA_C = 0.08838834764831845f * 1.4426950408889634f;
__device__ __forceinline__ int vperm16(int off) { return ((off >> 2) & 1) * 8 + (off >> 3) * 4 + (off & 3); }

__device__ __forceinline__ float xor32f(float x) { const unsigned u = __builtin_bit_cast(unsigned, x); auto r = __builtin_amdgcn_permlane32_swap(u, u, false, false);
    return __builtin_bit_cast(float, (threadIdx.x & 32) ? r[0] : r[1]); }
__device__ __forceinline__ float qxor1f(float x) { return __builtin_bit_cast(float, __builtin_amdgcn_update_dpp(0, __builtin_bit_cast(int, x), 0xB1, 0xF, 0xF, false)); }
__device__ __forceinline__ float qxor2f(float x) { return __builtin_bit_cast(float, __builtin_amdgcn_update_dpp(0, __builtin_bit_cast(int, x), 0x4E, 0xF, 0xF, false)); }
__device__ __forceinline__ int kimg_off(int key, int d) { return (((d >> 3) * 64 + key) << 3) + (d & 7); }
__device__ __forceinline__ int vimg_off(int dv, int kpos) { return (((kpos >> 3) * 128 + dv) << 3) + (kpos & 7); }
__device__ __forceinline__ void nsa_stage(LAS unsigned char* lds, int buf, const unsigned char* kimg, const unsigned char* vimg, bool withv, int tid, int wave) {
#pragma unroll
    for (int i = 0; i < 2; ++i) __builtin_amdgcn_global_load_lds((const unsigned*)(kimg + (i * 512 + tid) * 16), (LAS unsigned*)(lds + buf * NL_RING + (i * 512 + wave * 64) * 16), 16, 0, 0);
    if (withv) {
#pragma unroll
        for (int i = 0; i < 2; ++i) __builtin_amdgcn_global_load_lds((const unsigned*)(vimg + (i * 512 + tid) * 16), (LAS unsigned*)(lds + buf * NL_RING + 16384 + (i * 512 + wave * 64) * 16), 16, 0, 0);
    }
}
#define NSA_SYNC(N) do { asm volatile("s_waitcnt vmcnt(" #N ")" ::: "memory"); __builtin_amdgcn_s_barrier(); asm volatile("" ::: "memory"); } while (0)
template <int MODE, int KIND>
__device__ __forceinline__ void nsa_tile(const LAS unsigned char* kb, const LAS unsigned char* vb, int kt, const LAS unsigned char* qlds, const bf16x8 (&Qh)[4], f32x16 (&O)[4], float& m, float& l,
                                         bool colok, int tl, int lim, float il, LAS float* imp_row, int sidx0, int r32, int hi) {
    f32x16 acc;
#pragma unroll
    for (int i = 0; i < 16; ++i) acc[i] = 0.f;
    { const LAS unsigned char* kr = kb + hi * 1024 + (32 * kt + r32) * 16;
        bf16x8 kf[4], qf[4];
#pragma unroll
        for (int ks = 0; ks < 4; ++ks) { kf[ks] = *(const LAS bf16x8*)(kr + ks * 2048); qf[ks] = *(const LAS bf16x8*)(qlds + ks * 1024); }
#pragma unroll
        for (int ks = 0; ks < 4; ++ks) acc = MFMA32(kf[ks], qf[ks], acc);
#pragma unroll
        for (int ks = 0; ks < 4; ++ks) kf[ks] = *(const LAS bf16x8*)(kr + (4 + ks) * 2048);
#pragma unroll
        for (int ks = 0; ks < 4; ++ks) acc = MFMA32(kf[ks], Qh[ks], acc);
        __builtin_amdgcn_sched_group_barrier(0x100, 8, 0);
        __builtin_amdgcn_sched_group_barrier(0x008, 1, 0); __builtin_amdgcn_sched_group_barrier(0x100, 1, 0);
        __builtin_amdgcn_sched_group_barrier(0x008, 1, 0); __builtin_amdgcn_sched_group_barrier(0x100, 1, 0);
        __builtin_amdgcn_sched_group_barrier(0x008, 1, 0); __builtin_amdgcn_sched_group_barrier(0x100, 1, 0);
        __builtin_amdgcn_sched_group_barrier(0x008, 1, 0); __builtin_amdgcn_sched_group_barrier(0x100, 1, 0);
        __builtin_amdgcn_sched_group_barrier(0x008, 4, 0); }
    if (!(KIND == 2 && MODE == 0)) {
#pragma unroll
        for (int reg = 0; reg < 16; ++reg) { const int koff = (reg & 3) + 8 * (reg >> 2) + 4 * hi; bool ok;
            if (MODE == 0) ok = colok; else if (MODE == 1) ok = colok && (32 * kt + koff <= tl); else if (MODE == 2) ok = colok && (32 * kt + koff >= tl + 1); else ok = koff < lim;
            acc[reg] = ok ? acc[reg] : -3e38f; }
    }
    float p[16];
    if (KIND == 0) {
        float tmax = acc[0];
#pragma unroll
        for (int reg = 1; reg < 16; ++reg) tmax = fmaxf(tmax, acc[reg]);
        tmax = fmaxf(tmax, xor32f(tmax));
        const float mnew = fmaxf(m, tmax); l *= __builtin_amdgcn_exp2f((m - mnew) * NSA_C); m = mnew;
        const float mref = fmaxf(m, -1e30f) * NSA_C; float ps = 0.f;
#pragma unroll
        for (int reg = 0; reg < 16; ++reg) ps += __builtin_amdgcn_exp2f(__builtin_fmaf(acc[reg], NSA_C, -mref));
        l += ps + xor32f(ps);
    } else if (KIND == 2) {
        if (__any(m < -1e37f)) {
            float tmax = acc[0];
#pragma unroll
            for (int reg = 1; reg < 16; ++reg) tmax = fmaxf(tmax, acc[reg]);
            tmax = fmaxf(tmax, xor32f(tmax));
            if (MODE == 0) tmax = colok ? tmax : -3e38f;
            m = (m < -1e37f) ? tmax : m;
        }
        float mref = (m < -1e37f) ? 3e38f : m * NSA_C;
        if (MODE == 0) mref = colok ? mref : 3e38f;
        f32x2v ps2 = {0.f, 0.f};
#pragma unroll
        for (int reg = 0; reg < 16; reg += 2) { p[reg] = __builtin_amdgcn_exp2f(fminf(__builtin_fmaf(acc[reg], NSA_C, -mref), 100.f)); p[reg + 1] = __builtin_amdgcn_exp2f(fminf(__builtin_fmaf(acc[reg + 1], NSA_C, -mref), 100.f));
            ps2 += (f32x2v){p[reg], p[reg + 1]}; }
        const float ps = ps2.x + ps2.y;
        l += ps + xor32f(ps);
    } else {
        const float mref = fmaxf(m, -1e30f) * NSA_C;
#pragma unroll
        for (int reg = 0; reg < 16; ++reg) p[reg] = __builtin_amdgcn_exp2f(__builtin_fmaf(acc[reg], NSA_C, -mref)) * il;
#pragma unroll
        for (int q = 0; q < 4; ++q) { float gsum = 2.f * (p[4 * q] + p[4 * q + 1] + p[4 * q + 2]) + p[4 * q + 3], ls = p[4 * q + 3];
            gsum += qxor1f(gsum); ls += qxor1f(ls); gsum += qxor2f(gsum); ls += qxor2f(ls);
            if ((r32 & 3) == 0) { const int sidx = sidx0 + 2 * q + hi;
                __hip_atomic_fetch_add(imp_row + sidx, gsum, __ATOMIC_RELAXED, __HIP_MEMORY_SCOPE_WORKGROUP);
                if (sidx + 1 < NSEL) __hip_atomic_fetch_add(imp_row + sidx + 1, ls, __ATOMIC_RELAXED, __HIP_MEMORY_SCOPE_WORKGROUP); } }
    }
    if (KIND != 0) {
        bf16x8 pb[2];
#pragma unroll
        for (int s2 = 0; s2 < 2; ++s2) { u32x4 w; w.x = pk2(p[8 * s2], p[8 * s2 + 1]); w.y = pk2(p[8 * s2 + 2], p[8 * s2 + 3]); w.z = pk2(p[8 * s2 + 4], p[8 * s2 + 5]); w.w = pk2(p[8 * s2 + 6], p[8 * s2 + 7]); pb[s2] = __builtin_bit_cast(bf16x8, w); }
#pragma unroll
        for (int mt = 0; mt < 4; ++mt) { const LAS unsigned char* vr = vb + hi * 2048 + (32 * mt + r32) * 16;
#pragma unroll
            for (int s2 = 0; s2 < 2; ++s2) O[mt] = MFMA32(*(const LAS bf16x8*)(vr + (2 * kt + s2) * 4096), pb[s2], O[mt]); }
        __builtin_amdgcn_sched_group_barrier(0x100, 8, 1);
        __builtin_amdgcn_sched_group_barrier(0x008, 8, 1);
    }
}

template <int MODE>
__device__ __forceinline__ void nsa_block_fast(const LAS unsigned char* slot, const LAS unsigned char* qf, f32x16 (&O)[4], float m, float& l, bool colok, int tl, int r32, int hi) {
    const LAS unsigned char* kr = slot + hi * 1024 + r32 * 16;
    const LAS unsigned char* vb = slot + 16384 + hi * 2048 + r32 * 16;
    float mref = m * NSA_C;
    if (MODE == 0) mref = colok ? mref : 3e38f;
    f32x16 a0, a1;
#pragma unroll
    for (int i = 0; i < 16; ++i) { a0[i] = 0.f; a1[i] = 0.f; }
    bf16x8 vv[8];
    {
        bf16x8 qv[8], kv[8];
#pragma unroll
        for (int ks = 0; ks < 8; ++ks) { qv[ks] = *(const LAS bf16x8*)(qf + ks * 1024); kv[ks] = *(const LAS bf16x8*)(kr + ks * 2048); }
#pragma unroll
        for (int ks = 0; ks < 8; ++ks) a0 = MFMA32(kv[ks], qv[ks], a0);
#pragma unroll
        for (int ks = 0; ks < 8; ++ks) kv[ks] = *(const LAS bf16x8*)(kr + 512 + ks * 2048);
#pragma unroll
        for (int ks = 0; ks < 8; ++ks) a1 = MFMA32(kv[ks], qv[ks], a1);
    }
#pragma unroll
    for (int mt = 0; mt < 4; ++mt)
#pragma unroll
        for (int s2 = 0; s2 < 2; ++s2) vv[mt * 2 + s2] = *(const LAS bf16x8*)(vb + mt * 512 + s2 * 4096);
    f32x2v ps2 = {0.f, 0.f};
    bf16x8 pb[2];
#pragma unroll
    for (int reg = 0; reg < 16; reg += 2) { float x0 = a0[reg], x1 = a0[reg + 1];
        if (MODE != 0) { const int k0 = (reg & 3) + 8 * (reg >> 2) + 4 * hi, k1 = k0 + 1; const bool o0 = colok && (MODE == 1 ? (k0 <= tl) : (k0 >= tl + 1)), o1 = colok && (MODE == 1 ? (k1 <= tl) : (k1 >= tl + 1)); x0 = o0 ? x0 : -3e38f; x1 = o1 ? x1 : -3e38f; }
        x0 = __builtin_amdgcn_exp2f(fminf(__builtin_fmaf(x0, NSA_C, -mref), 100.f)); x1 = __builtin_amdgcn_exp2f(fminf(__builtin_fmaf(x1, NSA_C, -mref), 100.f));
        ps2 += (f32x2v){x0, x1}; a0[reg] = x0; a0[reg + 1] = x1; }
#pragma unroll
    for (int s2 = 0; s2 < 2; ++s2) { u32x4 w; w.x = pk2(a0[8 * s2], a0[8 * s2 + 1]); w.y = pk2(a0[8 * s2 + 2], a0[8 * s2 + 3]); w.z = pk2(a0[8 * s2 + 4], a0[8 * s2 + 5]); w.w = pk2(a0[8 * s2 + 6], a0[8 * s2 + 7]); pb[s2] = __builtin_bit_cast(bf16x8, w); }
#pragma unroll
    for (int mt = 0; mt < 4; ++mt)
#pragma unroll
        for (int s2 = 0; s2 < 2; ++s2) O[mt] = MFMA32(vv[mt * 2 + s2], pb[s2], O[mt]);
#pragma unroll
    for (int mt = 0; mt < 4; ++mt)
#pragma unroll
        for (int s2 = 0; s2 < 2; ++s2) vv[mt * 2 + s2] = *(const LAS bf16x8*)(vb + mt * 512 + (2 + s2) * 4096);
#pragma unroll
    for (int reg = 0; reg < 16; reg += 2) { float x0 = a1[reg], x1 = a1[reg + 1];
        if (MODE != 0) { const int k0 = 32 + (reg & 3) + 8 * (reg >> 2) + 4 * hi, k1 = k0 + 1; const bool o0 = colok && (MODE == 1 ? (k0 <= tl) : (k0 >= tl + 1)), o1 = colok && (MODE == 1 ? (k1 <= tl) : (k1 >= tl + 1)); x0 = o0 ? x0 : -3e38f; x1 = o1 ? x1 : -3e38f; }
        x0 = __builtin_amdgcn_exp2f(fminf(__builtin_fmaf(x0, NSA_C, -mref), 100.f)); x1 = __builtin_amdgcn_exp2f(fminf(__builtin_fmaf(x1, NSA_C, -mref), 100.f));
        ps2 += (f32x2v){x0, x1}; a1[reg] = x0; a1[reg + 1] = x1; }
#pragma unroll
    for (int s2 = 0; s2 < 2; ++s2) { u32x4 w; w.x = pk2(a1[8 * s2], a1[8 * s2 + 1]); w.y = pk2(a1[8 * s2 + 2], a1[8 * s2 + 3]); w.z = pk2(a1[8 * s2 + 4], a1[8 * s2 + 5]); w.w = pk2(a1[8 * s2 + 6], a1[8 * s2 + 7]); pb[s2] = __builtin_bit_cast(bf16x8, w); }
#pragma unroll
    for (int mt = 0; mt < 4; ++mt)
#pragma unroll
        for (int s2 = 0; s2 < 2; ++s2) O[mt] = MFMA32(vv[mt * 2 + s2], pb[s2], O[mt]);
    const float ps = ps2.x + ps2.y;
    l += ps + xor32f(ps);
}
template <int MODE>
__device__ __forceinline__ void nsa_block(const LAS unsigned char* slot, const LAS unsigned char* qf, f32x16 (&O)[4], float& m, float& l, bool colok, int tl, int r32, int hi) {
    if (__any(m < -1e37f)) {
        bf16x8 Qh[4];
#pragma unroll
        for (int ks = 0; ks < 4; ++ks) Qh[ks] = *(const LAS bf16x8*)(qf + (4 + ks) * 1024);
#pragma unroll 1
        for (int kt = 0; kt < 2; ++kt) nsa_tile<MODE, 2>(slot, slot + 16384, kt, qf, Qh, O, m, l, colok, tl, 0, 0.f, (LAS float*)slot, 0, r32, hi);
    } else nsa_block_fast<MODE>(slot, qf, O, m, l, colok, tl, r32, hi);
}

__device__ __forceinline__ void nsa_item(const Params& p, unsigned char* ws, LAS unsigned char* lds, int item, int tid, int lane, int wave) {
    const int tile = 127 - (item >> 2), bg = item & 3, b = bg >> 1, g = bg & 1, t0 = tile * 64, cur = tile;
    const int r32 = lane & 31, hi = lane >> 5, tl = 8 * wave + (r32 >> 2), head = g * 4 + (r32 & 3), t = t0 + tl, tok = b * T + t;
    const bf16_t* PROJ = (const bf16_t*)(ws + WS_PROJ);
    LAS float* IMP = (LAS float*)(lds + NL_IMP); LAS unsigned* SELM = (LAS unsigned*)(lds + NL_SELM);
    __syncthreads();
    nsa_stage(lds, 0, ws + WS_KC + (size_t)(bg * 8) * 16384, ws + WS_VC, false, tid, wave);
    for (int idx = tid; idx < 64 * NSEL; idx += NTHREADS) IMP[idx] = 0.f;
    LAS unsigned char* const qlds = lds + NL_Q + wave * 4096 + hi * 512 + r32 * 16;
    bf16x8 Qh[4];
#pragma unroll
    for (int ks = 0; ks < 4; ++ks) { *(LAS bf16x8*)(qlds + ks * 1024) = *(const bf16x8*)(PROJ + (size_t)tok * DINP + C_NQ + head * 128 + 16 * ks + 8 * hi);
        Qh[ks] = *(const bf16x8*)(PROJ + (size_t)tok * DINP + C_NQ + head * 128 + 16 * (4 + ks) + 8 * hi); }
    f32x16 O[4];
    float m, l;
#define OB_PTR() bf16_t* ob; { int tk_ = tok; asm volatile("" : "+v"(tk_)); ob = (bf16_t*)(ws + WS_OB) + (size_t)tk_ * D + head * 128 + 4 * hi; }
#define O_ZERO() do { _Pragma("unroll") for (int mt = 0; mt < 4; ++mt) _Pragma("unroll") for (int i = 0; i < 16; ++i) O[mt][i] = 0.f; } while (0)
#define RING_LOOP(NBLK, NOPS, STAGE, ...) do { const int nblk_ = (NBLK); \
        { const int sb_ = 0, slot_ = 0; STAGE; } if (nblk_ > 1) { const int sb_ = 1, slot_ = 1; STAGE; NSA_SYNC(NOPS); } else { NSA_SYNC(0); } \
        int cs_ = 0; \
        _Pragma("unroll 1") for (int st_ = 0; st_ < 2 * nblk_; ++st_) { \
            const int s = st_ >> 1, kt = st_ & 1; const bool more_ = (s + 2 < nblk_); \
            if (kt == 0 && more_) { const int sb_ = s + 2, slot_ = (cs_ == 0 ? 2 : cs_ - 1); STAGE; } \
            { const LAS unsigned char* slotp = lds + cs_ * NL_RING; __VA_ARGS__; } \
            if (kt == 1) { if (more_) { NSA_SYNC(NOPS); } else { NSA_SYNC(0); } cs_ = (cs_ == 2 ? 0 : cs_ + 1); } } } while (0)
#define RING_LOOPB(NBLK, NOPS, STAGE, ...) do { const int nblk_ = (NBLK); \
        { const int sb_ = 0, slot_ = 0; STAGE; } if (nblk_ > 1) { const int sb_ = 1, slot_ = 1; STAGE; NSA_SYNC(NOPS); } else { NSA_SYNC(0); } \
        int cs_ = 0; \
        _Pragma("unroll 1") for (int s = 0; s < nblk_; ++s) { const bool more_ = (s + 2 < nblk_); \
            if (more_) { const int sb_ = s + 2, slot_ = (cs_ == 0 ? 2 : cs_ - 1); STAGE; } \
            { const LAS unsigned char* slotp = lds + cs_ * NL_RING; __VA_ARGS__; } \
            if (more_) { NSA_SYNC(NOPS); } else { NSA_SYNC(0); } cs_ = (cs_ == 2 ? 0 : cs_ + 1); } } while (0)
#define RING_LOOP2(NBLK, NOPS, STAGE, ...) do { const int nblk_ = (NBLK); \
        NSA_SYNC(0);   \
        _Pragma("unroll 1") for (int st_ = 0; st_ < 2 * nblk_; ++st_) { \
            const int s = st_ >> 1, kt = st_ & 1; \
            if (kt == 0 && s + 1 < nblk_) { const int sb_ = s + 1, slot_ = (s + 1) & 1; STAGE; } \
            { const LAS unsigned char* slotp = lds + (s & 1) * NL_RING; __VA_ARGS__; } \
            if (kt == 1) { NSA_SYNC(0); } } } while (0)
#define RING_LOOPB2(NBLK, STAGE, ...) do { const int nblk_ = (NBLK); \
        NSA_SYNC(0);   \
        _Pragma("unroll 1") for (int s = 0; s < nblk_; ++s) { \
            if (s + 1 < nblk_) { const int sb_ = s + 1, slot_ = (s + 1) & 1; STAGE; } \
            { const LAS unsigned char* slotp = lds + (s & 1) * NL_RING; __VA_ARGS__; } \
            NSA_SYNC(0); } } while (0)
#define RING_LOOP4(NBLK, STAGE, ...) do { const int nblk_ = (NBLK); \
        { const int sb_ = 0, slot_ = 0; STAGE; } if (nblk_ > 1) { const int sb_ = 1, slot_ = 1; STAGE; } if (nblk_ > 2) { const int sb_ = 2, slot_ = 2; STAGE; } \
        if (nblk_ > 2) { NSA_SYNC(8); } else if (nblk_ > 1) { NSA_SYNC(4); } else { NSA_SYNC(0); } \
        int cs_ = 0; \
        _Pragma("unroll 1") for (int st_ = 0; st_ < 2 * nblk_; ++st_) { \
            const int s = st_ >> 1, kt = st_ & 1; \
            if (kt == 0 && s + 3 < nblk_) { const int sb_ = s + 3, slot_ = (cs_ + 3) & 3; STAGE; } \
            { const LAS unsigned char* slotp = lds + cs_ * NL_RING; __VA_ARGS__; } \
            if (kt == 1) { if (s + 3 < nblk_) { NSA_SYNC(8); } else if (s + 2 < nblk_) { NSA_SYNC(4); } else { NSA_SYNC(0); } cs_ = (cs_ + 1) & 3; } } } while (0)
    const int nvis = t >= 31 ? min((t - 31) / 16 + 1, NCMP) : 0;
    const int nbc = (min(4 * tile + 3, NCMP) + 63) >> 6;
    const unsigned char* kcb = ws + WS_KC + (size_t)(b * 2 + g) * 8 * 16384; const unsigned char* vcb = ws + WS_VC + (size_t)(b * 2 + g) * 8 * 16384;
    m = -3e38f; l = 0.f;
    RING_LOOP2(nbc, 2, nsa_stage(lds, slot_, kcb + (size_t)sb_ * 16384, vcb, false, tid, wave),
              (nsa_tile<3, 0>(slotp, slotp + 16384, kt, qlds, Qh, O, m, l, true, tl, nvis - 64 * s - 32 * kt, 0.f, IMP, 0, r32, hi)));
    nsa_stage(lds, 0, kcb, vcb, true, tid, wave);
    {
        const float il = 1.f / fmaxf(l, 1e-30f);
        O_ZERO();
        RING_LOOP2(nbc, 4, nsa_stage(lds, slot_, kcb + (size_t)sb_ * 16384, vcb + (size_t)sb_ * 16384, true, tid, wave),
                  (nsa_tile<3, 1>(slotp, slotp + 16384, kt, qlds, Qh, O, m, l, true, tl, nvis - 64 * s - 32 * kt, il, IMP + tl * NSEL, 16 * s + 8 * kt, r32, hi)));
        nsa_stage(lds, 0, ws + WS_KSR + (size_t)(bg * 128) * 16384, ws + WS_VST + (size_t)(bg * 128) * 16384, true, tid, wave);
        const float gt = sigmoidf_(bf2f(PROJ[(size_t)tok * DINP + C_NG + head * 3 + 0]));
        OB_PTR();
#pragma unroll
        for (int mt = 0; mt < 4; ++mt)
#pragma unroll
            for (int q = 0; q < 4; ++q) { u32x2 w; w.x = pk2(O[mt][4 * q] * gt, O[mt][4 * q + 1] * gt); w.y = pk2(O[mt][4 * q + 2] * gt, O[mt][4 * q + 3] * gt); *(u32x2*)(ob + 32 * mt + 8 * q) = w; }
    }
    {
#pragma unroll 1
        for (int tt = 0; tt < 8; ++tt) { const int tokl = 8 * wave + tt; const LAS float* ip = IMP + tokl * NSEL;
            unsigned key0 = 0u, key1 = 0u;
            { const int s0 = lane, s1 = lane + 64;
                if (s0 <= cur) { const bool forced = (s0 == 0) || (s0 == cur) || (s0 == cur - 1); key0 = ((__builtin_bit_cast(unsigned, ip[s0] + (forced ? 1e4f : 0.f)) | 0x80u) & ~0x7Fu) | (unsigned)(127 - s0); }
                if (s1 <= cur) { const bool forced = (s1 == cur) || (s1 == cur - 1); key1 = ((__builtin_bit_cast(unsigned, ip[s1] + (forced ? 1e4f : 0.f)) | 0x80u) & ~0x7Fu) | (unsigned)(127 - s1); } }
            unsigned thr = 0u;
#pragma unroll 4
            for (int bit = 31; bit >= 0; --bit) { const unsigned trial = thr | (1u << bit);
                const int cnt = __popcll(__ballot(key0 >= trial)) + __popcll(__ballot(key1 >= trial));
                thr = (cnt >= TOPN) ? trial : thr; }
            const unsigned long long b0 = __ballot(key0 != 0u && key0 >= thr), b1 = __ballot(key1 != 0u && key1 >= thr);
            if (lane == 0) { SELM[tokl * 4 + 0] = (unsigned)b0; SELM[tokl * 4 + 1] = (unsigned)(b0 >> 32); SELM[tokl * 4 + 2] = (unsigned)b1; SELM[tokl * 4 + 3] = (unsigned)(b1 >> 32); }
        }
        LDS_FENCE();
    }
    __syncthreads();
    LAS unsigned char* const qf = lds + NL_QF + wave * 8192 + hi * 512 + r32 * 16;
    { int tk_ = tok; asm volatile("" : "+v"(tk_)); const bf16_t* qr = (const bf16_t*)(ws + WS_QR) + (size_t)tk_ * D + head * 128 + 8 * hi;
#pragma unroll
        for (int ks = 0; ks < 8; ++ks) *(LAS bf16x8*)(qf + ks * 1024) = *(const bf16x8*)(qr + 16 * ks); }
    {
        const unsigned char* kb0 = ws + WS_KSR + (size_t)(b * 2 + g) * 128 * 16384; const unsigned char* vb0 = ws + WS_VST + (size_t)(b * 2 + g) * 128 * 16384;
        m = -3e38f; l = 0.f; O_ZERO();
        RING_LOOPB2(cur + 1, nsa_stage(lds, slot_, kb0 + (size_t)sb_ * 16384, vb0 + (size_t)sb_ * 16384, true, tid, wave),
                  { const bool colok = (SELM[tl * 4 + (s >> 5)] >> (s & 31)) & 1u;
                    if (__any(colok)) { if (s == cur) nsa_block<1>(slotp, qf, O, m, l, colok, tl, r32, hi); else nsa_block<0>(slotp, qf, O, m, l, colok, tl, r32, hi); } });
        { const int slo_ = cur >= 8 ? cur - 8 : 0; nsa_stage(lds, 0, ws + WS_KWR + (size_t)(bg * 128 + slo_) * 16384, ws + WS_VWT + (size_t)(bg * 128 + slo_) * 16384, true, tid, wave); }
        const float gt = sigmoidf_(bf2f(PROJ[(size_t)tok * DINP + C_NG + head * 3 + 1])) / fmaxf(l, 1e-30f);
        OB_PTR();
        u32x2 ow[16];
#pragma unroll
        for (int i = 0; i < 16; ++i) ow[i] = *(const u32x2*)(ob + 32 * (i >> 2) + 8 * (i & 3));
        asm volatile("" ::: "memory");
#pragma unroll
        for (int mt = 0; mt < 4; ++mt)
#pragma unroll
            for (int q = 0; q < 4; ++q) { u32x2 w = ow[mt * 4 + q];
                w.x = pk2(bflo(w.x) + O[mt][4 * q] * gt, bfhi(w.x) + O[mt][4 * q + 1] * gt); w.y = pk2(bflo(w.y) + O[mt][4 * q + 2] * gt, bfhi(w.y) + O[mt][4 * q + 3] * gt); *(u32x2*)(ob + 32 * mt + 8 * q) = w; }
    }
    {
        const int slo = cur >= 8 ? cur - 8 : 0;
        const unsigned char* kb0 = ws + WS_KWR + (size_t)((b * 2 + g) * 128 + slo) * 16384; const unsigned char* vb0 = ws + WS_VWT + (size_t)((b * 2 + g) * 128 + slo) * 16384;
        m = -3e38f; l = 0.f; O_ZERO();
        RING_LOOPB2(cur - slo + 1, nsa_stage(lds, slot_, kb0 + (size_t)sb_ * 16384, vb0 + (size_t)sb_ * 16384, true, tid, wave),
                  { const int sa = slo + s; if (sa == cur) nsa_block<1>(slotp, qf, O, m, l, true, tl, r32, hi);
                    else if (sa == cur - 8) nsa_block<2>(slotp, qf, O, m, l, true, tl, r32, hi);
                    else nsa_block<0>(slotp, qf, O, m, l, true, tl, r32, hi); });
        const float gt = sigmoidf_(bf2f(PROJ[(size_t)tok * DINP + C_NG + head * 3 + 2])) / fmaxf(l, 1e-30f);
        OB_PTR();
        u32x2 ow[16];
#pragma unroll
        for (int i = 0; i < 16; ++i) ow[i] = *(const u32x2*)(ob + 32 * (i >> 2) + 8 * (i & 3));
        asm volatile("" ::: "memory");
#pragma unroll
        for (int mt = 0; mt < 4; ++mt)
#pragma unroll
            for (int q = 0; q < 4; ++q) { u32x2 w = ow[mt * 4 + q];
                w.x = pk2(bflo(w.x) + O[mt][4 * q] * gt, bfhi(w.x) + O[mt][4 * q + 1] * gt); w.y = pk2(bflo(w.y) + O[mt][4 * q + 2] * gt, bfhi(w.y) + O[mt][4 * q + 3] * gt); *(u32x2*)(ob + 32 * mt + 8 * q) = w; }
    }
    asm volatile("s_waitcnt vmcnt(0)" ::: "memory");
#undef OB_PTR
#undef O_ZERO
}

__device__ __forceinline__ void cmp_item(const Params& p, unsigned char* ws, LAS unsigned char* lds, int item, int tid, int lane, int wave) {
    const int which = item >> 6, b = (item >> 5) & 1, g = (item >> 4) & 1, n0 = (item & 15) * 32;
    const bf16_t* PROJ = (const bf16_t*)(ws + WS_PROJ);
    const int ccol = (which ? C_NVC : C_NKC) + g * 128;
    const float* pe = p.in[which ? 11 : 8];
    const unsigned char* w1t = ws + WS_W1T + (size_t)which * 128 * 4096 * 2;
    const int fr = lane & 15, fq = lane >> 4;
    LAS unsigned char* LA = lds; LAS unsigned char* LB = lds + 16384; LAS bf16_t* HID = (LAS bf16_t*)(lds + 81920); LAS bf16_t* W2L = (LAS bf16_t*)(lds + 90624);
    __syncthreads();
    { const bf16_t* w2t = (const bf16_t*)(ws + WS_W2T) + which * 128 * 128;
        for (int idx = tid; idx < 128 * 16; idx += NTHREADS) { const int rr = idx >> 4, c = idx & 15; *(LAS u32x4*)(W2L + rr * PK + c * 8) = *(const u32x4*)(w2t + rr * 128 + c * 8); } }
    const int arow = tid >> 4, ach = tid & 15;
    auto stageB = [&](int pp, int buf) {
#pragma unroll
        for (int i = 0; i < 4; ++i) { const int pi = tid + 512 * i, row = pi >> 4, ch = (pi & 15) ^ (row & 15);
            __builtin_amdgcn_global_load_lds((const unsigned*)(w1t + (size_t)row * 8192 + pp * 256 + ch * 16), (LAS unsigned*)(LB + buf * 32768 + (i * 512 + wave * 64) * 16), 16, 0, 0); } };
    auto loadA = [&](int pp) -> u32x4 { const int tkn = 16 * (n0 + arow) + pp;
        if (tkn >= T) return (u32x4){0u, 0u, 0u, 0u};
        const u32x4 x = *(const u32x4*)(PROJ + (size_t)(b * T + tkn) * DINP + ccol + ach * 8); const f32x4 e0 = *(const f32x4*)(pe + pp * 128 + ach * 8), e1 = *(const f32x4*)(pe + pp * 128 + ach * 8 + 4);
        u32x4 o; o.x = pk2(bflo(x.x) + e0.x, bfhi(x.x) + e0.y); o.y = pk2(bflo(x.y) + e0.z, bfhi(x.y) + e0.w); o.z = pk2(bflo(x.z) + e1.x, bfhi(x.z) + e1.y); o.w = pk2(bflo(x.w) + e1.z, bfhi(x.w) + e1.w); return o; };
    f32x4 acc[2] = {(f32x4){0.f, 0.f, 0.f, 0.f}, (f32x4){0.f, 0.f, 0.f, 0.f}};
    stageB(0, 0); u32x4 areg = loadA(0);
    *(LAS u32x4*)(LA + arow * 256 + ((ach ^ (arow & 15)) << 4)) = areg;
    asm volatile("s_waitcnt vmcnt(0)" ::: "memory"); __syncthreads();
#pragma unroll 1
    for (int pp = 0; pp < 32; ++pp) { const int buf = pp & 1;
        if (pp + 1 < 32) { stageB(pp + 1, buf ^ 1); areg = loadA(pp + 1); }
        const LAS unsigned char* Ab = LA + buf * 8192; const LAS unsigned char* Bb = LB + buf * 32768;
#pragma unroll
        for (int kk = 0; kk < 4; ++kk) { const int wrow = 16 * wave + fr;
            const bf16x8 wf = *(const LAS bf16x8*)(Bb + wrow * 256 + (((4 * kk + fq) ^ (wrow & 15)) << 4));
#pragma unroll
            for (int nt = 0; nt < 2; ++nt) { const int nrow = 16 * nt + fr;
                acc[nt] = MFMA16(wf, *(const LAS bf16x8*)(Ab + nrow * 256 + (((4 * kk + fq) ^ (nrow & 15)) << 4)), acc[nt]); } }
        if (pp + 1 < 32) *(LAS u32x4*)(LA + (buf ^ 1) * 8192 + arow * 256 + ((ach ^ (arow & 15)) << 4)) = areg;
        asm volatile("s_waitcnt vmcnt(0)" ::: "memory"); __syncthreads();
    }
#pragma unroll
    for (int nt = 0; nt < 2; ++nt) { f32x4 hv;
#pragma unroll
        for (int r = 0; r < 4; ++r) hv[r] = siluf_(acc[nt][r]);
        *(LAS u32x2*)(HID + (16 * nt + fr) * PK + 16 * wave + 4 * fq) = pk4(hv); }
    __syncthreads();
    if (which == 0) {
        f32x4 o[2] = {(f32x4){0.f, 0.f, 0.f, 0.f}, (f32x4){0.f, 0.f, 0.f, 0.f}};
#pragma unroll
        for (int kk = 0; kk < 4; ++kk) { const bf16x8 af = FRAG(W2L, PK, 16 * wave + fr, 32 * kk + 8 * fq);
#pragma unroll
            for (int nt = 0; nt < 2; ++nt) o[nt] = MFMA16(af, FRAG(HID, PK, 16 * nt + fr, 32 * kk + 8 * fq), o[nt]); }
#pragma unroll
        for (int nt = 0; nt < 2; ++nt) { const int n = n0 + 16 * nt + fr; const f32x4 z = {0.f, 0.f, 0.f, 0.f};
            *(u32x2*)((bf16_t*)(ws + WS_KC) + ((size_t)((b * 2 + g) * 8 + (n >> 6)) << 13) + kimg_off(n & 63, 16 * wave + 4 * fq)) = pk4(n < NCMP ? o[nt] : z); }
    } else {
        f32x4 o[2] = {(f32x4){0.f, 0.f, 0.f, 0.f}, (f32x4){0.f, 0.f, 0.f, 0.f}};
#pragma unroll
        for (int kk = 0; kk < 4; ++kk) { const bf16x8 bfw = FRAG(W2L, PK, 16 * wave + fr, 32 * kk + 8 * fq);
#pragma unroll
            for (int nt = 0; nt < 2; ++nt) o[nt] = MFMA16(FRAG(HID, PK, 16 * nt + fr, 32 * kk + 8 * fq), bfw, o[nt]); }
#pragma unroll
        for (int nt = 0; nt < 2; ++nt) { f32x4 v = o[nt]; if (n0 + 16 * nt + 4 * fq + 3 >= NCMP) { if (n0 + 16 * nt + 4 * fq + 3 == NCMP) v[3] = 0.f; }
            { const int nb = n0 + 16 * nt; *(u32x2*)((bf16_t*)(ws + WS_VC) + ((size_t)((b * 2 + g) * 8 + (nb >> 6)) << 13) + vimg_off(16 * wave + fr, (nb & 63) + (fq & 1) * 8 + (fq >> 1) * 4)) = pk4(v); } }
    }
}

__device__ __forceinline__ void xattn_item(unsigned char* ws, LAS unsigned char* lds, int item, int tid, int lane, int wave) {
    const int b = item >> 7, h = (item >> 5) & 3, t0 = (item & 31) * 256;
    const int r32 = lane & 31, hi = lane >> 5, tok = b * T + t0 + 32 * wave + r32;
    LAS unsigned char* const qf = lds + NL_QF + wave * 8192 + hi * 512 + r32 * 16;
    __syncthreads();
#pragma unroll
    for (int ks = 0; ks < 8; ++ks) *(LAS bf16x8*)(qf + ks * 1024) = *(const bf16x8*)((const bf16_t*)(ws + WS_QX) + (size_t)tok * XD + h * 128 + 16 * ks + 8 * hi);
    f32x16 O[4]; float m = -3e38f, l = 0.f;
#pragma unroll
    for (int mt = 0; mt < 4; ++mt)
#pragma unroll
        for (int i = 0; i < 16; ++i) O[mt][i] = 0.f;
    const unsigned char* kb0 = ws + WS_XVT + 524288 + (size_t)(b * 4 + h) * 4 * 16384; const unsigned char* vb0 = ws + WS_XVT + (size_t)(b * 4 + h) * 4 * 16384;
    __syncthreads();
    nsa_stage(lds, 0, kb0, vb0, true, tid, wave);
    RING_LOOPB2(4, nsa_stage(lds, slot_, kb0 + (size_t)sb_ * 16384, vb0 + (size_t)sb_ * 16384, true, tid, wave),
              (nsa_block<0>(slotp, qf, O, m, l, true, 0, r32, hi)));
    const float il = 1.f / l;
    bf16_t* ox = (bf16_t*)(ws + WS_OX) + (size_t)tok * XD + h * 128 + 4 * hi;
#pragma unroll
    for (int mt = 0; mt < 4; ++mt)
#pragma unroll
        for (int q = 0; q < 4; ++q) { u32x2 w; w.x = pk2(O[mt][4 * q] * il, O[mt][4 * q + 1] * il); w.y = pk2(O[mt][4 * q + 2] * il, O[mt][4 * q + 3] * il); *(u32x2*)(ox + 32 * mt + 8 * q) = w; }
}


#define XB_TMO      128
#define XB_XCNT(j)  (256  + 64 * (j))
#define XB_XSUB(j)  (1280 + 64 * (j))
#define XB_XGEN(j)  (2304 + 64 * (j))
#define XB_TOP      3328
#define XB_TOPGEN   3392
#define XCD_BAR_WORDS 3456
#define XB_SPIN_CAP (1u << 18)
__device__ __forceinline__ unsigned xb_ld(unsigned* p)              { return __hip_atomic_load(p, __ATOMIC_RELAXED, __HIP_MEMORY_SCOPE_AGENT); }
__device__ __forceinline__ unsigned xb_add(unsigned* p, unsigned v) { return __hip_atomic_fetch_add(p, v, __ATOMIC_RELAXED, __HIP_MEMORY_SCOPE_AGENT); }
__device__ __forceinline__ unsigned xb_xcc_id() { return (unsigned)__builtin_amdgcn_s_getreg((3 << 11) | 20) & 0xFu; }
#define XB_SPIN(cond, bar) do { unsigned _sp = 0; while (cond) { __builtin_amdgcn_s_sleep(1); \
    if ((++_sp & 255u) == 0u) { if (xb_ld(&(bar)[XB_TMO])) break; if (_sp > XB_SPIN_CAP) { atomicAdd(&(bar)[XB_TMO], 1u); break; } } } } while (0)
struct XcdBarrier { unsigned* bar; unsigned x; volatile LAS unsigned* st; };
__device__ __forceinline__ XcdBarrier xcd_barrier_post(unsigned* bar, volatile LAS unsigned* st) {
    XcdBarrier b; b.bar = bar; b.x = xb_xcc_id(); b.st = st;
    if (threadIdx.x == 0) (void)xb_add(&bar[XB_XCNT(b.x)], 1u);
    return b;
}
__device__ __forceinline__ void xcd_barrier_complete(unsigned* bar, unsigned x, unsigned& nloc, unsigned& nx) {
    const unsigned G = gridDim.x * gridDim.y * gridDim.z;
    unsigned sum, cnt, mine, sp = 0u;
    for (;;) {
        sum = 0u; cnt = 0u; mine = 0u;
#pragma unroll
        for (unsigned j = 0; j < 16; ++j) { const unsigned c = xb_ld(&bar[XB_XCNT(j)]); sum += c; cnt += (c > 0u) ? 1u : 0u; mine = (j == x) ? c : mine; }
        if (sum == G) break;
        __builtin_amdgcn_s_sleep(1);
        if ((++sp & 255u) == 0u) { if (xb_ld(&bar[XB_TMO])) break; if (sp > XB_SPIN_CAP) { atomicAdd(&bar[XB_TMO], 1u); break; } }
    }
    nloc = mine > 0u ? mine : 1u; nx = cnt > 0u ? cnt : 1u;
}
__device__ __forceinline__ void xcd_barrier(const XcdBarrier& b) {
    asm volatile("s_waitcnt vmcnt(0)" ::: "memory");
    __syncthreads();
    if (threadIdx.x == 0) {
        unsigned* bar = b.bar;
        __builtin_amdgcn_s_waitcnt(0);
        unsigned nloc = b.st[0], nx = b.st[1];
        if (nloc == 0u) { xcd_barrier_complete(bar, b.x, nloc, nx); b.st[0] = nloc; b.st[1] = nx; }
        const unsigned old = xb_add(&bar[XB_XSUB(b.x)], 1u);
        const unsigned gen = old / nloc;
        if (old + 1u == (gen + 1u) * nloc) {
            __builtin_amdgcn_fence(__ATOMIC_RELEASE, "agent");
            asm volatile("s_waitcnt vmcnt(0)" ::: "memory");
            const unsigned og = xb_add(&bar[XB_TOP], 1u);
            const unsigned tg = og / nx;
            if (og + 1u == (tg + 1u) * nx) xb_add(&bar[XB_TOPGEN], 1u);
            else XB_SPIN(xb_ld(&bar[XB_TOPGEN]) == tg, bar);
            __builtin_amdgcn_fence(__ATOMIC_ACQUIRE, "agent");
            xb_add(&bar[XB_XGEN(b.x)], 1u);
            asm volatile("s_waitcnt vmcnt(0)" ::: "memory");
        } else {
            XB_SPIN(xb_ld(&bar[XB_XGEN(b.x)]) == gen, bar);
            __builtin_amdgcn_fence(__ATOMIC_ACQUIRE, "agent");
            asm volatile("s_waitcnt vmcnt(0)" ::: "memory");
        }
    }
    __syncthreads();
}

__global__ void __launch_bounds__(NTHREADS) mega(Params p) {
    extern __shared__ __attribute__((aligned(16))) unsigned char smem[];
    LAS unsigned char* lds = (LAS unsigned char*)smem;
    cg::grid_group grid = cg::this_grid();
    const int tid = threadIdx.x, lane = tid & 63, wave = __builtin_amdgcn_readfirstlane(tid >> 6);
    const int G = gridDim.x, bx = blockIdx.x;
    const int gw = bx * NWAVES + wave, NGW = G * NWAVES;
    unsigned char* ws = p.ws;
    const float* x = p.in[0];
    bf16_t* PROJ = (bf16_t*)(ws + WS_PROJ); bf16_t* Hb = (bf16_t*)(ws + WS_H);
    unsigned* ctl = (unsigned*)(ws + WS_CTL);
    const int lo = p.ph_lo, hi = p.ph_hi;
#define IN(k) (lo <= (k) && (k) < hi)
#ifndef PROBE_MASK
#define PROBE_MASK 0
#endif
#define PH(k) if (IN(k)) for (int rep_ = 0; rep_ < (((PROBE_MASK >> (k)) & 1) ? 2 : 1); ++rep_)
    volatile LAS unsigned* xst = (volatile LAS unsigned*)(lds + 131072 + 14336);
    if (tid < 2) xst[tid] = 0u;
    __syncthreads();
    const XcdBarrier xbar = xcd_barrier_post(ctl + CW_BAR, xst);
#define SEAM(k) do { if (IN(k) && IN((k) + 1)) { if ((k) == 0) grid.sync(); else xcd_barrier(xbar); } } while (0)

    PH(0) {
        LAS float* scr = (LAS float*)(lds + wave * 16384);
        constexpr int I_IN = 16 * (DINP / 32), I_SQ = 16 * 32, I_XQ = 16 * 16, I_XKV = 16 * 32, I_XO = 8 * 32, I_GU = NE * 16 * 64, I_DN = NE * 16 * 32, I_W1 = 64 * 4, I_W2 = 2 * 4;
        constexpr int NITEMS = I_IN + 3 * I_SQ + I_XQ + I_XKV + I_XO + 2 * I_W1 + 2 * I_W2 + I_GU + I_DN;
        auto decode = [&](int it) -> TrItem {
            int r = it;
            if (r < I_IN) { const int nb = r % (DINP / 32), kb = r / (DINP / 32); return TrItem{p.in[3], (bf16_t*)(ws + WS_WIN_T), D, DIN, DIN, nb * 32, kb * 64, nb * 32}; } r -= I_IN;
            if (r < I_SQ) { const int nb = r % 32, kb = r / 32; return TrItem{p.in[14], (bf16_t*)(ws + WS_WA_T), D, D, D, nb * 32, kb * 64, nb * 32}; } r -= I_SQ;
            if (r < I_SQ) { const int nb = r % 32, kb = r / 32; return TrItem{p.in[15], (bf16_t*)(ws + WS_WB_T), D, D, D, nb * 32, kb * 64, nb * 32}; } r -= I_SQ;
            if (r < I_SQ) { const int nb = r % 32, kb = r / 32; return TrItem{p.in[16], (bf16_t*)(ws + WS_WMIX_T), D, D, D, nb * 32, kb * 64, nb * 32}; } r -= I_SQ;
            if (r < I_XQ) { const int nb = r % 16, kb = r / 16; return TrItem{p.in[19], (bf16_t*)(ws + WS_WXQ_T), D, XD, XD, nb * 32, kb * 64, nb * 32}; } r -= I_XQ;
            if (r < I_XKV) { const int nb = r % 32, kb = r / 32; return TrItem{p.in[20], (bf16_t*)(ws + WS_WXKV_T), D, 2 * XD, 2 * XD, nb * 32, kb * 64, nb * 32}; } r -= I_XKV;
            if (r < I_XO) { const int nb = r % 32, kb = r / 32; return TrItem{p.in[21], (bf16_t*)(ws + WS_WXO_T), XD, D, D, nb * 32, kb * 64, nb * 32}; } r -= I_XO;
            if (r < I_W1) { const int nb = r % 4, kb = r / 4; return TrItem{p.in[9], (bf16_t*)(ws + WS_W1T), 4096, 128, 128, nb * 32, kb * 64, nb * 32}; } r -= I_W1;
            if (r < I_W1) { const int nb = r % 4, kb = r / 4; return TrItem{p.in[12], (bf16_t*)(ws + WS_W1T) + 128 * 4096, 4096, 128, 128, nb * 32, kb * 64, nb * 32}; } r -= I_W1;
            if (r < I_W2) { const int nb = r % 4, kb = r / 4; return TrItem{p.in[10], (bf16_t*)(ws + WS_W2T), 128, 128, 128, nb * 32, kb * 64, nb * 32}; } r -= I_W2;
            if (r < I_W2) { const int nb = r % 4, kb = r / 4; return TrItem{p.in[13], (bf16_t*)(ws + WS_W2T) + 128 * 128, 128, 128, 128, nb * 32, kb * 64, nb * 32}; } r -= I_W2;
            if (r < I_GU) { const int e = r / (16 * 64), q = r % (16 * 64), nb = q % 64, kb = q / 64; const int c0 = nb * 32, bj = c0 / 1024, cc = c0 % 1024;
                return TrItem{p.in[25] + (size_t)e * D * 2048, (bf16_t*)(ws + WS_WGU_T) + (size_t)e * 2048 * D, D, 2048, 2048, (cc / 128) * 256 + bj * 128 + (cc % 128), kb * 64, c0}; } r -= I_GU;
            { const int e = r / (16 * 32), q = r % (16 * 32), nb = q % 32, kb = q / 32;
                return TrItem{p.in[27] + (size_t)e * D * D, (bf16_t*)(ws + WS_WDN_T) + (size_t)e * D * D, D, D, D, nb * 32, kb * 64, nb * 32}; }
        };
        if (gw < NITEMS) {
            float v[32]; TrItem cur = decode(gw); tr_load(cur, v, lane);
            for (int it = gw; it < NITEMS; it += NGW) {
                tr_lds_write(v, scr, lane);
                const bool has = it + NGW < NITEMS; TrItem nxt = cur;
                if (has) { nxt = decode(it + NGW); tr_load(nxt, v, lane); }
                asm volatile("" ::: "memory");
                tr_store(cur, scr, lane);
                cur = nxt;
            }
        }
        for (int m = gw; m < NT; m += 2 * NGW) { const int m2 = m + NGW; const bool hb = m2 < NT; const int mb = hb ? m2 : m;
            rms_rows2_to_bf16(x + (size_t)m * D, x + (size_t)mb * D, p.in[2], Hb + (size_t)m * D, Hb + (size_t)mb * D, hb, lane); }
        for (int m = gw; m < BATCH * MEM; m += NGW) rms_row_to_bf16(p.in[1] + (size_t)m * D, p.in[18], (bf16_t*)(ws + WS_MEMN) + (size_t)m * D, lane);
    }
    SEAM(0);

    PH(1) {
        { pg8::Gemm g{D, D, D}; pg8::DenseOrder S; S.init(NT, DINP, G, bx, Hb, D, ws + WS_WIN_T, D); EpiStoreBf16 E{PROJ, DINP}; pg8::gemm_phase(lds, g, S, E); }
        { pg8::Gemm g{D, D, D}; pg8::DenseOrder S; S.init(BATCH * MEM, 2 * XD, G, (bx + 8) % G, ws + WS_MEMN, D, ws + WS_WXKV_T, D); EpiStoreBf16 E{(bf16_t*)(ws + WS_KVM), 2 * XD}; pg8::gemm_phase(lds, g, S, E); }
    }
    SEAM(1);

    PH(2) {
        { LAS int* qslot = (LAS int*)(lds + 131072 + 12288);
            for (;;) {
                __syncthreads();
                if (tid == 0) *qslot = (int)atomicAdd(ctl + CW_QUEUE + 8 + rep_, 1u);
                __syncthreads();
                const int it = *qslot;
                if (it >= 128 + BATCH * 8 * 128) break;
                if (it < 128) cmp_item(p, ws, lds, it, tid, lane, wave); else gdn_chunk_item(p, ws, lds, it - 128, tid, lane, wave);
            }
        }
        __syncthreads();
        {
            bf16_t* QR = (bf16_t*)(ws + WS_QR); bf16_t* KSR = (bf16_t*)(ws + WS_KSR); bf16_t* KWR = (bf16_t*)(ws + WS_KWR);
            for (int tok = gw; tok < NT; tok += NGW) {
                const int t = tok & (T - 1);
                const int dd = 2 * lane; float c0 = 1.f, s0 = 0.f, c1 = 1.f, s1 = 0.f;
                if (lane < 16) { const int i0 = dd & 15, i1 = i0 + 1;
                    const double f0 = exp2(-18.931568569324174 * (double)i0 / 16.0), f1 = exp2(-18.931568569324174 * (double)i1 / 16.0);
                    double r0 = (double)t * f0 * 0.15915494309189535, r1 = (double)t * f1 * 0.15915494309189535; r0 -= floor(r0); r1 -= floor(r1);
                    const float a0 = (float)(r0 * 6.283185307179586), a1 = (float)(r1 * 6.283185307179586);
                    c0 = __cosf(a0); s0 = __sinf(a0); c1 = __cosf(a1); s1 = __sinf(a1); }
                unsigned vin[12];
#pragma unroll
                for (int hh = 0; hh < 12; ++hh) vin[hh] = *(const unsigned*)(PROJ + (size_t)tok * DINP + (hh < 8 ? C_NQ + hh * 128 : (hh < 10 ? C_NKS + (hh - 8) * 128 : C_NKW + (hh - 10) * 128)) + dd);
                asm volatile("" ::: "memory");
#pragma unroll
                for (int hh = 0; hh < 12; ++hh) {
                    bf16_t* dst = hh < 8 ? QR + (size_t)tok * D + hh * 128 + dd : ((hh < 10 ? KSR : KWR) + ((size_t)(((tok >> 13) * 2 + (hh & 1)) * 128 + (t >> 6)) << 13) + kimg_off(t & 63, dd));
                    const unsigned v = vin[hh]; float v0 = bflo(v), v1 = bfhi(v);
                    const float p0 = __shfl_xor(v0, 8), p1 = __shfl_xor(v1, 8);
                    if (lane < 8) { v0 = v0 * c0 - p0 * s0; v1 = v1 * c1 - p1 * s1; } else if (lane < 16) { v0 = v0 * c0 + p0 * s0; v1 = v1 * c1 + p1 * s1; }
                    *(unsigned*)dst = pk2(v0, v1);
                }
            }
        }
        {
            LAS bf16_t* tt = (LAS bf16_t*)lds;
            for (int it = bx; it < 2 * BATCH * 2 * 128; it += G) {
                const int which = it >> 9, b = (it >> 8) & 1, g = (it >> 7) & 1, blk = it & 127;
                __syncthreads();
                { const int tk = tid >> 3, c = tid & 7; const bf16_t* src = PROJ + (size_t)(b * T + blk * 64 + tk) * DINP + (which ? C_NVW : C_NVS) + g * 128 + c * 16;
                    const u32x4 x0 = *(const u32x4*)src, x1 = *(const u32x4*)(src + 8); const int pos = (tk & ~15) + vperm16(tk & 15);
                    const unsigned xs[8] = {x0.x, x0.y, x0.z, x0.w, x1.x, x1.y, x1.z, x1.w};
#pragma unroll
                    for (int e = 0; e < 8; ++e) { tt[(c * 16 + 2 * e) * 72 + pos] = (bf16_t)(xs[e] & 0xffffu); tt[(c * 16 + 2 * e + 1) * 72 + pos] = (bf16_t)(xs[e] >> 16); } }
                __syncthreads();
                { const int dv = tid >> 2, pc = tid & 3; const LAS u32x4* sp = (const LAS u32x4*)(tt + dv * 72 + pc * 16);
                    bf16_t* dst = (bf16_t*)(ws + (which ? WS_VWT : WS_VST)) + ((size_t)((b * 2 + g) * 128 + blk) << 13);
                    *(u32x4*)(dst + vimg_off(dv, pc * 16)) = sp[0]; *(u32x4*)(dst + vimg_off(dv, pc * 16 + 8)) = sp[1]; }
            }
            __syncthreads();
        }
        {
            LAS bf16_t* tt = (LAS bf16_t*)lds;
            for (int it = bx; it < BATCH * 4 * 4; it += G) {
                const int b = it >> 4, h = (it >> 2) & 3, blk = it & 3;
                __syncthreads();
                { const int tk = tid >> 3, c = tid & 7; const bf16_t* src = (const bf16_t*)(ws + WS_KVM) + (size_t)(b * MEM + blk * 64 + tk) * 1024 + 512 + h * 128 + c * 16;
                    const u32x4 x0 = *(const u32x4*)src, x1 = *(const u32x4*)(src + 8); const int pos = (tk & ~15) + vperm16(tk & 15);
                    const unsigned xs[8] = {x0.x, x0.y, x0.z, x0.w, x1.x, x1.y, x1.z, x1.w};
#pragma unroll
                    for (int e = 0; e < 8; ++e) { tt[(c * 16 + 2 * e) * 72 + pos] = (bf16_t)(xs[e] & 0xffffu); tt[(c * 16 + 2 * e + 1) * 72 + pos] = (bf16_t)(xs[e] >> 16); } }
                __syncthreads();
                { const int dv = tid >> 2, pc = tid & 3; const LAS u32x4* sp = (const LAS u32x4*)(tt + dv * 72 + pc * 16);
                    bf16_t* dst = (bf16_t*)(ws + WS_XVT) + ((size_t)((b * 4 + h) * 4 + blk) << 13);
                    *(u32x4*)(dst + vimg_off(dv, pc * 16)) = sp[0]; *(u32x4*)(dst + vimg_off(dv, pc * 16 + 8)) = sp[1]; }
                { const int tk = tid >> 3, c = tid & 7; const bf16_t* src = (const bf16_t*)(ws + WS_KVM) + (size_t)(b * MEM + blk * 64 + tk) * 1024 + h * 128 + c * 16;
                    bf16_t* dst = (bf16_t*)(ws + WS_XVT + 524288) + ((size_t)((b * 4 + h) * 4 + blk) << 13);
                    *(u32x4*)(dst + kimg_off(tk, c * 16)) = *(const u32x4*)src; *(u32x4*)(dst + kimg_off(tk, c * 16 + 8)) = *(const u32x4*)(src + 8); }
            }
            __syncthreads();
        }
    }
    SEAM(2);

    if (IN(3)) {
        if (bx < 32) { gdn_scan(ws, lds, bx, tid, lane, wave);
            if (tid == 0) { __builtin_amdgcn_fence(__ATOMIC_RELEASE, "agent"); asm volatile("s_waitcnt vmcnt(0)" ::: "memory"); __hip_atomic_fetch_add(ctl + CW_SCANDONE, 1u, __ATOMIC_RELAXED, __HIP_MEMORY_SCOPE_AGENT); } }
        {
            LAS int* qslot = (LAS int*)(lds + 131072 + 12288);
            for (;;) {
                __syncthreads();
                if (tid == 0) *qslot = (int)atomicAdd(ctl + CW_QUEUE, 1u);
                __syncthreads();
                const int it = *qslot;
                if (it >= 512) break;
                nsa_item(p, ws, lds, it, tid, lane, wave);
            }
        }
        {
            LAS int* qslot = (LAS int*)(lds + 131072 + 12288);
            if (tid == 0) { unsigned sp = 0; while (__hip_atomic_load(ctl + CW_SCANDONE, __ATOMIC_RELAXED, __HIP_MEMORY_SCOPE_AGENT) < 32u) { __builtin_amdgcn_s_sleep(2); if (++sp > (1u << 22)) break; }
                __builtin_amdgcn_fence(__ATOMIC_ACQUIRE, "agent"); asm volatile("s_waitcnt vmcnt(0)" ::: "memory"); }
            __syncthreads();
            const float* GO = (const float*)(ws + WS_GO); bf16_t* OA = (bf16_t*)(ws + WS_OA);
            for (;;) {
                __syncthreads();
                if (tid == 0) *qslot = (int)atomicAdd(ctl + CW_P4Q, 1u);
                __syncthreads();
                const int it0 = *qslot; if (it0 >= NT / 64) break;
                const float gn0 = p.in[7][2 * lane], gn1 = p.in[7][2 * lane + 1];
#pragma unroll 1
                for (int q0 = wave * 8; q0 < 512; q0 += NWAVES * 8) {
                    float v0[8], v1[8]; unsigned z[8];
#pragma unroll
                    for (int i = 0; i < 8; ++i) { const int q = q0 + i, tok = it0 * 64 + (q >> 3), h = q & 7; const size_t o = (size_t)tok * D + h * 128 + 2 * lane;
                        const f32x2v g2 = *(const f32x2v*)(GO + o); v0[i] = g2.x; v1[i] = g2.y; z[i] = *(const unsigned*)(PROJ + (size_t)tok * DINP + C_GZ + h * 128 + 2 * lane); }
                    asm volatile("" ::: "memory");
#pragma unroll
                    for (int i = 0; i < 8; ++i) { const int q = q0 + i, tok = it0 * 64 + (q >> 3), h = q & 7; const size_t o = (size_t)tok * D + h * 128 + 2 * lane;
                        const float r = __builtin_amdgcn_rsqf(wave_sum(v0[i] * v0[i] + v1[i] * v1[i]) * (1.f / 128.f) + 1e-6f);
                        *(unsigned*)(OA + o) = pk2(v0[i] * r * gn0 * siluf_(bflo(z[i])), v1[i] * r * gn1 * siluf_(bfhi(z[i]))); }
                }
            }
        }
    }
    SEAM(3);


    PH(5) {
        bf16_t* MIXED = (bf16_t*)(ws + WS_MIXED);
        { pg8::Gemm g{D, D, D}; pg8::DenseOrder S; S.init(NT, D, G, bx, ws + WS_OA, D, ws + WS_WA_T, D); EpiGate E{MIXED, PROJ, C_MA, 0}; pg8::gemm_phase(lds, g, S, E); }
        { pg8::Gemm g{D, D, D}; pg8::DenseOrder S; S.init(NT, D, G, bx, ws + WS_OB, D, ws + WS_WB_T, D); EpiGate E{MIXED, PROJ, C_MB, 1}; pg8::gemm_phase(lds, g, S, E); }
    }
    SEAM(5);

    PH(6) { pg8::Gemm g{D, D, D}; pg8::DenseOrder S; S.init(NT, D, G, bx, ws + WS_MIXED, D, ws + WS_WMIX_T, D);
        EpiResidualNorm E{(float*)(ws + WS_X1), x, Hb, p.in[17], (float*)(ctl + CW_SS1)}; pg8::gemm_phase(lds, g, S, E); }
    SEAM(6);
    PH(8) { pg8::Gemm g{D, D, D}; pg8::DenseOrder S; S.init(NT, XD, G, bx, Hb, D, ws + WS_WXQ_T, D); EpiScaleRowsBf16 E{(bf16_t*)(ws + WS_QX), XD, (const float*)(ctl + CW_SS1)}; pg8::gemm_phase(lds, g, S, E); }
    SEAM(8);
    PH(9) { for (int it = bx; it < BATCH * 4 * 32; it += G) xattn_item(ws, lds, it, tid, lane, wave); __syncthreads(); }
    SEAM(9);
    if (IN(10)) { pg8::Gemm g{XD, XD, XD}; pg8::DenseOrder S; S.init(NT, D, G, bx, ws + WS_OX, XD, ws + WS_WXO_T, XD); EpiResidualSS E{(float*)(ws + WS_X1), (const float*)(ws + WS_X1), (float*)(ctl + CW_SS2)}; pg8::gemm_phase(lds, g, S, E); }
    SEAM(10);
    PH(11) {
        LAS float* wl = (LAS float*)lds;
        LAS float* xch = (LAS float*)(lds + 131072);
        LAS int* lcnt = (LAS int*)(lds + 131072 + 8192);
        if (tid < 32) lcnt[tid] = 0;
        const float* X2 = (const float*)(ws + WS_X1);
        const int pr = wave >> 1, kh = wave & 1, tok0 = bx * 64 + pr * 16, li = lane & 15, kk = lane >> 4;
        const f32x4* xr = (const f32x4*)(X2 + (size_t)(tok0 + li) * D + kh * 512) + 2 * kk;
        f32x4 xv[32];
#pragma unroll
        for (int sc = 0; sc < 16; ++sc) { xv[2 * sc] = xr[8 * sc]; xv[2 * sc + 1] = xr[8 * sc + 1]; }
        const float rstd = __builtin_amdgcn_rsqf(((const float*)(ctl + CW_SS2))[tok0 + li] * (1.f / D) + 1e-6f);
        {
            const float* rwg = p.in[23];
#pragma unroll 1
            for (int b = 0; b < 16; b += 4) { float t[4][4];
#pragma unroll
                for (int q = 0; q < 4; ++q) { const int idx = (b + q) * 512 + tid, k4 = idx >> 5, e = idx & 31;
#pragma unroll
                    for (int s2 = 0; s2 < 4; ++s2) t[q][s2] = rwg[(4 * k4 + s2) * 32 + e]; }
#pragma unroll
                for (int q = 0; q < 4; ++q) { const int idx = (b + q) * 512 + tid; *(LAS f32x4*)(wl + idx * 4) = (f32x4){t[q][0], t[q][1], t[q][2], t[q][3]}; } }
        }
        __syncthreads();
        f32x4 acc0 = {0.f, 0.f, 0.f, 0.f}, acc1 = {0.f, 0.f, 0.f, 0.f};
        const f32x4* gr = (const f32x4*)(p.in[22] + kh * 512) + 2 * kk;
        u32x4* o8 = (u32x4*)(Hb + (size_t)(tok0 + li) * D + kh * 512) + kk;
        LAS const f32x4* wb = (LAS const f32x4*)wl + (kh * 128 + 2 * kk) * 32 + li;
#pragma unroll
        for (int sc = 0; sc < 16; ++sc) {
            const f32x4 g0 = gr[8 * sc], g1 = gr[8 * sc + 1];
            const f32x4 h0 = xv[2 * sc] * rstd * g0, h1 = xv[2 * sc + 1] * rstd * g1;
            u32x4 w; w.x = pk2(h0[0], h0[1]); w.y = pk2(h0[2], h0[3]); w.z = pk2(h1[0], h1[1]); w.w = pk2(h1[2], h1[3]);
            o8[4 * sc] = w;
            const f32x4 b00 = wb[(8 * sc) * 32], b01 = wb[(8 * sc) * 32 + 16], b10 = wb[(8 * sc + 1) * 32], b11 = wb[(8 * sc + 1) * 32 + 16];
#pragma unroll
            for (int s2 = 0; s2 < 4; ++s2) { acc0 = __builtin_amdgcn_mfma_f32_16x16x4f32(h0[s2], b00[s2], acc0, 0, 0, 0); acc1 = __builtin_amdgcn_mfma_f32_16x16x4f32(h0[s2], b01[s2], acc1, 0, 0, 0); }
#pragma unroll
            for (int s2 = 0; s2 < 4; ++s2) { acc0 = __builtin_amdgcn_mfma_f32_16x16x4f32(h1[s2], b10[s2], acc0, 0, 0, 0); acc1 = __builtin_amdgcn_mfma_f32_16x16x4f32(h1[s2], b11[s2], acc1, 0, 0, 0); }
        }
        if (kh == 1) {
#pragma unroll
            for (int r = 0; r < 4; ++r) { xch[pr * 512 + (4 * kk + r) * 32 + li] = acc0[r]; xch[pr * 512 + (4 * kk + r) * 32 + 16 + li] = acc1[r]; } }
        __syncthreads();
        int my_e[4] = {0, 0, 0, 0}, my_rk[4] = {0, 0, 0, 0}; float my_g[4] = {0.f, 0.f, 0.f, 0.f};
        if (kh == 0) {
            const float bias0 = p.in[24][li], bias1 = p.in[24][16 + li];
#pragma unroll
            for (int r = 0; r < 4; ++r) {
                float v0 = acc0[r] + xch[pr * 512 + (4 * kk + r) * 32 + li] + bias0, v1 = acc1[r] + xch[pr * 512 + (4 * kk + r) * 32 + 16 + li] + bias1;
                float tv[4]; int ti[4];
#pragma unroll
                for (int rk = 0; rk < 4; ++rk) { float bv; int bi; if (v0 >= v1) { bv = v0; bi = li; } else { bv = v1; bi = 16 + li; }
#pragma unroll
                    for (int o = 1; o < 16; o <<= 1) { const float ov = __shfl_xor(bv, o); const int oi = __shfl_xor(bi, o); if (ov > bv || (ov == bv && oi < bi)) { bv = ov; bi = oi; } }
                    tv[rk] = bv; ti[rk] = bi; if (bi == li) v0 = -3e38f; if (bi == 16 + li) v1 = -3e38f; }
                if (li == r) {
                    const float e1 = __expf(tv[1] - tv[0]), e2 = __expf(tv[2] - tv[0]), e3 = __expf(tv[3] - tv[0]), inv = 1.f / (1.f + e1 + e2 + e3);
                    my_g[0] = inv; my_g[1] = e1 * inv; my_g[2] = e2 * inv; my_g[3] = e3 * inv;
#pragma unroll
                    for (int rk = 0; rk < 4; ++rk) { my_e[rk] = ti[rk]; my_rk[rk] = __hip_atomic_fetch_add(lcnt + ti[rk], 1, __ATOMIC_RELAXED, __HIP_MEMORY_SCOPE_WORKGROUP); } }
            }
        }
        __syncthreads();
        if (tid < 32) lcnt[32 + tid] = (int)atomicAdd(ctl + CW_ECNT + tid, (unsigned)lcnt[tid]);
        __syncthreads();
        if (kh == 0 && li < 4) { const int tok = tok0 + 4 * kk + li; int* RT = (int*)(ws + WS_ROWTOK2); float* RG = (float*)(ws + WS_ROWGATE2); i32x4 pos;
#pragma unroll
            for (int rk = 0; rk < 4; ++rk) { const int q = my_e[rk] * NT + lcnt[32 + my_e[rk]] + my_rk[rk]; RT[q] = tok; RG[q] = my_g[rk]; pos[rk] = q; }
            *(i32x4*)((int*)(ws + WS_POS) + tok * 4) = pos; }
    }
    SEAM(11);
    LAS int* moe_cum = (LAS int*)(lds + 131072);
    if (IN(13) || IN(14) || IN(15)) {
        LAS int* tmp = moe_cum + 128;
        __syncthreads();
        if (tid < 32) tmp[tid] = (int)ctl[CW_ECNT + tid];
        __syncthreads();
        if (tid == 0) { int cumb = 0; moe_cum[0] = 0; for (int e = 0; e < NE; ++e) { cumb += (tmp[e] + MOEB - 1) / MOEB; moe_cum[e + 1] = cumb; } }
        __syncthreads();
    }
    PH(13) { pg8::Gemm g{D, D, D}; MoeOrder S{G, bx, 8, moe_cum, (const char*)Hb, (const char*)(ws + WS_WGU_T), (size_t)2048 * D * 2, (const int*)(ws + WS_ROWTOK2), 1};
        EpiSwiglu E{(bf16_t*)(ws + WS_ACT), p.in[26]}; pg8::gemm_phase<EpiSwiglu, MoeOrder, true>(lds, g, S, E); }
    SEAM(13);
    PH(14) { pg8::Gemm g{D, D, D}; MoeOrder S{G, bx, 4, moe_cum, (const char*)(ws + WS_ACT), (const char*)(ws + WS_WDN_T), (size_t)D * D * 2, (const int*)(ws + WS_ROWGATE2), 0};
        EpiDown E{(bf16_t*)(ws + WS_Y), p.in[28]}; pg8::gemm_phase(lds, g, S, E); }
    SEAM(14);
    PH(15) {
        const float* X2 = (const float*)(ws + WS_X1); const int* POS = (const int*)(ws + WS_POS); const bf16_t* Y = (const bf16_t*)(ws + WS_Y);
        for (int tok = gw; tok < NT; tok += NGW) {
            const f32x4* xr = (const f32x4*)(X2 + (size_t)tok * D) + lane; f32x4 v[4];
#pragma unroll
            for (int j = 0; j < 4; ++j) v[j] = xr[64 * j];
#pragma unroll
            for (int k = 0; k < 4; ++k) { const int q = POS[tok * 4 + k]; const u32x2* yr = (const u32x2*)(Y + (size_t)(moe_cum[q >> 14] * 256 + (q & (NT - 1))) * D) + lane;
#pragma unroll
                for (int j = 0; j < 4; ++j) { const u32x2 w = yr[64 * j]; v[j].x += bflo(w.x); v[j].y += bfhi(w.x); v[j].z += bflo(w.y); v[j].w += bfhi(w.y); } }
            float s = 0.f;
#pragma unroll
            for (int j = 0; j < 4; ++j) s += (v[j].x * v[j].x + v[j].y * v[j].y) + (v[j].z * v[j].z + v[j].w * v[j].w);
            const float rstd = __builtin_amdgcn_rsqf(wave_sum(s) * (1.f / D) + 1e-6f);
            f32x4* orow = (f32x4*)(p.out + (size_t)tok * D) + lane; const f32x4* gr = (const f32x4*)p.in[29] + lane;
#pragma unroll
            for (int j = 0; j < 4; ++j) { const f32x4 gg = gr[64 * j]; orow[64 * j] = (f32x4){v[j].x * rstd * gg.x, v[j].y * rstd * gg.y, v[j].z * rstd * gg.z, v[j].w * rstd * gg.w}; }
        }
    }
}

constexpr int NPHASES = 16;
extern "C" void kernel_launch(void* const* d_in, const int* in_sizes, int n_in, void* d_out, int out_size, void* d_ws, size_t ws_size, hipStream_t stream) {
    static int grid = 0;
    if (grid == 0) {
        int dev = 0, cus = 0, per_cu = 0;
        (void)hipGetDevice(&dev); (void)hipDeviceGetAttribute(&cus, hipDeviceAttributeMultiprocessorCount, dev);
        (void)hipFuncSetAttribute((const void*)mega, hipFuncAttributeMaxDynamicSharedMemorySize, LDS_BYTES);
        (void)hipOccupancyMaxActiveBlocksPerMultiprocessor(&per_cu, (const void*)mega, NTHREADS, LDS_BYTES);
        if (per_cu < 1) { fprintf(stderr, "occupancy query says %d blocks/CU\n", per_cu); per_cu = 1; }
        grid = cus * 1;
        if (ws_size < WS_END) fprintf(stderr, "workspace too small: %zu < %zu\n", ws_size, (size_t)WS_END);
    }
    (void)hipMemsetAsync((char*)d_ws + WS_CTL, 0, CTL_ZERO, stream);
    (void)hipMemsetAsync((char*)d_ws + WS_ROWTOK2, 0, (size_t)NE * NT * 4, stream);
    Params p{};
    for (int i = 0; i < 30; ++i) p.in[i] = (const float*)d_in[i];
    p.out = (float*)d_out; p.ws = (unsigned char*)d_ws;
#if SINGLE_LAUNCH
    p.ph_lo = 0; p.ph_hi = NPHASES;
    void* args[] = {&p};
    hipError_t e = hipLaunchCooperativeKernel((const void*)mega, dim3(grid), dim3(NTHREADS), args, LDS_BYTES, stream);
    if (e != hipSuccess) fprintf(stderr, "cooperative launch failed: %s (grid %d)\n", hipGetErrorString(e), grid);
#else
    for (int ph = 0; ph < NPHASES; ++ph) { p.ph_lo = ph; p.ph_hi = ph + 1; hipLaunchKernelGGL(mega, dim3(grid), dim3(NTHREADS), LDS_BYTES, stream, p); }
#endif
}
```

```cpp
#include <hip/hip_runtime.h>
#include <hip/hip_cooperative_groups.h>
#include <cstdio>
#include <cstdint>
namespace cg = cooperative_groups;

#ifndef SINGLE_LAUNCH
#define SINGLE_LAUNCH 1
#endif

#define LAS __attribute__((address_space(3)))
typedef unsigned short bf16_t;
typedef short bf16x8 __attribute__((ext_vector_type(8)));
typedef float f32x4 __attribute__((ext_vector_type(4)));
typedef unsigned u32x4 __attribute__((ext_vector_type(4)));
typedef int i32x4 __attribute__((ext_vector_type(4)));
typedef long i64x2v __attribute__((ext_vector_type(2)));
typedef int i32x4v __attribute__((ext_vector_type(4)));
typedef int i32x8v __attribute__((ext_vector_type(8)));
typedef unsigned u32x2 __attribute__((ext_vector_type(2)));

constexpr int BATCH = 2, T = 8192, NT = BATCH * T, D = 1024;
constexpr int DIN = 8744, DINP = 8960;
constexpr int C_GQ = 0, C_GK = 1024, C_GV = 2048, C_GZ = 3072, C_GB = 4096, C_GA = 4104, C_NQ = 4112, C_NKC = 5136, C_NVC = 5392,
              C_NKS = 5648, C_NVS = 5904, C_NKW = 6160, C_NVW = 6416, C_NG = 6672, C_MA = 6696, C_MB = 7720;
constexpr int NCMP = 511, NCMPP = 512, NSEL = 128, TOPN = 16, WIN = 512;
constexpr int MEM = 256, XD = 512;
constexpr int NE = 32, TOPK = 4, MOEB = 256, NROWS = NT * TOPK + NE * MOEB;
constexpr int NTHREADS = 512, NWAVES = 8;
constexpr int LDS_BYTES = 147456;

constexpr size_t MiB = 1u << 20;
constexpr size_t WS_CTL = 0, CTL_BYTES = 1 * MiB;
constexpr size_t WS_WIN_T = 1 * MiB, WS_WA_T = 19 * MiB, WS_WB_T = 21 * MiB, WS_WMIX_T = 23 * MiB, WS_WXQ_T = 25 * MiB, WS_WXKV_T = 26 * MiB,
                 WS_WXO_T = 28 * MiB, WS_WGU_T = 30 * MiB, WS_WDN_T = 158 * MiB;
constexpr size_t WS_H = 222 * MiB;
constexpr size_t WS_MEMN = 254 * MiB, WS_KVM = 255 * MiB;
constexpr size_t WS_PROJ = 256 * MiB;
constexpr size_t WS_CHK = 536 * MiB;
constexpr size_t WS_U = 648 * MiB;
constexpr size_t WS_GO = 712 * MiB;
constexpr size_t WS_XS = 256 * MiB, WS_ACT = 400 * MiB, WS_Y = 544 * MiB;
constexpr size_t WS_OA = 776 * MiB, WS_OB = 808 * MiB, WS_QR = 840 * MiB, WS_MIXED = 840 * MiB;
constexpr size_t WS_KSR = 872 * MiB, WS_KWR = 880 * MiB, WS_KC = 888 * MiB, WS_VC = 890 * MiB;
constexpr size_t WS_X1 = 892 * MiB;
constexpr size_t WS_QX = 956 * MiB, WS_OX = 972 * MiB;
constexpr size_t WS_GL = 988 * MiB;
constexpr size_t WS_TOPE = 989 * MiB, WS_TOPG = WS_TOPE + 256 * 1024, WS_POS = WS_TOPG + 256 * 1024, WS_ROWGATE = WS_POS + 256 * 1024;
constexpr size_t WS_ROWTOK = WS_ROWGATE + 512 * 1024;
constexpr size_t WS_VST = 991 * MiB, WS_VWT = 999 * MiB;
constexpr size_t WS_W1T = 1007 * MiB;
constexpr size_t WS_W2T = 1009 * MiB;
constexpr size_t WS_XVT = 1010 * MiB;
constexpr size_t WS_ROWTOK2 = 1011 * MiB;
constexpr size_t WS_ROWGATE2 = 1013 * MiB;
constexpr size_t WS_ROWRS2 = 1015 * MiB;
constexpr size_t WS_DNINV = 1017 * MiB;
constexpr size_t WS_END = 1018 * MiB;
constexpr int CH_NEGW = 0, CH_QD = 16384, CH_KDT = 32768, CH_QK = 49152, CH_BYTES = 57344;
constexpr int CW_QUEUE = 0;
constexpr int CW_SCANDONE = 64;
constexpr int CW_P4Q = 65;
constexpr int CW_ECNT = 96;
constexpr int CW_BLKCNT = 1024;
constexpr int CW_BAR = 16384;
constexpr int CW_SS1 = 32768;
constexpr int CW_SS2 = 49152;
constexpr size_t CTL_ZERO = 131072 + 65536 + 65536;

struct Params {
    const float* in[30];
    float* out;
    unsigned char* ws;
    int ph_lo, ph_hi;
};

__device__ __forceinline__ unsigned f2bf(float f) { unsigned u = __builtin_bit_cast(unsigned, f); return (u + 0x7fffu + ((u >> 16) & 1u)) >> 16; }
typedef float f32x2_t __attribute__((ext_vector_type(2)));
typedef __bf16 bf16x2_t __attribute__((ext_vector_type(2)));
__device__ __forceinline__ unsigned pk2(float lo, float hi) { f32x2_t v = {lo, hi}; bf16x2_t b = __builtin_convertvector(v, bf16x2_t); return __builtin_bit_cast(unsigned, b); }
__device__ __forceinline__ float bf2f(unsigned short v) { return __builtin_bit_cast(float, (unsigned)v << 16); }
__device__ __forceinline__ unsigned pk4_fp8(float a, float b, float c, float d) {
    a = __builtin_amdgcn_fmed3f(a, -448.f, 448.f); b = __builtin_amdgcn_fmed3f(b, -448.f, 448.f); c = __builtin_amdgcn_fmed3f(c, -448.f, 448.f); d = __builtin_amdgcn_fmed3f(d, -448.f, 448.f);
    int w = __builtin_amdgcn_cvt_pk_fp8_f32(a, b, 0, false); w = __builtin_amdgcn_cvt_pk_fp8_f32(c, d, w, true); return (unsigned)w; }
__device__ __forceinline__ int lane_id() { int r; asm volatile("v_mbcnt_lo_u32_b32 %0, -1, 0\n\tv_mbcnt_hi_u32_b32 %0, -1, %0" : "=v"(r)); return r; }
__device__ __forceinline__ float bflo(unsigned v) { return __builtin_bit_cast(float, v << 16); }
__device__ __forceinline__ float bfhi(unsigned v) { return __builtin_bit_cast(float, v & 0xffff0000u); }
__device__ __forceinline__ float wave_sum(float v) {
#pragma unroll
    for (int o = 1; o < 64; o <<= 1) v += __shfl_xor(v, o);
    return v;
}
__device__ __forceinline__ float wave_max(float v) {
#pragma unroll
    for (int o = 1; o < 64; o <<= 1) v = fmaxf(v, __shfl_xor(v, o));
    return v;
}
__device__ __forceinline__ float sigmoidf_(float x) { return __builtin_amdgcn_rcpf(1.f + __builtin_amdgcn_exp2f(x * -1.4426950408889634f)); }
__device__ __forceinline__ float siluf_(float x) { return x * __builtin_amdgcn_rcpf(1.f + __builtin_amdgcn_exp2f(x * -1.4426950408889634f)); }
#define LDS_FENCE() asm volatile("s_waitcnt lgkmcnt(0)" ::: "memory")

namespace pg8 {
constexpr int BM = 256, BK = 64, HALF = 128, HTB = HALF * BK * 2, NXCD = 8;
__device__ __forceinline__ int lds_byte(int r, int c) { const int st = (r >> 4) * 2 + (c >> 5), rr = r & 15, cc = c & 31, ob = rr * 64 + cc * 2; return st * 1024 + (ob ^ (((ob >> 9) & 1) << 5)); }
__device__ __forceinline__ void stage_rc(int b, int& R, int& C) { const int st = b / 1024, sb = b % 1024, swz = sb ^ (((sb >> 9) & 1) << 5); R = (st >> 1) * 16 + swz / 64; C = (st & 1) * 32 + (swz % 64) / 2; }
__device__ __forceinline__ int perm32(int rho) { const int n = rho >> 4, i = rho & 15; return 8 * (i >> 2) + 4 * n + (i & 3); }

struct Unit { int pm, pn, aux; const char* a; const char* b; const int* rows; };
struct Gemm { int lda, ldb, K; };

template <class Epi, class Sched, bool GATHER = false, bool FP8 = false>
__device__ __forceinline__ void gemm_phase(LAS unsigned char* lds, const Gemm g, const Sched& S, const Epi& E) {
    int tid_o = threadIdx.x; asm volatile("" : "+v"(tid_o));
    const int tid = tid_o, wid = __builtin_amdgcn_readfirstlane(tid >> 6), lane = tid & 63, wr = wid >> 2, wc = wid & 3, fr = lane & 15, fq = lane >> 4;
    const int K = g.K, nt = K / BK;
    unsigned voffA[2], voffB[2];
#pragma unroll
    for (int i = 0; i < 2; ++i) { int R, C; stage_rc(tid * 16 + i * 8192, R, C); const int Rb = (R & ~31) + perm32(R & 31);
        voffA[i] = (unsigned)(R * g.lda + C) * 2u; voffB[i] = (unsigned)(Rb * g.ldb + C) * 2u; }
    auto voffA_f = [&](int i) -> unsigned { int t4 = threadIdx.x; asm volatile("" : "+v"(t4)); int R, C; stage_rc(t4 * 16 + i * 8192, R, C); return (unsigned)(R * g.lda + C) * 2u; };
    auto voffB_f = [&](int i) -> unsigned { int t4 = threadIdx.x; asm volatile("" : "+v"(t4)); int R, C; stage_rc(t4 * 16 + i * 8192, R, C); const int Rb = (R & ~31) + perm32(R & 31); return (unsigned)(Rb * g.ldb + C) * 2u; };
    unsigned goff[2], gnoff[2];
    static_assert(NT <= 16384, "row tokens are packed in 14 bits");
    auto load_goff = [&](const Unit& u, unsigned (&o)[2]) {
        int t2 = wid * 64 + lane_id(); asm volatile("" : "+v"(t2));
#pragma unroll
        for (int i = 0; i < 2; ++i) { int gR, gC; stage_rc(t2 * 16 + i * 8192, gR, gC); o[i] = ((unsigned)u.rows[gR] & 0x3fffu) | (((unsigned)u.rows[HALF + gR] & 0x3fffu) << 14) | ((unsigned)(gC >> 3) << 28); } };
    auto gbyte = [&](unsigned pk, int h, int i) -> unsigned { (void)i; asm volatile("" : "+v"(pk)); return ((h ? (pk >> 14) : pk) & 0x3fffu) * (unsigned)(g.lda * 2) + ((pk >> 28) << 4); };
    const size_t kstep = (size_t)(BK * 2);
    const size_t hstepA = (size_t)HALF * g.lda * 2, hstepB = (size_t)HALF * g.ldb * 2;
    const unsigned ldsw = (unsigned)wid * 1024u;
    const int aoff = lds_byte(wr * 64 + fr, fq * 8), boff = lds_byte(wc * 32 + fr, fq * 8);
#define PG8_SA(b, h) (((b) * 2 + (h)) * HTB)
#define PG8_SB(b, h) ((4 + (b) * 2 + (h)) * HTB)
#define PG8_STAGE(bufoff, gbase, voff) do { const char* gb_ = (const char*)(gbase); asm volatile("" : "+s"(gb_)); _Pragma("unroll") for (int _i = 0; _i < 2; ++_i) { unsigned vo_ = (voff)[_i]; asm volatile("" : "+v"(vo_)); \
        __builtin_amdgcn_global_load_lds((const unsigned*)(gb_ + vo_), (LAS unsigned*)(lds + (bufoff) + ldsw + _i * 8192), 16, 0, 0); } } while (0)
#define PG8_STAGEG(bufoff, gbase, o0, o1) do { const char* gb_ = (const char*)(gbase); asm volatile("" : "+s"(gb_)); unsigned o0_ = (o0), o1_ = (o1); asm volatile("" : "+v"(o0_), "+v"(o1_)); \
        __builtin_amdgcn_global_load_lds((const unsigned*)(gb_ + o0_), (LAS unsigned*)(lds + (bufoff) + ldsw), 16, 0, 0); \
        __builtin_amdgcn_global_load_lds((const unsigned*)(gb_ + o1_), (LAS unsigned*)(lds + (bufoff) + ldsw + 8192), 16, 0, 0); } while (0)
#define PG8_STAGEA(bufoff, ptr, h, nx) do { if constexpr (GATHER) { PG8_STAGEG(bufoff, ptr, gbyte((nx) ? gnoff[0] : goff[0], h, 0), gbyte((nx) ? gnoff[1] : goff[1], h, 1)); } else { PG8_STAGE(bufoff, (ptr) + (h) * hstepA, voffA); } } while (0)
#define PG8_LDA(dst, b, h) do { _Pragma("unroll") for (int m = 0; m < ((FP8 && GATHER) ? 2 : 4); ++m) _Pragma("unroll") for (int k = 0; k < 2; ++k) dst[m][k] = *(const LAS bf16x8*)(lds + PG8_SA(b, h) + aoff + m * 2048 + k * 1024); } while (0)
#define PG8_LDB(dst, b, h) do { _Pragma("unroll") for (int n = 0; n < 2; ++n) _Pragma("unroll") for (int k = 0; k < 2; ++k) dst[n][k] = *(const LAS bf16x8*)(lds + PG8_SB(b, h) + boff + n * 2048 + k * 1024); } while (0)
#define PG8_MMA(ai, bj, At, Bt) do { __builtin_amdgcn_s_setprio(1); _Pragma("unroll") for (int m = 0; m < 4; ++m) _Pragma("unroll") for (int n = 0; n < 2; ++n) _Pragma("unroll") for (int k = 0; k < 2; ++k) { \
        if constexpr (FP8) { if (k == 0) { const i32x4v b0_ = __builtin_bit_cast(i32x4v, Bt[n][0]), b1_ = __builtin_bit_cast(i32x4v, Bt[n][1]), a0_ = __builtin_bit_cast(i32x4v, At[m][0]), a1_ = __builtin_bit_cast(i32x4v, At[m][1]); \
            acc[ai][bj][m][n] = __builtin_amdgcn_mfma_scale_f32_16x16x128_f8f6f4((i32x8v){b0_[0], b0_[1], b0_[2], b0_[3], b1_[0], b1_[1], b1_[2], b1_[3]}, (i32x8v){a0_[0], a0_[1], a0_[2], a0_[3], a1_[0], a1_[1], a1_[2], a1_[3]}, acc[ai][bj][m][n], 0, 0, 0, 0, 0, 0); } } \
        else acc[ai][bj][m][n] = __builtin_amdgcn_mfma_f32_16x16x32_bf16(Bt[n][k], At[m][k], acc[ai][bj][m][n], 0, 0, 0); } \
        __builtin_amdgcn_s_setprio(0); } while (0)
#define PG8_MF8(Bn, Am, C) do { const i32x4v b0_ = __builtin_bit_cast(i32x4v, Bn[0]), b1_ = __builtin_bit_cast(i32x4v, Bn[1]), a0_ = __builtin_bit_cast(i32x4v, Am[0]), a1_ = __builtin_bit_cast(i32x4v, Am[1]); \
        C = __builtin_amdgcn_mfma_scale_f32_16x16x128_f8f6f4((i32x8v){b0_[0], b0_[1], b0_[2], b0_[3], b1_[0], b1_[1], b1_[2], b1_[3]}, (i32x8v){a0_[0], a0_[1], a0_[2], a0_[3], a1_[0], a1_[1], a1_[2], a1_[3]}, C, 0, 0, 0, 0, 0, 0); } while (0)
#define PG8_MMAP(ai, b, h) do { if constexpr (FP8 && GATHER) { __builtin_amdgcn_s_setprio(1); \
            _Pragma("unroll") for (int m = 0; m < 2; ++m) _Pragma("unroll") for (int n = 0; n < 2; ++n) { PG8_MF8(B0[n], At[m], acc[ai][0][m][n]); PG8_MF8(B1[n], At[m], acc[ai][1][m][n]); } \
            __builtin_amdgcn_sched_barrier(0); \
            _Pragma("unroll") for (int m = 0; m < 2; ++m) _Pragma("unroll") for (int k = 0; k < 2; ++k) At[m][k] = *(const LAS bf16x8*)(lds + PG8_SA(b, h) + aoff + (m + 2) * 2048 + k * 1024); \
            asm volatile("s_waitcnt lgkmcnt(0)" ::: "memory"); __builtin_amdgcn_sched_barrier(0); \
            _Pragma("unroll") for (int m = 0; m < 2; ++m) _Pragma("unroll") for (int n = 0; n < 2; ++n) { PG8_MF8(B0[n], At[m], acc[ai][0][m + 2][n]); PG8_MF8(B1[n], At[m], acc[ai][1][m + 2][n]); } \
            __builtin_amdgcn_s_setprio(0); } \
        else { PG8_MMA(ai, 0, At, B0); PG8_MMA(ai, 1, At, B1); } } while (0)
#define PG8_WAIT_V(n) asm volatile("s_waitcnt vmcnt(" #n ")" ::: "memory")
#define PG8_WAIT_L(n) asm volatile("s_waitcnt lgkmcnt(" #n ")" ::: "memory")
#define PG8_BAR __builtin_amdgcn_s_barrier()
#define PG8_SCHED __builtin_amdgcn_sched_barrier(0)
    Unit cur, nxt; int ui = 0;
    if (!S.next(0, cur)) return;
    f32x4 acc[2][2][4][2];
#pragma unroll
    for (int a = 0; a < 2; ++a)
#pragma unroll
        for (int b = 0; b < 2; ++b)
#pragma unroll
            for (int m = 0; m < 4; ++m)
#pragma unroll
                for (int n = 0; n < 2; ++n) acc[a][b][m][n] = (f32x4){0.f, 0.f, 0.f, 0.f};
    bf16x8 At[4][2], B0[2][2], B1[2][2];
    const char* cA = cur.a; const char* cB = cur.b;
    if constexpr (GATHER) load_goff(cur, goff);
    PG8_STAGE(PG8_SB(0, 0), cB, voffB); PG8_STAGE(PG8_SB(0, 1), cB + hstepB, voffB); PG8_STAGEA(PG8_SA(0, 0), cA, 0, false); PG8_STAGEA(PG8_SA(0, 1), cA, 1, false);
    if (wr == 1) PG8_BAR;
    PG8_WAIT_V(2); PG8_BAR;
    PG8_STAGE(PG8_SB(1, 0), cB + kstep, voffB); PG8_STAGEA(PG8_SA(1, 0), cA + kstep, 0, false); PG8_STAGE(PG8_SB(1, 1), cB + hstepB + kstep, voffB);
    PG8_WAIT_V(6); PG8_BAR;
    for (;;) {
        const bool has_next = S.next(ui + 1, nxt);
        const char* nA = has_next ? nxt.a : cA; const char* nB = has_next ? nxt.b : cB;
        if constexpr (GATHER) { if (has_next) load_goff(nxt, gnoff); else { gnoff[0] = goff[0]; gnoff[1] = goff[1]; } }
        for (int t = 0; t < nt; t += 2) {
            const bool last = (t == nt - 2);
            const char* a1 = cA + (size_t)(t + 1) * kstep;
            const char* a2 = last ? nA : cA + (size_t)(t + 2) * kstep; const char* b2 = last ? nB : cB + (size_t)(t + 2) * kstep;
            const char* a3 = a2 + kstep; const char* b3 = b2 + kstep;
            PG8_LDB(B0, 0, 0); PG8_LDB(B1, 0, 1); PG8_SCHED; PG8_LDA(At, 0, 0); PG8_STAGEA(PG8_SA(1, 1), a1, 1, false);
            PG8_WAIT_V(8); PG8_WAIT_L(0); PG8_BAR; PG8_MMAP(0, 0, 0); PG8_BAR; PG8_SCHED;
            PG8_LDA(At, 0, 1); PG8_STAGE(PG8_SB(0, 0), b2, voffB); PG8_STAGE(PG8_SB(0, 1), b2 + hstepB, voffB); PG8_STAGEA(PG8_SA(0, 0), a2, 0, last);
            PG8_WAIT_V(8); PG8_WAIT_L(0); PG8_BAR; PG8_MMAP(1, 0, 1); PG8_BAR; PG8_SCHED;
            PG8_LDB(B0, 1, 0); PG8_LDB(B1, 1, 1); PG8_SCHED; PG8_LDA(At, 1, 0); PG8_STAGEA(PG8_SA(0, 1), a2, 1, last);
            PG8_WAIT_V(8); PG8_WAIT_L(0); PG8_BAR; PG8_MMAP(0, 1, 0); PG8_BAR; PG8_SCHED;
            PG8_LDA(At, 1, 1); PG8_STAGE(PG8_SB(1, 0), b3, voffB); PG8_STAGE(PG8_SB(1, 1), b3 + hstepB, voffB); PG8_STAGEA(PG8_SA(1, 0), a3, 0, last);
            PG8_WAIT_V(8); PG8_WAIT_L(0); PG8_BAR; PG8_MMAP(1, 1, 1); PG8_BAR; PG8_SCHED;
        }
        if (wr == 0) PG8_BAR;
        E(acc, cur, wr, wc, fr, fq);
        if (!has_next) break;
#pragma unroll
        for (int a = 0; a < 2; ++a)
#pragma unroll
            for (int b = 0; b < 2; ++b)
#pragma unroll
                for (int m = 0; m < 4; ++m)
#pragma unroll
                    for (int n = 0; n < 2; ++n) acc[a][b][m][n] = (f32x4){0.f, 0.f, 0.f, 0.f};
        cur = nxt; cA = nA; cB = nB; ++ui;
        if constexpr (GATHER) { goff[0] = gnoff[0]; goff[1] = gnoff[1]; }
        if (wr == 1) PG8_BAR;
    }
    PG8_WAIT_V(0);
    PG8_BAR;
#undef PG8_SA
#undef PG8_SB
#undef PG8_STAGE
#undef PG8_STAGEG
#undef PG8_STAGEA
#undef PG8_LDA
#undef PG8_LDB
#undef PG8_MMA
#undef PG8_MMAP
#undef PG8_MF8
#undef PG8_WAIT_V
#undef PG8_WAIT_L
#undef PG8_BAR
#undef PG8_SCHED
}

struct DenseOrder {
    int nM, nN, nwg, G, c, WGM; const char* A; const char* Bt; size_t tstepA, tstepB;
    __device__ void init(int M, int N, int G_, int c_, const void* A_, int lda, const void* Bt_, int ldb, int wgm = 5) {
        nM = M / BM; nN = N / BM; nwg = nM * nN; G = G_; c = c_; WGM = wgm; A = (const char*)A_; Bt = (const char*)Bt_; tstepA = (size_t)BM * lda * 2; tstepB = (size_t)BM * ldb * 2; }
    __device__ bool next(int i, Unit& u) const {
        const long L = (long)i * G + c; if (L >= nwg) return false;
        int wgid = (int)L; { const int q = nwg / NXCD, r = nwg % NXCD, xcd = wgid % NXCD, off = wgid / NXCD; wgid = (xcd < r ? xcd * (q + 1) : r * (q + 1) + (xcd - r) * q) + off; }
        const int nig = WGM * nN, gid = wgid / nig, fm = gid * WGM, gsz = (nM - fm) < WGM ? (nM - fm) : WGM;
        u.pm = fm + ((wgid % nig) % gsz); u.pn = (wgid % nig) / gsz; u.aux = 0; u.rows = nullptr;
        u.a = A + (size_t)u.pm * tstepA; u.b = Bt + (size_t)u.pn * tstepB; return true;
    }
};
}

#define EPI_LOOP _Pragma("unroll") for (int ai = 0; ai < 2; ++ai) _Pragma("unroll") for (int m = 0; m < 4; ++m) _Pragma("unroll") for (int bj = 0; bj < 2; ++bj)
#define EPI_ROW(u) ((u).pm * 256 + ai * 128 + wr * 64 + m * 16 + fr)
#define EPI_COL(u) ((u).pn * 256 + bj * 128 + wc * 32 + fq * 8)

struct EpiStoreBf16 {
    bf16_t* O; int ldc;
    __device__ __forceinline__ void operator()(const f32x4 (&acc)[2][2][4][2], const pg8::Unit& u, int wr, int wc, int fr, int fq) const {
        EPI_LOOP { const f32x4 v0 = acc[ai][bj][m][0], v1 = acc[ai][bj][m][1];
            u32x4 w; w.x = pk2(v0[0], v0[1]); w.y = pk2(v0[2], v0[3]); w.z = pk2(v1[0], v1[1]); w.w = pk2(v1[2], v1[3]);
            __builtin_nontemporal_store(w, (u32x4*)(O + (size_t)EPI_ROW(u) * ldc + EPI_COL(u))); }
    }
};
struct EpiStoreScaled {
    bf16_t* O; int ldc; const float* inv;
    __device__ __forceinline__ void operator()(const f32x4 (&acc)[2][2][4][2], const pg8::Unit& u, int wr, int wc, int fr_in, int fq_in) const {
        (void)fr_in; (void)fq_in; int t_ = lane_id(); asm volatile("" : "+v"(t_)); const int fr = t_ & 15, fq = (t_ >> 4) & 3; const float isc = inv[0];
        EPI_LOOP { const f32x4 v0 = acc[ai][bj][m][0] * isc, v1 = acc[ai][bj][m][1] * isc;
            u32x4 w; w.x = pk2(v0[0], v0[1]); w.y = pk2(v0[2], v0[3]); w.z = pk2(v1[0], v1[1]); w.w = pk2(v1[2], v1[3]);
            __builtin_nontemporal_store(w, (u32x4*)(O + (size_t)EPI_ROW(u) * ldc + EPI_COL(u))); }
    }
};
struct EpiGate {
    bf16_t* O; const bf16_t* proj; int gcol; int add;
    __device__ __forceinline__ void operator()(const f32x4 (&acc)[2][2][4][2], const pg8::Unit& u, int wr, int wc, int fr, int fq) const {
#pragma unroll
        for (int ai = 0; ai < 2; ++ai) {
            u32x4 gv[4][2], pv[4][2];
#pragma unroll
            for (int m = 0; m < 4; ++m)
#pragma unroll
                for (int bj = 0; bj < 2; ++bj) { const int row = EPI_ROW(u), col = EPI_COL(u);
                    gv[m][bj] = *(const u32x4*)(proj + (size_t)row * DINP + gcol + col);
                    pv[m][bj] = add ? *(const u32x4*)(O + (size_t)row * D + col) : (u32x4){0u, 0u, 0u, 0u}; }
            asm volatile("" ::: "memory");
#pragma unroll
            for (int m = 0; m < 4; ++m)
#pragma unroll
                for (int bj = 0; bj < 2; ++bj) { const int row = EPI_ROW(u), col = EPI_COL(u); const u32x4 g = gv[m][bj], q = pv[m][bj];
                    float r[8]; const f32x4 v0 = acc[ai][bj][m][0], v1 = acc[ai][bj][m][1];
                    r[0] = v0[0] * sigmoidf_(bflo(g.x)); r[1] = v0[1] * sigmoidf_(bfhi(g.x)); r[2] = v0[2] * sigmoidf_(bflo(g.y)); r[3] = v0[3] * sigmoidf_(bfhi(g.y));
                    r[4] = v1[0] * sigmoidf_(bflo(g.z)); r[5] = v1[1] * sigmoidf_(bfhi(g.z)); r[6] = v1[2] * sigmoidf_(bflo(g.w)); r[7] = v1[3] * sigmoidf_(bfhi(g.w));
                    if (add) { r[0] += bflo(q.x); r[1] += bfhi(q.x); r[2] += bflo(q.y); r[3] += bfhi(q.y); r[4] += bflo(q.z); r[5] += bfhi(q.z); r[6] += bflo(q.w); r[7] += bfhi(q.w); }
                    u32x4 w; w.x = pk2(r[0], r[1]); w.y = pk2(r[2], r[3]); w.z = pk2(r[4], r[5]); w.w = pk2(r[6], r[7]); *(u32x4*)(O + (size_t)row * D + col) = w; }
        }
    }
};
struct EpiResidual {
    float* O; const float* R;
    __device__ __forceinline__ void operator()(const f32x4 (&acc)[2][2][4][2], const pg8::Unit& u, int wr, int wc, int fr, int fq) const {
#pragma unroll
        for (int ai = 0; ai < 2; ++ai) {
            f32x4 rv[4][2][2];
#pragma unroll
            for (int m = 0; m < 4; ++m)
#pragma unroll
                for (int bj = 0; bj < 2; ++bj) { const size_t o = (size_t)EPI_ROW(u) * D + EPI_COL(u); rv[m][bj][0] = *(const f32x4*)(R + o); rv[m][bj][1] = *(const f32x4*)(R + o + 4); }
            asm volatile("" ::: "memory");
#pragma unroll
            for (int m = 0; m < 4; ++m)
#pragma unroll
                for (int bj = 0; bj < 2; ++bj) { const size_t o = (size_t)EPI_ROW(u) * D + EPI_COL(u);
                    *(f32x4*)(O + o) = rv[m][bj][0] + acc[ai][bj][m][0]; *(f32x4*)(O + o + 4) = rv[m][bj][1] + acc[ai][bj][m][1]; }
        }
    }
};
struct EpiResidualSS {
    bf16_t* Xb; float* ss; unsigned char* X8;
    __device__ __forceinline__ void operator()(const f32x4 (&acc)[2][2][4][2], const pg8::Unit& u, int wr, int wc, int fr, int fq) const {
#pragma unroll
        for (int ai = 0; ai < 2; ++ai) {
            u32x4 rv[4][2];
#pragma unroll
            for (int m = 0; m < 4; ++m)
#pragma unroll
                for (int bj = 0; bj < 2; ++bj) rv[m][bj] = *(const u32x4*)(Xb + (size_t)EPI_ROW(u) * D + EPI_COL(u));
            asm volatile("" ::: "memory");
#pragma unroll
            for (int m = 0; m < 4; ++m) { float sq = 0.f;
#pragma unroll
                for (int bj = 0; bj < 2; ++bj) { const size_t o = (size_t)EPI_ROW(u) * D + EPI_COL(u); const u32x4 r = rv[m][bj];
                    const f32x4 v0 = (f32x4){bflo(r.x), bfhi(r.x), bflo(r.y), bfhi(r.y)} + acc[ai][bj][m][0], v1 = (f32x4){bflo(r.z), bfhi(r.z), bflo(r.w), bfhi(r.w)} + acc[ai][bj][m][1];
                    u32x4 w; w.x = pk2(v0[0], v0[1]); w.y = pk2(v0[2], v0[3]); w.z = pk2(v1[0], v1[1]); w.w = pk2(v1[2], v1[3]);
                    *(u32x4*)(Xb + o) = w;
                    { u32x2 w8; w8.x = pk4_fp8(4.f * v0[0], 4.f * v0[1], 4.f * v0[2], 4.f * v0[3]); w8.y = pk4_fp8(4.f * v1[0], 4.f * v1[1], 4.f * v1[2], 4.f * v1[3]); *(u32x2*)(X8 + o) = w8; }
                    sq += (v0[0] * v0[0] + v0[1] * v0[1]) + (v0[2] * v0[2] + v0[3] * v0[3]) + (v1[0] * v1[0] + v1[1] * v1[1]) + (v1[2] * v1[2] + v1[3] * v1[3]); }
                sq += __shfl_xor(sq, 16); sq += __shfl_xor(sq, 32);
                if (fq == 0) atomicAdd(ss + u.pm * 256 + ai * 128 + wr * 64 + m * 16 + fr, sq); }
        }
    }
};
struct EpiResidualNorm {
    const float* R; bf16_t* Xb; float* ss;
    __device__ __forceinline__ void operator()(const f32x4 (&acc)[2][2][4][2], const pg8::Unit& u, int wr, int wc, int fr, int fq) const {
#pragma unroll
        for (int ai = 0; ai < 2; ++ai) {
            f32x4 rv[4][2][2];
#pragma unroll
            for (int m = 0; m < 4; ++m)
#pragma unroll
                for (int bj = 0; bj < 2; ++bj) { const size_t o = (size_t)EPI_ROW(u) * D + EPI_COL(u); rv[m][bj][0] = *(const f32x4*)(R + o); rv[m][bj][1] = *(const f32x4*)(R + o + 4); }
            asm volatile("" ::: "memory");
#pragma unroll
            for (int m = 0; m < 4; ++m) { const int row = u.pm * 256 + ai * 128 + wr * 64 + m * 16 + fr; float sq = 0.f;
#pragma unroll
                for (int bj = 0; bj < 2; ++bj) { const int col = u.pn * 256 + bj * 128 + wc * 32 + fq * 8; const size_t o = (size_t)row * D + col;
                    const f32x4 v0 = rv[m][bj][0] + acc[ai][bj][m][0], v1 = rv[m][bj][1] + acc[ai][bj][m][1];
                    sq += (v0[0] * v0[0] + v0[1] * v0[1]) + (v0[2] * v0[2] + v0[3] * v0[3]) + (v1[0] * v1[0] + v1[1] * v1[1]) + (v1[2] * v1[2] + v1[3] * v1[3]);
                    u32x4 w; w.x = pk2(v0[0], v0[1]); w.y = pk2(v0[2], v0[3]); w.z = pk2(v1[0], v1[1]); w.w = pk2(v1[2], v1[3]);
                    *(u32x4*)(Xb + o) = w; }
                sq += __shfl_xor(sq, 16); sq += __shfl_xor(sq, 32);
                if (fq == 0) atomicAdd(ss + row, sq); }
        }
    }
};
struct EpiScaleRowsBf16 {
    bf16_t* O; int ldc; const float* ss;
    __device__ __forceinline__ void operator()(const f32x4 (&acc)[2][2][4][2], const pg8::Unit& u, int wr, int wc, int fr, int fq) const {
        float rs[2][4];
#pragma unroll
        for (int ai = 0; ai < 2; ++ai)
#pragma unroll
            for (int m = 0; m < 4; ++m) rs[ai][m] = ss[u.pm * 256 + ai * 128 + wr * 64 + m * 16 + fr];
#pragma unroll
        for (int ai = 0; ai < 2; ++ai)
#pragma unroll
            for (int m = 0; m < 4; ++m) rs[ai][m] = __builtin_amdgcn_rsqf(rs[ai][m] * (1.f / D) + 1e-6f);
        EPI_LOOP { const int row = EPI_ROW(u); const f32x4 v0 = acc[ai][bj][m][0] * rs[ai][m], v1 = acc[ai][bj][m][1] * rs[ai][m];
            u32x4 w; w.x = pk2(v0[0], v0[1]); w.y = pk2(v0[2], v0[3]); w.z = pk2(v1[0], v1[1]); w.w = pk2(v1[2], v1[3]);
            *(u32x4*)(O + (size_t)row * ldc + EPI_COL(u)) = w; }
    }
};
struct EpiSwiglu {
    bf16_t* O; const float* bias; const float* inv;
    __device__ __forceinline__ void operator()(const f32x4 (&acc)[2][2][4][2], const pg8::Unit& u, int wr, int wc, int fr_in, int fq_in) const {
        (void)fr_in; (void)fq_in; int t_ = lane_id(); asm volatile("" : "+v"(t_)); const int fr = t_ & 15, fq = (t_ >> 4) & 3;
        const float* bg = bias + (size_t)u.aux * 2048 + u.pn * 128 + wc * 32 + fq * 8; const float* bu = bg + 1024;
        float bgv[8], buv[8], rsv[2][4];
#pragma unroll
        for (int j = 0; j < 8; ++j) { bgv[j] = bg[j]; buv[j] = bu[j]; }
        { const float* rsp = (const float*)((const char*)u.rows + (WS_ROWRS2 - WS_ROWTOK2));
#pragma unroll
            for (int ai = 0; ai < 2; ++ai)
#pragma unroll
                for (int m = 0; m < 4; ++m) rsv[ai][m] = rsp[ai * 128 + wr * 64 + m * 16 + fr] * inv[u.aux]; }
#pragma unroll
        for (int ai = 0; ai < 2; ++ai)
#pragma unroll
            for (int m = 0; m < 4; ++m) {
                const int row = u.pm * 256 + ai * 128 + wr * 64 + m * 16 + fr;
                float r[8];
#pragma unroll
                for (int j = 0; j < 8; ++j) { float gt = acc[ai][0][m][j >> 2][j & 3] * rsv[ai][m] + bgv[j], up = acc[ai][1][m][j >> 2][j & 3] * rsv[ai][m] + buv[j];
                    gt = fminf(gt, 7.f); up = fminf(fmaxf(up, -7.f), 7.f); r[j] = gt * sigmoidf_(gt * 1.702f) * (up + 1.f); }
                u32x2 w; w.x = pk4_fp8(4.f * r[0], 4.f * r[1], 4.f * r[2], 4.f * r[3]); w.y = pk4_fp8(4.f * r[4], 4.f * r[5], 4.f * r[6], 4.f * r[7]);
                *(u32x2*)((unsigned char*)O + (size_t)row * D + u.pn * 128 + wc * 32 + fq * 8) = w; }
    }
};
struct EpiDown {
    bf16_t* O; const float* bias; const float* inv;
    __device__ __forceinline__ void operator()(const f32x4 (&acc)[2][2][4][2], const pg8::Unit& u, int wr, int wc, int fr_in, int fq_in) const {
        (void)fr_in; (void)fq_in; int t_ = lane_id(); asm volatile("" : "+v"(t_)); const int fr = t_ & 15, fq = (t_ >> 4) & 3;
        float gt[2][4]; f32x4 bb[2][2]; const float isc = inv[u.aux];
#pragma unroll
        for (int ai = 0; ai < 2; ++ai)
#pragma unroll
            for (int m = 0; m < 4; ++m) gt[ai][m] = ((const float*)u.rows)[ai * 128 + wr * 64 + m * 16 + fr];
#pragma unroll
        for (int bj = 0; bj < 2; ++bj) { const float* bp = bias + (size_t)u.aux * D + u.pn * 256 + bj * 128 + wc * 32 + fq * 8; bb[bj][0] = *(const f32x4*)bp; bb[bj][1] = *(const f32x4*)(bp + 4); }
        EPI_LOOP { const int row = EPI_ROW(u), col = EPI_COL(u);
            const f32x4 v0 = (acc[ai][bj][m][0] * isc + bb[bj][0]) * gt[ai][m], v1 = (acc[ai][bj][m][1] * isc + bb[bj][1]) * gt[ai][m];
            u32x2 w; w.x = pk4_fp8(8.f * v0[0], 8.f * v0[1], 8.f * v0[2], 8.f * v0[3]); w.y = pk4_fp8(8.f * v1[0], 8.f * v1[1], 8.f * v1[2], 8.f * v1[3]);
            *(u32x2*)((unsigned char*)O + (size_t)row * D + col) = w; }
    }
};
struct MoeOrder {
    int G, c, NPN; const LAS int* cum; const char* A; const char* Bt; size_t estepB; const int* rowtab; int gather; int rowB; int nrb_s;
    __device__ bool next(int i, pg8::Unit& u) const {
        const int nrb = nrb_s;
        int rb, pn;
        if ((G & 7) == 0 && (G / 8) % NPN == 0 && (i + 1) * (G / NPN) <= nrb) { const int per = G / NPN, rpx = per / 8, xcd = c & 7, j = c >> 3; rb = i * per + xcd * rpx + j / NPN; pn = j % NPN; if (rb >= nrb) return false; }
        else { const int L = i * G + c; if (L >= nrb * NPN) return false; rb = L / NPN; pn = L % NPN; }
        int e = 0;
#pragma unroll 1
        for (int k = 1; k < NE; ++k) e += (rb >= cum[k]) ? 1 : 0;
        e = __builtin_amdgcn_readfirstlane(e); const int jb = __builtin_amdgcn_readfirstlane(rb - cum[e]);
        u.pm = rb; u.pn = pn; u.aux = e; u.rows = rowtab + e * NT + jb * 256; u.a = gather ? A : A + (size_t)rb * 256 * rowB; u.b = Bt + (size_t)e * estepB + (size_t)pn * 256 * rowB; return true;
    }
};

struct TrItem { const float* W; bf16_t* WT; int K, N, ldw, dst_row0, k0, n0; const float* gk = nullptr; float s8 = 0.f; };
__device__ __forceinline__ void tr_load(const TrItem& t, float (&v)[32], int lane) {
    const int n = t.n0 + (lane & 31); const bool ok = n < t.N; const float* src = t.W + (size_t)(t.k0 + (lane >> 5)) * t.ldw + (ok ? n : 0);
#pragma unroll
    for (int i = 0; i < 32; ++i) { const float x = __builtin_nontemporal_load(src + (size_t)(2 * i) * t.ldw); v[i] = ok ? x : 0.f; }
    if (t.gk) {
#pragma unroll
        for (int i = 0; i < 32; ++i) v[i] *= t.gk[t.k0 + 2 * i + (lane >> 5)]; }
}
__device__ __forceinline__ void tr_lds_write(const float (&v)[32], LAS float* scr, int lane) {
#pragma unroll
    for (int i = 0; i < 32; ++i) scr[(2 * i + (lane >> 5)) * 33 + (lane & 31)] = v[i];
    LDS_FENCE();
}
__device__ __forceinline__ void tr_store(const TrItem& t, LAS float* scr, int lane) {
    const int c = lane & 7;
#pragma unroll
    for (int j = 0; j < 4; ++j) { const int nn = (lane >> 3) + 8 * j; const LAS float* sp = scr + (8 * c) * 33 + nn;
        u32x4 o; o.x = pk2(sp[0 * 33], sp[1 * 33]); o.y = pk2(sp[2 * 33], sp[3 * 33]); o.z = pk2(sp[4 * 33], sp[5 * 33]); o.w = pk2(sp[6 * 33], sp[7 * 33]);
        *(u32x4*)(t.WT + (size_t)(t.dst_row0 + nn) * t.K + t.k0 + 8 * c) = o; }
    LDS_FENCE();
}
__device__ __forceinline__ void tr_store8(const TrItem& t, LAS float* scr, int lane) {
    const int c = lane & 7; const float s8 = t.s8;
#pragma unroll
    for (int j = 0; j < 4; ++j) { const int nn = (lane >> 3) + 8 * j; const LAS float* sp = scr + (8 * c) * 33 + nn;
        u32x2 o; o.x = pk4_fp8(sp[0 * 33] * s8, sp[1 * 33] * s8, sp[2 * 33] * s8, sp[3 * 33] * s8); o.y = pk4_fp8(sp[4 * 33] * s8, sp[5 * 33] * s8, sp[6 * 33] * s8, sp[7 * 33] * s8);
        *(u32x2*)((unsigned char*)t.WT + (size_t)(t.dst_row0 + nn) * t.K + t.k0 + 8 * c) = o; }
    LDS_FENCE();
}
__device__ __forceinline__ void rms_rows2_to_fp8(const float* xa, const float* xb, const float* __restrict__ gain, unsigned char* oa, unsigned char* ob, bool hasb, int lane) {
    const f32x4* ra = (const f32x4*)xa + lane; const f32x4* rb = (const f32x4*)xb + lane; const f32x4* gr = (const f32x4*)gain + lane;
    f32x4 va[4], vb[4], gg[4]; float sa = 0.f, sb = 0.f;
#pragma unroll
    for (int j = 0; j < 4; ++j) { va[j] = __builtin_nontemporal_load(ra + 64 * j); vb[j] = __builtin_nontemporal_load(rb + 64 * j); gg[j] = gr[64 * j]; }
    asm volatile("" ::: "memory");
#pragma unroll
    for (int j = 0; j < 4; ++j) { sa += (va[j].x * va[j].x + va[j].y * va[j].y) + (va[j].z * va[j].z + va[j].w * va[j].w); sb += (vb[j].x * vb[j].x + vb[j].y * vb[j].y) + (vb[j].z * vb[j].z + vb[j].w * vb[j].w); }
    const float rsa = 16.f * __builtin_amdgcn_rsqf(wave_sum(sa) * (1.f / D) + 1e-6f), rsb = 16.f * __builtin_amdgcn_rsqf(wave_sum(sb) * (1.f / D) + 1e-6f);
    unsigned* o4a = (unsigned*)oa + lane; unsigned* o4b = (unsigned*)ob + lane;
#pragma unroll
    for (int j = 0; j < 4; ++j) { o4a[64 * j] = pk4_fp8(va[j].x * rsa * gg[j].x, va[j].y * rsa * gg[j].y, va[j].z * rsa * gg[j].z, va[j].w * rsa * gg[j].w);
        if (hasb) o4b[64 * j] = pk4_fp8(vb[j].x * rsb * gg[j].x, vb[j].y * rsb * gg[j].y, vb[j].z * rsb * gg[j].z, vb[j].w * rsb * gg[j].w); }
}
__device__ __forceinline__ float rms_row_to_bf16(const float* xrow, const float* __restrict__ gain, bf16_t* orow, int lane) {
    const f32x4* xr = (const f32x4*)xrow + lane; const f32x4* gr = (const f32x4*)gain + lane;
    f32x4 v[4]; float s = 0.f;
#pragma unroll
    for (int j = 0; j < 4; ++j) { v[j] = xr[64 * j]; s += (v[j].x * v[j].x + v[j].y * v[j].y) + (v[j].z * v[j].z + v[j].w * v[j].w); }
    const float rstd = __builtin_amdgcn_rsqf(wave_sum(s) * (1.f / D) + 1e-6f);
    u32x2* o8 = (u32x2*)orow + lane;
#pragma unroll
    for (int j = 0; j < 4; ++j) { const f32x4 gg = gr[64 * j]; u32x2 w; w.x = pk2(v[j].x * rstd * gg.x, v[j].y * rstd * gg.y); w.y = pk2(v[j].z * rstd * gg.z, v[j].w * rstd * gg.w); o8[64 * j] = w; }
    return rstd;
}

__device__ __forceinline__ void rms_rows2_to_bf16(const float* xa, const float* xb, const float* __restrict__ gain, bf16_t* oa, bf16_t* ob, bool hasb, int lane) {
    const f32x4* ra = (const f32x4*)xa + lane; const f32x4* rb = (const f32x4*)xb + lane; const f32x4* gr = (const f32x4*)gain + lane;
    f32x4 va[4], vb[4], gg[4]; float sa = 0.f, sb = 0.f;
#pragma unroll
    for (int j = 0; j < 4; ++j) { va[j] = __builtin_nontemporal_load(ra + 64 * j); vb[j] = __builtin_nontemporal_load(rb + 64 * j); gg[j] = gr[64 * j]; }
    asm volatile("" ::: "memory");
#pragma unroll
    for (int j = 0; j < 4; ++j) { sa += (va[j].x * va[j].x + va[j].y * va[j].y) + (va[j].z * va[j].z + va[j].w * va[j].w); sb += (vb[j].x * vb[j].x + vb[j].y * vb[j].y) + (vb[j].z * vb[j].z + vb[j].w * vb[j].w); }
    const float rsa = __builtin_amdgcn_rsqf(wave_sum(sa) * (1.f / D) + 1e-6f), rsb = __builtin_amdgcn_rsqf(wave_sum(sb) * (1.f / D) + 1e-6f);
    u32x2* o8a = (u32x2*)oa + lane; u32x2* o8b = (u32x2*)ob + lane;
#pragma unroll
    for (int j = 0; j < 4; ++j) { u32x2 w; w.x = pk2(va[j].x * rsa * gg[j].x, va[j].y * rsa * gg[j].y); w.y = pk2(va[j].z * rsa * gg[j].z, va[j].w * rsa * gg[j].w); o8a[64 * j] = w;
        if (hasb) { u32x2 u; u.x = pk2(vb[j].x * rsb * gg[j].x, vb[j].y * rsb * gg[j].y); u.y = pk2(vb[j].z * rsb * gg[j].z, vb[j].w * rsb * gg[j].w); o8b[64 * j] = u; } }
}

template <int R> struct AttnState { float m[R], l[R], o[R][2]; };
template <int R> __device__ __forceinline__ void attn_init(AttnState<R>& st) {
#pragma unroll
    for (int h = 0; h < R; ++h) { st.m[h] = -1e30f; st.l[h] = 0.f; st.o[h][0] = 0.f; st.o[h][1] = 0.f; }
}
template <int R> __device__ __forceinline__ void attn_block(AttnState<R>& st, const LAS float* q, LAS float* pbuf, const bf16_t* krow, bool valid,
                                                           const bf16_t* vbase, int vstride, int jlo, int jhi, int lane, float scale, float* sraw) {
    float s[R];
#pragma unroll
    for (int h = 0; h < R; ++h) s[h] = 0.f;
    if (valid) {
        const u32x4* kp = (const u32x4*)krow;
#pragma unroll 4
        for (int c = 0; c < 16; ++c) {
            const u32x4 kv = kp[c];
            const float k0 = bflo(kv.x), k1 = bfhi(kv.x), k2 = bflo(kv.y), k3 = bfhi(kv.y), k4 = bflo(kv.z), k5 = bfhi(kv.z), k6 = bflo(kv.w), k7 = bfhi(kv.w);
#pragma unroll
            for (int h = 0; h < R; ++h) { const f32x4 qa = *(const LAS f32x4*)(q + h * 128 + c * 8), qb = *(const LAS f32x4*)(q + h * 128 + c * 8 + 4);
                s[h] += (k0 * qa.x + k1 * qa.y) + (k2 * qa.z + k3 * qa.w) + (k4 * qb.x + k5 * qb.y) + (k6 * qb.z + k7 * qb.w); }
        }
    }
    float alpha[R];
#pragma unroll
    for (int h = 0; h < R; ++h) {
        const float sv = valid ? s[h] * scale : -1e30f; if (sraw) sraw[h] = sv;
        const float bm = wave_max(sv), mn = fmaxf(st.m[h], bm); alpha[h] = __expf(st.m[h] - mn);
        const float p = valid ? __expf(sv - mn) : 0.f;
        st.l[h] = st.l[h] * alpha[h] + wave_sum(p); st.m[h] = mn; st.o[h][0] *= alpha[h]; st.o[h][1] *= alpha[h];
        pbuf[h * 64 + lane] = p;
    }
    LDS_FENCE();
    const bf16_t* vp = vbase + (size_t)jlo * vstride + 2 * lane;
#pragma unroll 4
    for (int j = jlo; j < jhi; ++j) {
        const unsigned vv = *(const unsigned*)vp; vp += vstride; const float v0 = bflo(vv), v1 = bfhi(vv);
#pragma unroll
        for (int h = 0; h < R; ++h) { const float p = pbuf[h * 64 + j]; st.o[h][0] += p * v0; st.o[h][1] += p * v1; }
    }
    LDS_FENCE();
}


#define MFMA16(a, b, c) __builtin_amdgcn_mfma_f32_16x16x32_bf16((a), (b), (c), 0, 0, 0)
#define FRAG(base, pitch, row, kcol) (*(const LAS bf16x8*)((base) + (row) * (pitch) + (kcol)))
__device__ __forceinline__ u32x2 pk4(const f32x4 v) { u32x2 w; w.x = pk2(v[0], v[1]); w.y = pk2(v[2], v[3]); return w; }
__device__ __forceinline__ u32x4 pk8(const f32x4 a, const f32x4 b) { u32x4 w; w.x = pk2(a[0], a[1]); w.y = pk2(a[2], a[3]); w.z = pk2(b[0], b[1]); w.w = pk2(b[2], b[3]); return w; }
constexpr int PK = 136, PC = 72;

__device__ __forceinline__ void gdn_chunk_item(const Params& p, unsigned char* ws, LAS unsigned char* lds, int item, int tid, int lane, int wave, int& cw_head) {
    asm volatile("" : "+v"(tid)); lane = tid & 63;
    const int n = item & 127, bh = item >> 7, h = bh & 7, b = bh >> 3;
    const int tok0 = b * T + n * 64;
    const bf16_t* PROJ = (const bf16_t*)(ws + WS_PROJ);
    LAS bf16_t* K_RM = (LAS bf16_t*)(lds); LAS bf16_t* KB_RM = (LAS bf16_t*)(lds + 17408); LAS bf16_t* Q_RM = (LAS bf16_t*)(lds + 34816);
    LAS bf16_t* KT_RM = (LAS bf16_t*)(lds + 52224); LAS bf16_t* KBGT = (LAS bf16_t*)(lds + 70656); LAS bf16_t* VBT = (LAS bf16_t*)(lds + 89088);
    LAS float* sc = (LAS float*)(lds + 107520);
    unsigned char* chk = ws + WS_CHK + (size_t)item * CH_BYTES;
    const int fr = lane & 15, fq = lane >> 4, ksw = wave >> 2, ct = wave & 3;
    LAS float* cwl = (LAS float*)(lds + 108544);
    __syncthreads();
    if (cw_head != h) {
        for (int idx = tid; idx < 3 * 4 * 128; idx += NTHREADS) { const int w = idx >> 9, j = (idx >> 7) & 3, c = idx & 127; cwl[idx] = p.in[4][j * 3072 + w * 1024 + h * 128 + c]; }
        cw_head = h;
        __syncthreads();
    }
    {
        float kbv[16];
        const int r = tid >> 3, cg = tid & 7, t = n * 64 + r;
        const float gb = bf2f(PROJ[(size_t)(tok0 + r) * DINP + C_GB + h]), ga = bf2f(PROJ[(size_t)(tok0 + r) * DINP + C_GA + h]);
        const float beta = sigmoidf_(gb); const float xx = ga + p.in[6][h]; const float sp = xx > 20.f ? xx : log1pf(__expf(xx));
        if (cg == 0) sc[r] = -__expf(p.in[5][h]) * sp;
        u32x4 xr[3][4][2];
#define CONV_LOAD(w) do { _Pragma("unroll") for (int j = 0; j < 4; ++j) { const bool inb = (t - 3 + j >= 0); const u32x4* xp = (const u32x4*)(PROJ + (size_t)(inb ? tok0 + r - 3 + j : tok0) * DINP + (w) * 1024 + h * 128 + cg * 16); \
            xr[w][j][0] = xp[0]; xr[w][j][1] = xp[1]; } asm volatile("" ::: "memory"); } while (0)
        CONV_LOAD(0); CONV_LOAD(1);
#pragma unroll
        for (int w = 0; w < 3; ++w) {
            if (w == 1) CONV_LOAD(2);
            const int ch0 = w * 1024 + h * 128 + cg * 16; (void)ch0;
            float a[16];
#pragma unroll
            for (int e = 0; e < 16; ++e) a[e] = 0.f;
#pragma unroll
            for (int j = 0; j < 4; ++j) {
                {
                    u32x4 x0 = xr[w][j][0], x1 = xr[w][j][1];
                    if (n == 0) { const bool inb = (t - 3 + j >= 0); if (!inb) { x0 = (u32x4){0u, 0u, 0u, 0u}; x1 = x0; } }
                    const LAS f32x4* wp = (const LAS f32x4*)(cwl + (w * 4 + j) * 128 + cg * 16); const f32x4 w0 = wp[0], w1 = wp[1], w2 = wp[2], w3 = wp[3];
                    a[0] += bflo(x0.x) * w0.x; a[1] += bfhi(x0.x) * w0.y; a[2] += bflo(x0.y) * w0.z; a[3] += bfhi(x0.y) * w0.w;
                    a[4] += bflo(x0.z) * w1.x; a[5] += bfhi(x0.z) * w1.y; a[6] += bflo(x0.w) * w1.z; a[7] += bfhi(x0.w) * w1.w;
                    a[8] += bflo(x1.x) * w2.x; a[9] += bfhi(x1.x) * w2.y; a[10] += bflo(x1.y) * w2.z; a[11] += bfhi(x1.y) * w2.w;
                    a[12] += bflo(x1.z) * w3.x; a[13] += bfhi(x1.z) * w3.y; a[14] += bflo(x1.w) * w3.z; a[15] += bfhi(x1.w) * w3.w;
                }
            }
            float ss = 0.f;
#pragma unroll
            for (int e = 0; e < 16; ++e) { a[e] = siluf_(a[e]); ss += a[e] * a[e]; }
            if (w < 2) { ss += __shfl_xor(ss, 1); ss += __shfl_xor(ss, 2); ss += __shfl_xor(ss, 4); const float rn = __builtin_amdgcn_rsqf(ss + 1e-6f) * (w == 0 ? 0.08838834764831845f : 1.f);
#pragma unroll
                for (int e = 0; e < 16; ++e) a[e] *= rn; }
            if (w == 0) { u32x4 o0, o1;
                o0.x = pk2(a[0], a[1]); o0.y = pk2(a[2], a[3]); o0.z = pk2(a[4], a[5]); o0.w = pk2(a[6], a[7]); o1.x = pk2(a[8], a[9]); o1.y = pk2(a[10], a[11]); o1.z = pk2(a[12], a[13]); o1.w = pk2(a[14], a[15]);
                *(LAS u32x4*)(Q_RM + r * PK + cg * 16) = o0; *(LAS u32x4*)(Q_RM + r * PK + cg * 16 + 8) = o1; }
            else if (w == 1) { u32x4 o0, o1;
                o0.x = pk2(a[0], a[1]); o0.y = pk2(a[2], a[3]); o0.z = pk2(a[4], a[5]); o0.w = pk2(a[6], a[7]); o1.x = pk2(a[8], a[9]); o1.y = pk2(a[10], a[11]); o1.z = pk2(a[12], a[13]); o1.w = pk2(a[14], a[15]);
                *(LAS u32x4*)(K_RM + r * PK + cg * 16) = o0; *(LAS u32x4*)(K_RM + r * PK + cg * 16 + 8) = o1;
#pragma unroll
                for (int e = 0; e < 16; e += 2) { const unsigned w2 = pk2(a[e], a[e + 1]); KT_RM[(cg * 16 + e) * PC + r] = (bf16_t)(w2 & 0xffffu); KT_RM[(cg * 16 + e + 1) * PC + r] = (bf16_t)(w2 >> 16);
                    kbv[e] = a[e] * beta; kbv[e + 1] = a[e + 1] * beta; }
                o0.x = pk2(kbv[0], kbv[1]); o0.y = pk2(kbv[2], kbv[3]); o0.z = pk2(kbv[4], kbv[5]); o0.w = pk2(kbv[6], kbv[7]); o1.x = pk2(kbv[8], kbv[9]); o1.y = pk2(kbv[10], kbv[11]); o1.z = pk2(kbv[12], kbv[13]); o1.w = pk2(kbv[14], kbv[15]);
                *(LAS u32x4*)(KB_RM + r * PK + cg * 16) = o0; *(LAS u32x4*)(KB_RM + r * PK + cg * 16 + 8) = o1; }
            else {
#pragma unroll
                for (int e = 0; e < 16; e += 2) { const unsigned w2 = pk2(a[e] * beta, a[e + 1] * beta); VBT[(cg * 16 + e) * PC + r] = (bf16_t)(w2 & 0xffffu); VBT[(cg * 16 + e + 1) * PC + r] = (bf16_t)(w2 >> 16); } }
        }
    }
    __syncthreads();
    if (wave == 0) { float v = sc[lane];
#pragma unroll
        for (int o = 1; o < 64; o <<= 1) { const float u = __shfl_up(v, o); if (lane >= o) v += u; }
        const float gl = __shfl(v, 63); sc[64 + lane] = v; sc[128 + lane] = __expf(v); sc[192 + lane] = __expf(gl - v);
        if (lane == 63) ((float*)(ws + WS_GL))[item] = __expf(v); }
    __syncthreads();
    { const int r = tid >> 3, cg = tid & 7; const float eg = sc[128 + r];
        const u32x4 k0 = *(const LAS u32x4*)(KB_RM + r * PK + cg * 16), k1 = *(const LAS u32x4*)(KB_RM + r * PK + cg * 16 + 8);
        const unsigned kw[8] = {k0.x, k0.y, k0.z, k0.w, k1.x, k1.y, k1.z, k1.w};
#pragma unroll
        for (int e = 0; e < 8; ++e) { const unsigned w2 = pk2(bflo(kw[e]) * eg, bfhi(kw[e]) * eg); KBGT[(cg * 16 + 2 * e) * PC + r] = (bf16_t)(w2 & 0xffffu); KBGT[(cg * 16 + 2 * e + 1) * PC + r] = (bf16_t)(w2 >> 16); } }
    f32x4 d1[2], d2[2], d3[2];
#pragma unroll
    for (int ti = 0; ti < 2; ++ti) { d1[ti] = (f32x4){0.f, 0.f, 0.f, 0.f}; d2[ti] = d1[ti]; d3[ti] = d1[ti]; }
#pragma unroll
    for (int kk = 0; kk < 4; ++kk) {
        const bf16x8 k_b = FRAG(K_RM, PK, 16 * ct + fr, 32 * kk + 8 * fq), kb_b = FRAG(KB_RM, PK, 16 * ct + fr, 32 * kk + 8 * fq), q_b = FRAG(Q_RM, PK, 16 * ct + fr, 32 * kk + 8 * fq);
#pragma unroll
        for (int ti = 0; ti < 2; ++ti) { const int row = 16 * (2 * ksw + ti) + fr;
            const bf16x8 kb_a = FRAG(KB_RM, PK, row, 32 * kk + 8 * fq), k_a = FRAG(K_RM, PK, row, 32 * kk + 8 * fq);
            d1[ti] = MFMA16(kb_a, k_b, d1[ti]); d2[ti] = MFMA16(k_a, kb_b, d2[ti]); d3[ti] = MFMA16(k_a, q_b, d3[ti]); }
    }
#pragma unroll
    for (int q = 0; q < 2; ++q) { const int idx = 2 * wave + q;
        { const int mt = idx >> 2, ks = idx & 3, c = 16 * mt + fr, i0 = 32 * ks + 4 * fq; const float eg = sc[128 + c];
            const u32x2 a = *(const LAS u32x2*)(Q_RM + c * PK + i0), bq = *(const LAS u32x2*)(Q_RM + c * PK + i0 + 16);
            u32x4 o; o.x = pk2(bflo(a.x) * eg, bfhi(a.x) * eg); o.y = pk2(bflo(a.y) * eg, bfhi(a.y) * eg); o.z = pk2(bflo(bq.x) * eg, bfhi(bq.x) * eg); o.w = pk2(bflo(bq.y) * eg, bfhi(bq.y) * eg);
            *(u32x4*)(chk + CH_QD + (idx * 64 + lane) * 16) = o; }
        { const int it = idx >> 1, ks = idx & 1, i = 16 * it + fr, c0 = 32 * ks + 4 * fq;
            const u32x2 a = *(const LAS u32x2*)(KT_RM + i * PC + c0), bq = *(const LAS u32x2*)(KT_RM + i * PC + c0 + 16);
            const f32x4 e0 = *(const LAS f32x4*)(sc + 192 + c0), e1 = *(const LAS f32x4*)(sc + 192 + c0 + 16);
            u32x4 o; o.x = pk2(bflo(a.x) * e0.x, bfhi(a.x) * e0.y); o.y = pk2(bflo(a.y) * e0.z, bfhi(a.y) * e0.w); o.z = pk2(bflo(bq.x) * e1.x, bfhi(bq.x) * e1.y); o.w = pk2(bflo(bq.y) * e1.z, bfhi(bq.y) * e1.w);
            *(u32x4*)(chk + CH_KDT + (idx * 64 + lane) * 16) = o; }
    }
    __syncthreads();
    LAS bf16_t* Xb0 = (LAS bf16_t*)(lds); LAS bf16_t* Xb1 = (LAS bf16_t*)(lds + 9216); LAS bf16_t* XTb0 = (LAS bf16_t*)(lds + 18432); LAS bf16_t* XTb1 = (LAS bf16_t*)(lds + 27648);
    LAS bf16_t* Pb0 = (LAS bf16_t*)(lds + 36864); LAS bf16_t* Pb1 = (LAS bf16_t*)(lds + 46080);
    f32x4 accP[2];
    {
        const int cidx = 16 * ct + fr; const float gc = sc[64 + cidx];
        f32x4 qk[2];
#pragma unroll
        for (int ti = 0; ti < 2; ++ti) { const int r0 = 16 * (2 * ksw + ti) + 4 * fq; const f32x4 gr = *(const LAS f32x4*)(sc + 64 + r0);
            f32x4 xt, xx;
#pragma unroll
            for (int r = 0; r < 4; ++r) { const int rr = r0 + r;
                xt[r] = (rr > cidx) ? -(d1[ti][r] * __expf(gr[r] - gc)) : 0.f;
                xx[r] = (cidx > rr) ? -(d2[ti][r] * __expf(gc - gr[r])) : 0.f;
                qk[ti][r] = (rr <= cidx) ? d3[ti][r] * __expf(gc - gr[r]) : 0.f;
                accP[ti][r] = xx[r] + (rr == cidx ? 1.f : 0.f); }
            *(LAS u32x2*)(XTb0 + cidx * PC + r0) = pk4(xt); *(LAS u32x2*)(Xb0 + cidx * PC + r0) = pk4(xx); *(LAS u32x2*)(Pb0 + cidx * PC + r0) = pk4(accP[ti]); }
        *(u32x4*)(chk + CH_QK + ((ct * 2 + ksw) * 64 + lane) * 16) = pk8(qk[0], qk[1]);
    }
    __syncthreads();
#pragma unroll
    for (int itn = 0; itn < 5; ++itn) {
        LAS bf16_t* Xc = (itn & 1) ? Xb1 : Xb0; LAS bf16_t* Xn = (itn & 1) ? Xb0 : Xb1; LAS bf16_t* XTc = (itn & 1) ? XTb1 : XTb0; LAS bf16_t* XTn = (itn & 1) ? XTb0 : XTb1;
        LAS bf16_t* Pc = (itn & 1) ? Pb1 : Pb0; LAS bf16_t* Pn = (itn & 1) ? Pb0 : Pb1;
        f32x4 e1[2], e2[2];
#pragma unroll
        for (int ti = 0; ti < 2; ++ti) { e1[ti] = (f32x4){0.f, 0.f, 0.f, 0.f}; e2[ti] = e1[ti]; }
#pragma unroll
        for (int kk = 0; kk < 2; ++kk) {
            const bf16x8 bxt = FRAG(XTc, PC, 16 * ct + fr, 32 * kk + 8 * fq), bx = FRAG(Xc, PC, 16 * ct + fr, 32 * kk + 8 * fq);
#pragma unroll
            for (int ti = 0; ti < 2; ++ti) { const int row = 16 * (2 * ksw + ti) + fr;
                e1[ti] = MFMA16(FRAG(Xc, PC, row, 32 * kk + 8 * fq), bxt, e1[ti]);
                if (itn < 4) e2[ti] = MFMA16(FRAG(XTc, PC, row, 32 * kk + 8 * fq), bx, e2[ti]); }
        }
#pragma unroll
        for (int ti = 0; ti < 2; ++ti) { const int r0 = 16 * (2 * ksw + ti) + 4 * fq;
            *(LAS u32x2*)(XTn + (16 * ct + fr) * PC + r0) = pk4(e1[ti]); if (itn < 4) *(LAS u32x2*)(Xn + (16 * ct + fr) * PC + r0) = pk4(e2[ti]); }
        __syncthreads();
#pragma unroll
        for (int kk = 0; kk < 2; ++kk) { const bf16x8 bp = FRAG(Pc, PC, 16 * ct + fr, 32 * kk + 8 * fq);
#pragma unroll
            for (int ti = 0; ti < 2; ++ti) accP[ti] = MFMA16(FRAG(XTn, PC, 16 * (2 * ksw + ti) + fr, 32 * kk + 8 * fq), bp, accP[ti]); }
#pragma unroll
        for (int ti = 0; ti < 2; ++ti) *(LAS u32x2*)(Pn + (16 * ct + fr) * PC + 16 * (2 * ksw + ti) + 4 * fq) = pk4(accP[ti]);
        __syncthreads();
    }
    LAS bf16_t* Tm = Pb1;
    {
        f32x4 u[4];
#pragma unroll
        for (int rt = 0; rt < 4; ++rt) u[rt] = (f32x4){0.f, 0.f, 0.f, 0.f};
#pragma unroll
        for (int kk = 0; kk < 2; ++kk) { const bf16x8 bv = FRAG(VBT, PC, 16 * wave + fr, 32 * kk + 8 * fq);
#pragma unroll
            for (int rt = 0; rt < 4; ++rt) u[rt] = MFMA16(FRAG(Tm, PC, 16 * rt + fr, 32 * kk + 8 * fq), bv, u[rt]); }
        f32x4* U = (f32x4*)(ws + WS_U) + ((size_t)(item * 8 + wave) * 4) * 64 + lane;
#pragma unroll
        for (int rt = 0; rt < 4; ++rt) U[rt * 64] = u[rt];
#pragma unroll
        for (int q = 0; q < 2; ++q) { const int ks2 = ksw + 2 * q;
            f32x4 w2[2] = {(f32x4){0.f, 0.f, 0.f, 0.f}, (f32x4){0.f, 0.f, 0.f, 0.f}};
#pragma unroll
            for (int kk = 0; kk < 2; ++kk) { const bf16x8 bt = FRAG(Tm, PC, 16 * ct + fr, 32 * kk + 8 * fq);
#pragma unroll
                for (int ti = 0; ti < 2; ++ti) w2[ti] = MFMA16(FRAG(KBGT, PC, 16 * (2 * ks2 + ti) + fr, 32 * kk + 8 * fq), bt, w2[ti]); }
            *(u32x4*)(chk + CH_NEGW + ((ct * 4 + ks2) * 64 + lane) * 16) = pk8(-w2[0], -w2[1]); }
    }
}

__device__ __forceinline__ void gdn_scan(unsigned char* ws, LAS unsigned char* lds, int sblk, int tid, int lane, int wave) {
    const int bh = sblk, b = bh >> 3, h = bh & 7, sl = wave;
    const int fr = lane & 15, fq = lane >> 4;
    const unsigned char* chunks = ws + WS_CHK + (size_t)bh * 128 * CH_BYTES;
    const float* GL = (const float*)(ws + WS_GL) + bh * 128;
    float* GO = (float*)(ws + WS_GO);
#define GDN_STAGE(nn, buf) do { const unsigned char* _src = chunks + (size_t)(nn) * CH_BYTES; _Pragma("unroll") for (int _i = 0; _i < 7; ++_i) \
        __builtin_amdgcn_global_load_lds((const unsigned*)(_src + (_i * 512 + tid) * 16), (LAS unsigned*)(lds + (buf) * CH_BYTES + (_i * 512 + wave * 64) * 16), 16, 0, 2); } while (0)
    __syncthreads();
    GDN_STAGE(0, 0);
    f32x4 S[8]; bf16x8 Sb[4]; f32x4 ucur[4];
#pragma unroll
    for (int i = 0; i < 8; ++i) S[i] = (f32x4){0.f, 0.f, 0.f, 0.f};
#pragma unroll
    for (int i = 0; i < 4; ++i) Sb[i] = (bf16x8){0, 0, 0, 0, 0, 0, 0, 0};
    const f32x4* Ubase = (const f32x4*)(ws + WS_U) + ((size_t)(bh * 128) * 8 + sl) * 256 + lane;
    {
#pragma unroll
        for (int rt = 0; rt < 4; ++rt) ucur[rt] = __builtin_nontemporal_load(Ubase + rt * 64);
    }
    asm volatile("s_waitcnt vmcnt(0)" ::: "memory");
    __syncthreads();
#pragma unroll 1
    for (int n = 0; n < 128; ++n) {
        const int buf = n & 1;
        if (n + 1 < 128) GDN_STAGE(n + 1, buf ^ 1);
        {
            const LAS unsigned char* L = lds + buf * CH_BYTES + lane * 16;
            f32x4 unext[4];
            if (n + 1 < 128) {
#pragma unroll
                for (int rt = 0; rt < 4; ++rt) unext[rt] = __builtin_nontemporal_load(Ubase + (size_t)(n + 1) * 2048 + rt * 64);
            }
            const float gl = GL[n];
            f32x4 vn[4], o[4];
#pragma unroll
            for (int rt = 0; rt < 4; ++rt) { vn[rt] = ucur[rt]; o[rt] = (f32x4){0.f, 0.f, 0.f, 0.f}; }
#pragma unroll
            for (int ks = 0; ks < 4; ++ks)
#pragma unroll
                for (int rt = 0; rt < 4; ++rt) {
                    vn[rt] = MFMA16(*(const LAS bf16x8*)(L + CH_NEGW + (rt * 4 + ks) * 1024), Sb[ks], vn[rt]);
                    o[rt] = MFMA16(*(const LAS bf16x8*)(L + CH_QD + (rt * 4 + ks) * 1024), Sb[ks], o[rt]); }
            bf16x8 vb[2];
            vb[0] = __builtin_bit_cast(bf16x8, pk8(vn[0], vn[1])); vb[1] = __builtin_bit_cast(bf16x8, pk8(vn[2], vn[3]));
#pragma unroll
            for (int ks = 0; ks < 2; ++ks)
#pragma unroll
                for (int rt = 0; rt < 4; ++rt) o[rt] = MFMA16(*(const LAS bf16x8*)(L + CH_QK + (rt * 2 + ks) * 1024), vb[ks], o[rt]);
#pragma unroll
            for (int it = 0; it < 8; ++it) S[it] = S[it] * gl;
#pragma unroll
            for (int ks = 0; ks < 2; ++ks)
#pragma unroll
                for (int it = 0; it < 8; ++it) S[it] = MFMA16(*(const LAS bf16x8*)(L + CH_KDT + (it * 2 + ks) * 1024), vb[ks], S[it]);
#pragma unroll
            for (int ks = 0; ks < 4; ++ks) Sb[ks] = __builtin_bit_cast(bf16x8, pk8(S[2 * ks], S[2 * ks + 1]));
            float* go = GO + (size_t)(b * T + n * 64 + 4 * fq) * D + h * 128 + sl * 16 + fr;
#pragma unroll
            for (int rt = 0; rt < 4; ++rt)
#pragma unroll
                for (int r = 0; r < 4; ++r) go[(size_t)(16 * rt + r) * D] = o[rt][r];
            if (n + 1 < 128) {
#pragma unroll
                for (int rt = 0; rt < 4; ++rt) ucur[rt] = unext[rt];
            }
            asm volatile("s_waitcnt vmcnt(20)" ::: "memory");
        }
        __syncthreads();
    }
    asm volatile("s_waitcnt vmcnt(0)" ::: "memory");
    __syncthreads();
#undef GDN_STAGE
}


#define MFMA32(a, b, c) __builtin_amdgcn_mfma_f32_32x32x16_bf16((a), (b), (c), 0, 0, 0)
typedef float f32x16 __attribute__((ext_vector_type(16)));
typedef float f32x2v __attribute__((ext_vector_type(2)));
constexpr int NL_RING = 32768;
constexpr int NL_IMP = 65536, NL_Q = 98304, NL_QF = 65536, NL_SELM = 131072;
constexpr float NSA_C = 0.08838834764831845f * 1.4426950408889634f;
__device__ __forceinline__ int vperm16(int off) { return ((off >> 2) & 1) * 8 + (off >> 3) * 4 + (off & 3); }

__device__ __forceinline__ float xor32f(float x) { const unsigned u = __builtin_bit_cast(unsigned, x); auto r = __builtin_amdgcn_permlane32_swap(u, u, false, false);
    return __builtin_bit_cast(float, (threadIdx.x & 32) ? r[0] : r[1]); }
__device__ __forceinline__ float qxor1f(float x) { return __builtin_bit_cast(float, __builtin_amdgcn_update_dpp(0, __builtin_bit_cast(int, x), 0xB1, 0xF, 0xF, false)); }
__device__ __forceinline__ float qxor2f(float x) { return __builtin_bit_cast(float, __builtin_amdgcn_update_dpp(0, __builtin_bit_cast(int, x), 0x4E, 0xF, 0xF, false)); }
__device__ __forceinline__ int kimg_off(int key, int d) { return (((d >> 3) * 64 + key) << 3) + (d & 7); }
__device__ __forceinline__ int vimg_off(int dv, int kpos) { return (((kpos >> 3) * 128 + dv) << 3) + (kpos & 7); }
__device__ __forceinline__ void nsa_stage(LAS unsigned char* lds, int buf, const unsigned char* kimg, const unsigned char* vimg, bool withv, int tid, int wave) {
#pragma unroll
    for (int i = 0; i < 2; ++i) __builtin_amdgcn_global_load_lds((const unsigned*)(kimg + (i * 512 + tid) * 16), (LAS unsigned*)(lds + buf * NL_RING + (i * 512 + wave * 64) * 16), 16, 0, 0);
    if (withv) {
#pragma unroll
        for (int i = 0; i < 2; ++i) __builtin_amdgcn_global_load_lds((const unsigned*)(vimg + (i * 512 + tid) * 16), (LAS unsigned*)(lds + buf * NL_RING + 16384 + (i * 512 + wave * 64) * 16), 16, 0, 0);
    }
}
#define NSA_SYNC(N) do { asm volatile("s_waitcnt vmcnt(" #N ")" ::: "memory"); __builtin_amdgcn_s_barrier(); asm volatile("" ::: "memory"); } while (0)
template <int MODE, int KIND>
__device__ __forceinline__ void nsa_tile(const LAS unsigned char* kb, const LAS unsigned char* vb, int kt, const LAS unsigned char* qlds, const bf16x8 (&Qh)[4], f32x16 (&O)[4], float& m, float& l,
                                         bool colok, int tl, int lim, float il, LAS float* imp_row, int sidx0, int r32, int hi) {
    f32x16 acc;
#pragma unroll
    for (int i = 0; i < 16; ++i) acc[i] = 0.f;
    { const LAS unsigned char* kr = kb + hi * 1024 + (32 * kt + r32) * 16;
        bf16x8 kf[4], qf[4];
#pragma unroll
        for (int ks = 0; ks < 4; ++ks) { kf[ks] = *(const LAS bf16x8*)(kr + ks * 2048); qf[ks] = *(const LAS bf16x8*)(qlds + ks * 1024); }
#pragma unroll
        for (int ks = 0; ks < 4; ++ks) acc = MFMA32(kf[ks], qf[ks], acc);
#pragma unroll
        for (int ks = 0; ks < 4; ++ks) kf[ks] = *(const LAS bf16x8*)(kr + (4 + ks) * 2048);
#pragma unroll
        for (int ks = 0; ks < 4; ++ks) acc = MFMA32(kf[ks], Qh[ks], acc);
        __builtin_amdgcn_sched_group_barrier(0x100, 8, 0);
        __builtin_amdgcn_sched_group_barrier(0x008, 1, 0); __builtin_amdgcn_sched_group_barrier(0x100, 1, 0);
        __builtin_amdgcn_sched_group_barrier(0x008, 1, 0); __builtin_amdgcn_sched_group_barrier(0x100, 1, 0);
        __builtin_amdgcn_sched_group_barrier(0x008, 1, 0); __builtin_amdgcn_sched_group_barrier(0x100, 1, 0);
        __builtin_amdgcn_sched_group_barrier(0x008, 1, 0); __builtin_amdgcn_sched_group_barrier(0x100, 1, 0);
        __builtin_amdgcn_sched_group_barrier(0x008, 4, 0); }
    if (!(KIND == 2 && MODE == 0)) {
#pragma unroll
        for (int reg = 0; reg < 16; ++reg) { const int koff = (reg & 3) + 8 * (reg >> 2) + 4 * hi; bool ok;
            if (MODE == 0) ok = colok; else if (MODE == 1) ok = colok && (32 * kt + koff <= tl); else if (MODE == 2) ok = colok && (32 * kt + koff >= tl + 1); else ok = koff < lim;
            acc[reg] = ok ? acc[reg] : -3e38f; }
    }
    float p[16];
    if (KIND == 0) {
        float tmax = acc[0];
#pragma unroll
        for (int reg = 1; reg < 16; ++reg) tmax = fmaxf(tmax, acc[reg]);
        tmax = fmaxf(tmax, xor32f(tmax));
        const float mnew = fmaxf(m, tmax); l *= __builtin_amdgcn_exp2f((m - mnew) * NSA_C); m = mnew;
        const float mref = fmaxf(m, -1e30f) * NSA_C; float ps = 0.f;
#pragma unroll
        for (int reg = 0; reg < 16; ++reg) ps += __builtin_amdgcn_exp2f(__builtin_fmaf(acc[reg], NSA_C, -mref));
        l += ps + xor32f(ps);
    } else if (KIND == 2) {
        if (__any(m < -1e37f)) {
            float tmax = acc[0];
#pragma unroll
            for (int reg = 1; reg < 16; ++reg) tmax = fmaxf(tmax, acc[reg]);
            tmax = fmaxf(tmax, xor32f(tmax));
            if (MODE == 0) tmax = colok ? tmax : -3e38f;
            m = (m < -1e37f) ? tmax : m;
        }
        float mref = (m < -1e37f) ? 3e38f : m * NSA_C;
        if (MODE == 0) mref = colok ? mref : 3e38f;
        f32x2v ps2 = {0.f, 0.f};
#pragma unroll
        for (int reg = 0; reg < 16; reg += 2) { p[reg] = __builtin_amdgcn_exp2f(fminf(__builtin_fmaf(acc[reg], NSA_C, -mref), 100.f)); p[reg + 1] = __builtin_amdgcn_exp2f(fminf(__builtin_fmaf(acc[reg + 1], NSA_C, -mref), 100.f));
            ps2 += (f32x2v){p[reg], p[reg + 1]}; }
        const float ps = ps2.x + ps2.y;
        l += ps + xor32f(ps);
    } else {
        const float mref = fmaxf(m, -1e30f) * NSA_C;
#pragma unroll
        for (int reg = 0; reg < 16; ++reg) p[reg] = __builtin_amdgcn_exp2f(__builtin_fmaf(acc[reg], NSA_C, -mref)) * il;
#pragma unroll
        for (int q = 0; q < 4; ++q) { float gsum = 2.f * (p[4 * q] + p[4 * q + 1] + p[4 * q + 2]) + p[4 * q + 3], ls = p[4 * q + 3];
            gsum += qxor1f(gsum); ls += qxor1f(ls); gsum += qxor2f(gsum); ls += qxor2f(ls);
            if ((r32 & 3) == 0) { const int sidx = sidx0 + 2 * q + hi;
                __hip_atomic_fetch_add(imp_row + sidx, gsum, __ATOMIC_RELAXED, __HIP_MEMORY_SCOPE_WORKGROUP);
                if (sidx + 1 < NSEL) __hip_atomic_fetch_add(imp_row + sidx + 1, ls, __ATOMIC_RELAXED, __HIP_MEMORY_SCOPE_WORKGROUP); } }
    }
    if (KIND != 0) {
        bf16x8 pb[2];
#pragma unroll
        for (int s2 = 0; s2 < 2; ++s2) { u32x4 w; w.x = pk2(p[8 * s2], p[8 * s2 + 1]); w.y = pk2(p[8 * s2 + 2], p[8 * s2 + 3]); w.z = pk2(p[8 * s2 + 4], p[8 * s2 + 5]); w.w = pk2(p[8 * s2 + 6], p[8 * s2 + 7]); pb[s2] = __builtin_bit_cast(bf16x8, w); }
#pragma unroll
        for (int mt = 0; mt < 4; ++mt) { const LAS unsigned char* vr = vb + hi * 2048 + (32 * mt + r32) * 16;
#pragma unroll
            for (int s2 = 0; s2 < 2; ++s2) O[mt] = MFMA32(*(const LAS bf16x8*)(vr + (2 * kt + s2) * 4096), pb[s2], O[mt]); }
        __builtin_amdgcn_sched_group_barrier(0x100, 8, 1);
        __builtin_amdgcn_sched_group_barrier(0x008, 8, 1);
    }
}

template <int MODE>
__device__ __forceinline__ void nsa_block_fast(const LAS unsigned char* slot, const LAS unsigned char* qf, f32x16 (&O)[4], float m, float& l, bool colok, int tl, int r32, int hi) {
    const LAS unsigned char* kr = slot + hi * 1024 + r32 * 16;
    const LAS unsigned char* vb = slot + 16384 + hi * 2048 + r32 * 16;
    float mref = m * NSA_C;
    if (MODE == 0) mref = colok ? mref : 3e38f;
    f32x16 a0, a1;
#pragma unroll
    for (int i = 0; i < 16; ++i) { a0[i] = 0.f; a1[i] = 0.f; }
    bf16x8 vv[8];
    {
        bf16x8 qv[8], kv[8];
#pragma unroll
        for (int ks = 0; ks < 8; ++ks) { qv[ks] = *(const LAS bf16x8*)(qf + ks * 1024); kv[ks] = *(const LAS bf16x8*)(kr + ks * 2048); }
#pragma unroll
        for (int ks = 0; ks < 8; ++ks) a0 = MFMA32(kv[ks], qv[ks], a0);
#pragma unroll
        for (int ks = 0; ks < 8; ++ks) kv[ks] = *(const LAS bf16x8*)(kr + 512 + ks * 2048);
#pragma unroll
        for (int ks = 0; ks < 8; ++ks) a1 = MFMA32(kv[ks], qv[ks], a1);
    }
#pragma unroll
    for (int mt = 0; mt < 4; ++mt)
#pragma unroll
        for (int s2 = 0; s2 < 2; ++s2) vv[mt * 2 + s2] = *(const LAS bf16x8*)(vb + mt * 512 + s2 * 4096);
    f32x2v ps2 = {0.f, 0.f};
    bf16x8 pb[2];
#pragma unroll
    for (int reg = 0; reg < 16; reg += 2) { float x0 = a0[reg], x1 = a0[reg + 1];
        if (MODE != 0) { const int k0 = (reg & 3) + 8 * (reg >> 2) + 4 * hi, k1 = k0 + 1; const bool o0 = colok && (MODE == 1 ? (k0 <= tl) : (k0 >= tl + 1)), o1 = colok && (MODE == 1 ? (k1 <= tl) : (k1 >= tl + 1)); x0 = o0 ? x0 : -3e38f; x1 = o1 ? x1 : -3e38f; }
        x0 = __builtin_amdgcn_exp2f(fminf(__builtin_fmaf(x0, NSA_C, -mref), 100.f)); x1 = __builtin_amdgcn_exp2f(fminf(__builtin_fmaf(x1, NSA_C, -mref), 100.f));
        ps2 += (f32x2v){x0, x1}; a0[reg] = x0; a0[reg + 1] = x1; }
#pragma unroll
    for (int s2 = 0; s2 < 2; ++s2) { u32x4 w; w.x = pk2(a0[8 * s2], a0[8 * s2 + 1]); w.y = pk2(a0[8 * s2 + 2], a0[8 * s2 + 3]); w.z = pk2(a0[8 * s2 + 4], a0[8 * s2 + 5]); w.w = pk2(a0[8 * s2 + 6], a0[8 * s2 + 7]); pb[s2] = __builtin_bit_cast(bf16x8, w); }
#pragma unroll
    for (int mt = 0; mt < 4; ++mt)
#pragma unroll
        for (int s2 = 0; s2 < 2; ++s2) O[mt] = MFMA32(vv[mt * 2 + s2], pb[s2], O[mt]);
#pragma unroll
    for (int mt = 0; mt < 4; ++mt)
#pragma unroll
        for (int s2 = 0; s2 < 2; ++s2) vv[mt * 2 + s2] = *(const LAS bf16x8*)(vb + mt * 512 + (2 + s2) * 4096);
#pragma unroll
    for (int reg = 0; reg < 16; reg += 2) { float x0 = a1[reg], x1 = a1[reg + 1];
        if (MODE != 0) { const int k0 = 32 + (reg & 3) + 8 * (reg >> 2) + 4 * hi, k1 = k0 + 1; const bool o0 = colok && (MODE == 1 ? (k0 <= tl) : (k0 >= tl + 1)), o1 = colok && (MODE == 1 ? (k1 <= tl) : (k1 >= tl + 1)); x0 = o0 ? x0 : -3e38f; x1 = o1 ? x1 : -3e38f; }
        x0 = __builtin_amdgcn_exp2f(fminf(__builtin_fmaf(x0, NSA_C, -mref), 100.f)); x1 = __builtin_amdgcn_exp2f(fminf(__builtin_fmaf(x1, NSA_C, -mref), 100.f));
        ps2 += (f32x2v){x0, x1}; a1[reg] = x0; a1[reg + 1] = x1; }
#pragma unroll
    for (int s2 = 0; s2 < 2; ++s2) { u32x4 w; w.x = pk2(a1[8 * s2], a1[8 * s2 + 1]); w.y = pk2(a1[8 * s2 + 2], a1[8 * s2 + 3]); w.z = pk2(a1[8 * s2 + 4], a1[8 * s2 + 5]); w.w = pk2(a1[8 * s2 + 6], a1[8 * s2 + 7]); pb[s2] = __builtin_bit_cast(bf16x8, w); }
#pragma unroll
    for (int mt = 0; mt < 4; ++mt)
#pragma unroll
        for (int s2 = 0; s2 < 2; ++s2) O[mt] = MFMA32(vv[mt * 2 + s2], pb[s2], O[mt]);
    const float ps = ps2.x + ps2.y;
    l += ps + xor32f(ps);
}
template <int MODE>
__device__ __forceinline__ void nsa_block(const LAS unsigned char* slot, const LAS unsigned char* qf, f32x16 (&O)[4], float& m, float& l, bool colok, int tl, int r32, int hi) {
    if (__any(m < -1e37f)) {
        bf16x8 Qh[4];
#pragma unroll
        for (int ks = 0; ks < 4; ++ks) Qh[ks] = *(const LAS bf16x8*)(qf + (4 + ks) * 1024);
#pragma unroll 1
        for (int kt = 0; kt < 2; ++kt) nsa_tile<MODE, 2>(slot, slot + 16384, kt, qf, Qh, O, m, l, colok, tl, 0, 0.f, (LAS float*)slot, 0, r32, hi);
    } else nsa_block_fast<MODE>(slot, qf, O, m, l, colok, tl, r32, hi);
}

__device__ __forceinline__ void nsa_item(const Params& p, unsigned char* ws, LAS unsigned char* lds, int item, int tid, int lane, int wave) {
    const int tile = 127 - (item >> 2), bg = item & 3, b = bg >> 1, g = bg & 1, t0 = tile * 64, cur = tile;
    const int r32 = lane & 31, hi = lane >> 5, tl = 8 * wave + (r32 >> 2), head = g * 4 + (r32 & 3), t = t0 + tl, tok = b * T + t;
    const bf16_t* PROJ = (const bf16_t*)(ws + WS_PROJ);
    LAS float* IMP = (LAS float*)(lds + NL_IMP); LAS unsigned* SELM = (LAS unsigned*)(lds + NL_SELM);
    __syncthreads();
    nsa_stage(lds, 0, ws + WS_KC + (size_t)(bg * 8) * 16384, ws + WS_VC, false, tid, wave);
    for (int idx = tid; idx < 64 * NSEL; idx += NTHREADS) IMP[idx] = 0.f;
    LAS unsigned char* const qlds = lds + NL_Q + wave * 4096 + hi * 512 + r32 * 16;
    bf16x8 Qh[4];
#pragma unroll
    for (int ks = 0; ks < 4; ++ks) { *(LAS bf16x8*)(qlds + ks * 1024) = *(const bf16x8*)(PROJ + (size_t)tok * DINP + C_NQ + head * 128 + 16 * ks + 8 * hi);
        Qh[ks] = *(const bf16x8*)(PROJ + (size_t)tok * DINP + C_NQ + head * 128 + 16 * (4 + ks) + 8 * hi); }
    f32x16 O[4];
    float m, l;
#define OB_PTR() bf16_t* ob; { int tk_ = tok; asm volatile("" : "+v"(tk_)); ob = (bf16_t*)(ws + WS_OB) + (size_t)tk_ * D + head * 128 + 4 * hi; }
#define O_ZERO() do { _Pragma("unroll") for (int mt = 0; mt < 4; ++mt) _Pragma("unroll") for (int i = 0; i < 16; ++i) O[mt][i] = 0.f; } while (0)
#define RING_LOOP(NBLK, NOPS, STAGE, ...) do { const int nblk_ = (NBLK); \
        { const int sb_ = 0, slot_ = 0; STAGE; } if (nblk_ > 1) { const int sb_ = 1, slot_ = 1; STAGE; NSA_SYNC(NOPS); } else { NSA_SYNC(0); } \
        int cs_ = 0; \
        _Pragma("unroll 1") for (int st_ = 0; st_ < 2 * nblk_; ++st_) { \
            const int s = st_ >> 1, kt = st_ & 1; const bool more_ = (s + 2 < nblk_); \
            if (kt == 0 && more_) { const int sb_ = s + 2, slot_ = (cs_ == 0 ? 2 : cs_ - 1); STAGE; } \
            { const LAS unsigned char* slotp = lds + cs_ * NL_RING; __VA_ARGS__; } \
            if (kt == 1) { if (more_) { NSA_SYNC(NOPS); } else { NSA_SYNC(0); } cs_ = (cs_ == 2 ? 0 : cs_ + 1); } } } while (0)
#define RING_LOOPB(NBLK, NOPS, STAGE, ...) do { const int nblk_ = (NBLK); \
        { const int sb_ = 0, slot_ = 0; STAGE; } if (nblk_ > 1) { const int sb_ = 1, slot_ = 1; STAGE; NSA_SYNC(NOPS); } else { NSA_SYNC(0); } \
        int cs_ = 0; \
        _Pragma("unroll 1") for (int s = 0; s < nblk_; ++s) { const bool more_ = (s + 2 < nblk_); \
            if (more_) { const int sb_ = s + 2, slot_ = (cs_ == 0 ? 2 : cs_ - 1); STAGE; } \
            { const LAS unsigned char* slotp = lds + cs_ * NL_RING; __VA_ARGS__; } \
            if (more_) { NSA_SYNC(NOPS); } else { NSA_SYNC(0); } cs_ = (cs_ == 2 ? 0 : cs_ + 1); } } while (0)
#define RING_LOOP2(NBLK, NOPS, STAGE, ...) do { const int nblk_ = (NBLK); \
        NSA_SYNC(0);   \
        _Pragma("unroll 1") for (int st_ = 0; st_ < 2 * nblk_; ++st_) { \
            const int s = st_ >> 1, kt = st_ & 1; \
            if (kt == 0 && s + 1 < nblk_) { const int sb_ = s + 1, slot_ = (s + 1) & 1; STAGE; } \
            { const LAS unsigned char* slotp = lds + (s & 1) * NL_RING; __VA_ARGS__; } \
            if (kt == 1) { NSA_SYNC(0); } } } while (0)
#define RING_LOOPB2(NBLK, STAGE, ...) do { const int nblk_ = (NBLK); \
        NSA_SYNC(0);   \
        _Pragma("unroll 1") for (int s = 0; s < nblk_; ++s) { \
            if (s + 1 < nblk_) { const int sb_ = s + 1, slot_ = (s + 1) & 1; STAGE; } \
            { const LAS unsigned char* slotp = lds + (s & 1) * NL_RING; __VA_ARGS__; } \
            NSA_SYNC(0); } } while (0)
#define RING_LOOP4(NBLK, STAGE, ...) do { const int nblk_ = (NBLK); \
        { const int sb_ = 0, slot_ = 0; STAGE; } if (nblk_ > 1) { const int sb_ = 1, slot_ = 1; STAGE; } if (nblk_ > 2) { const int sb_ = 2, slot_ = 2; STAGE; } \
        if (nblk_ > 2) { NSA_SYNC(8); } else if (nblk_ > 1) { NSA_SYNC(4); } else { NSA_SYNC(0); } \
        int cs_ = 0; \
        _Pragma("unroll 1") for (int st_ = 0; st_ < 2 * nblk_; ++st_) { \
            const int s = st_ >> 1, kt = st_ & 1; \
            if (kt == 0 && s + 3 < nblk_) { const int sb_ = s + 3, slot_ = (cs_ + 3) & 3; STAGE; } \
            { const LAS unsigned char* slotp = lds + cs_ * NL_RING; __VA_ARGS__; } \
            if (kt == 1) { if (s + 3 < nblk_) { NSA_SYNC(8); } else if (s + 2 < nblk_) { NSA_SYNC(4); } else { NSA_SYNC(0); } cs_ = (cs_ + 1) & 3; } } } while (0)
    const int nvis = t >= 31 ? min((t - 31) / 16 + 1, NCMP) : 0;
    const int nbc = (min(4 * tile + 3, NCMP) + 63) >> 6;
    const unsigned char* kcb = ws + WS_KC + (size_t)(b * 2 + g) * 8 * 16384; const unsigned char* vcb = ws + WS_VC + (size_t)(b * 2 + g) * 8 * 16384;
    m = -3e38f; l = 0.f;
    RING_LOOP2(nbc, 2, nsa_stage(lds, slot_, kcb + (size_t)sb_ * 16384, vcb, false, tid, wave),
              (nsa_tile<3, 0>(slotp, slotp + 16384, kt, qlds, Qh, O, m, l, true, tl, nvis - 64 * s - 32 * kt, 0.f, IMP, 0, r32, hi)));
    nsa_stage(lds, 0, kcb, vcb, true, tid, wave);
    {
        const float il = 1.f / fmaxf(l, 1e-30f);
        O_ZERO();
        RING_LOOP2(nbc, 4, nsa_stage(lds, slot_, kcb + (size_t)sb_ * 16384, vcb + (size_t)sb_ * 16384, true, tid, wave),
                  (nsa_tile<3, 1>(slotp, slotp + 16384, kt, qlds, Qh, O, m, l, true, tl, nvis - 64 * s - 32 * kt, il, IMP + tl * NSEL, 16 * s + 8 * kt, r32, hi)));
        nsa_stage(lds, 0, ws + WS_KSR + (size_t)(bg * 128) * 16384, ws + WS_VST + (size_t)(bg * 128) * 16384, true, tid, wave);
        const float gt = sigmoidf_(bf2f(PROJ[(size_t)tok * DINP + C_NG + head * 3 + 0]));
        OB_PTR();
#pragma unroll
        for (int mt = 0; mt < 4; ++mt)
#pragma unroll
            for (int q = 0; q < 4; ++q) { u32x2 w; w.x = pk2(O[mt][4 * q] * gt, O[mt][4 * q + 1] * gt); w.y = pk2(O[mt][4 * q + 2] * gt, O[mt][4 * q + 3] * gt); *(u32x2*)(ob + 32 * mt + 8 * q) = w; }
    }
    {
#pragma unroll 1
        for (int tt = 0; tt < 8; tt += 4) {
            unsigned key0[4], key1[4], thr[4];
#pragma unroll
            for (int q = 0; q < 4; ++q) { const int tokl = 8 * wave + tt + q; const LAS float* ip = IMP + tokl * NSEL; key0[q] = 0u; key1[q] = 0u; thr[q] = 0u;
                const int s0 = lane, s1 = lane + 64;
                if (s0 <= cur) { const bool forced = (s0 == 0) || (s0 == cur) || (s0 == cur - 1); key0[q] = ((__builtin_bit_cast(unsigned, ip[s0] + (forced ? 1e4f : 0.f)) | 0x80u) & ~0x7Fu) | (unsigned)(127 - s0); }
                if (s1 <= cur) { const bool forced = (s1 == cur) || (s1 == cur - 1); key1[q] = ((__builtin_bit_cast(unsigned, ip[s1] + (forced ? 1e4f : 0.f)) | 0x80u) & ~0x7Fu) | (unsigned)(127 - s1); } }
#pragma unroll 2
            for (int bit = 30; bit >= 0; --bit) {
#pragma unroll
                for (int q = 0; q < 4; ++q) { const unsigned trial = thr[q] | (1u << bit);
                    const int cnt = __popcll(__ballot(key0[q] >= trial)) + __popcll(__ballot(key1[q] >= trial));
                    thr[q] = (cnt >= TOPN) ? trial : thr[q]; } }
#pragma unroll
            for (int q = 0; q < 4; ++q) { const int tokl = 8 * wave + tt + q;
                const unsigned long long b0 = __ballot(key0[q] != 0u && key0[q] >= thr[q]), b1 = __ballot(key1[q] != 0u && key1[q] >= thr[q]);
                if (lane == 0) { SELM[tokl * 4 + 0] = (unsigned)b0; SELM[tokl * 4 + 1] = (unsigned)(b0 >> 32); SELM[tokl * 4 + 2] = (unsigned)b1; SELM[tokl * 4 + 3] = (unsigned)(b1 >> 32); } }
        }
        LDS_FENCE();
    }
    __syncthreads();
    LAS unsigned char* const qf = lds + NL_QF + wave * 8192 + hi * 512 + r32 * 16;
    { int tk_ = tok; asm volatile("" : "+v"(tk_)); const bf16_t* qr = (const bf16_t*)(ws + WS_QR) + (size_t)tk_ * D + head * 128 + 8 * hi;
#pragma unroll
        for (int ks = 0; ks < 8; ++ks) *(LAS bf16x8*)(qf + ks * 1024) = *(const bf16x8*)(qr + 16 * ks); }
    {
        const unsigned char* kb0 = ws + WS_KSR + (size_t)(b * 2 + g) * 128 * 16384; const unsigned char* vb0 = ws + WS_VST + (size_t)(b * 2 + g) * 128 * 16384;
        m = -3e38f; l = 0.f; O_ZERO();
        RING_LOOPB2(cur + 1, nsa_stage(lds, slot_, kb0 + (size_t)sb_ * 16384, vb0 + (size_t)sb_ * 16384, true, tid, wave),
                  { const bool colok = (SELM[tl * 4 + (s >> 5)] >> (s & 31)) & 1u;
                    if (__any(colok)) { if (s == cur) nsa_block<1>(slotp, qf, O, m, l, colok, tl, r32, hi); else nsa_block<0>(slotp, qf, O, m, l, colok, tl, r32, hi); } });
        { const int slo_ = cur >= 8 ? cur - 8 : 0; nsa_stage(lds, 0, ws + WS_KWR + (size_t)(bg * 128 + slo_) * 16384, ws + WS_VWT + (size_t)(bg * 128 + slo_) * 16384, true, tid, wave); }
        const float gt = sigmoidf_(bf2f(PROJ[(size_t)tok * DINP + C_NG + head * 3 + 1])) / fmaxf(l, 1e-30f);
        OB_PTR();
        u32x2 ow[16];
#pragma unroll
        for (int i = 0; i < 16; ++i) ow[i] = *(const u32x2*)(ob + 32 * (i >> 2) + 8 * (i & 3));
        asm volatile("" ::: "memory");
#pragma unroll
        for (int mt = 0; mt < 4; ++mt)
#pragma unroll
            for (int q = 0; q < 4; ++q) { u32x2 w = ow[mt * 4 + q];
                w.x = pk2(bflo(w.x) + O[mt][4 * q] * gt, bfhi(w.x) + O[mt][4 * q + 1] * gt); w.y = pk2(bflo(w.y) + O[mt][4 * q + 2] * gt, bfhi(w.y) + O[mt][4 * q + 3] * gt); *(u32x2*)(ob + 32 * mt + 8 * q) = w; }
    }
    {
        const int slo = cur >= 8 ? cur - 8 : 0;
        const unsigned char* kb0 = ws + WS_KWR + (size_t)((b * 2 + g) * 128 + slo) * 16384; const unsigned char* vb0 = ws + WS_VWT + (size_t)((b * 2 + g) * 128 + slo) * 16384;
        m = -3e38f; l = 0.f; O_ZERO();
        RING_LOOPB2(cur - slo + 1, nsa_stage(lds, slot_, kb0 + (size_t)sb_ * 16384, vb0 + (size_t)sb_ * 16384, true, tid, wave),
                  { const int sa = slo + s; if (sa == cur) nsa_block<1>(slotp, qf, O, m, l, true, tl, r32, hi);
                    else if (sa == cur - 8) nsa_block<2>(slotp, qf, O, m, l, true, tl, r32, hi);
                    else nsa_block<0>(slotp, qf, O, m, l, true, tl, r32, hi); });
        const float gt = sigmoidf_(bf2f(PROJ[(size_t)tok * DINP + C_NG + head * 3 + 2])) / fmaxf(l, 1e-30f);
        OB_PTR();
        u32x2 ow[16];
#pragma unroll
        for (int i = 0; i < 16; ++i) ow[i] = *(const u32x2*)(ob + 32 * (i >> 2) + 8 * (i & 3));
        asm volatile("" ::: "memory");
#pragma unroll
        for (int mt = 0; mt < 4; ++mt)
#pragma unroll
            for (int q = 0; q < 4; ++q) { u32x2 w = ow[mt * 4 + q];
                w.x = pk2(bflo(w.x) + O[mt][4 * q] * gt, bfhi(w.x) + O[mt][4 * q + 1] * gt); w.y = pk2(bflo(w.y) + O[mt][4 * q + 2] * gt, bfhi(w.y) + O[mt][4 * q + 3] * gt); *(u32x2*)(ob + 32 * mt + 8 * q) = w; }
    }
    asm volatile("s_waitcnt vmcnt(0)" ::: "memory");
#undef OB_PTR
#undef O_ZERO
}

__device__ __forceinline__ void cmp_item(const Params& p, unsigned char* ws, LAS unsigned char* lds, int item, int tid, int lane, int wave) {
    asm volatile("" : "+v"(tid)); lane = tid & 63;
    const int which = item >> 6, b = (item >> 5) & 1, g = (item >> 4) & 1, n0 = (item & 15) * 32;
    const bf16_t* PROJ = (const bf16_t*)(ws + WS_PROJ);
    const int ccol = (which ? C_NVC : C_NKC) + g * 128;
    const float* pe = p.in[which ? 11 : 8];
    const unsigned char* w1t = ws + WS_W1T + (size_t)which * 128 * 4096 * 2;
    const int fr = lane & 15, fq = lane >> 4;
    LAS unsigned char* LA = lds; LAS unsigned char* LB = lds + 16384; LAS bf16_t* HID = (LAS bf16_t*)(lds + 81920); LAS bf16_t* W2L = (LAS bf16_t*)(lds + 90624);
    __syncthreads();
    { const bf16_t* w2t = (const bf16_t*)(ws + WS_W2T) + which * 128 * 128;
        for (int idx = tid; idx < 128 * 16; idx += NTHREADS) { const int rr = idx >> 4, c = idx & 15; *(LAS u32x4*)(W2L + rr * PK + c * 8) = *(const u32x4*)(w2t + rr * 128 + c * 8); } }
    const int arow = tid >> 4, ach = tid & 15;
    auto stageB = [&](int pp, int buf) {
#pragma unroll
        for (int i = 0; i < 4; ++i) { const int pi = tid + 512 * i, row = pi >> 4, ch = (pi & 15) ^ (row & 15);
            __builtin_amdgcn_global_load_lds((const unsigned*)(w1t + (size_t)row * 8192 + pp * 256 + ch * 16), (LAS unsigned*)(LB + buf * 32768 + (i * 512 + wave * 64) * 16), 16, 0, 0); } };
    auto loadA = [&](int pp) -> u32x4 { const int tkn = 16 * (n0 + arow) + pp;
        if (tkn >= T) return (u32x4){0u, 0u, 0u, 0u};
        const u32x4 x = *(const u32x4*)(PROJ + (size_t)(b * T + tkn) * DINP + ccol + ach * 8); const f32x4 e0 = *(const f32x4*)(pe + pp * 128 + ach * 8), e1 = *(const f32x4*)(pe + pp * 128 + ach * 8 + 4);
        u32x4 o; o.x = pk2(bflo(x.x) + e0.x, bfhi(x.x) + e0.y); o.y = pk2(bflo(x.y) + e0.z, bfhi(x.y) + e0.w); o.z = pk2(bflo(x.z) + e1.x, bfhi(x.z) + e1.y); o.w = pk2(bflo(x.w) + e1.z, bfhi(x.w) + e1.w); return o; };
    f32x4 acc[2] = {(f32x4){0.f, 0.f, 0.f, 0.f}, (f32x4){0.f, 0.f, 0.f, 0.f}};
    stageB(0, 0); u32x4 areg = loadA(0);
    *(LAS u32x4*)(LA + arow * 256 + ((ach ^ (arow & 15)) << 4)) = areg;
    asm volatile("s_waitcnt vmcnt(0)" ::: "memory"); __syncthreads();
#pragma unroll 1
    for (int pp = 0; pp < 32; ++pp) { const int buf = pp & 1;
        if (pp + 1 < 32) { stageB(pp + 1, buf ^ 1); areg = loadA(pp + 1); }
        const LAS unsigned char* Ab = LA + buf * 8192; const LAS unsigned char* Bb = LB + buf * 32768;
#pragma unroll
        for (int kk = 0; kk < 4; ++kk) { const int wrow = 16 * wave + fr;
            const bf16x8 wf = *(const LAS bf16x8*)(Bb + wrow * 256 + (((4 * kk + fq) ^ (wrow & 15)) << 4));
#pragma unroll
            for (int nt = 0; nt < 2; ++nt) { const int nrow = 16 * nt + fr;
                acc[nt] = MFMA16(wf, *(const LAS bf16x8*)(Ab + nrow * 256 + (((4 * kk + fq) ^ (nrow & 15)) << 4)), acc[nt]); } }
        if (pp + 1 < 32) *(LAS u32x4*)(LA + (buf ^ 1) * 8192 + arow * 256 + ((ach ^ (arow & 15)) << 4)) = areg;
        asm volatile("s_waitcnt vmcnt(0)" ::: "memory"); __syncthreads();
    }
#pragma unroll
    for (int nt = 0; nt < 2; ++nt) { f32x4 hv;
#pragma unroll
        for (int r = 0; r < 4; ++r) hv[r] = siluf_(acc[nt][r]);
        *(LAS u32x2*)(HID + (16 * nt + fr) * PK + 16 * wave + 4 * fq) = pk4(hv); }
    __syncthreads();
    if (which == 0) {
        f32x4 o[2] = {(f32x4){0.f, 0.f, 0.f, 0.f}, (f32x4){0.f, 0.f, 0.f, 0.f}};
#pragma unroll
        for (int kk = 0; kk < 4; ++kk) { const bf16x8 af = FRAG(W2L, PK, 16 * wave + fr, 32 * kk + 8 * fq);
#pragma unroll
            for (int nt = 0; nt < 2; ++nt) o[nt] = MFMA16(af, FRAG(HID, PK, 16 * nt + fr, 32 * kk + 8 * fq), o[nt]); }
#pragma unroll
        for (int nt = 0; nt < 2; ++nt) { const int n = n0 + 16 * nt + fr; const f32x4 z = {0.f, 0.f, 0.f, 0.f};
            *(u32x2*)((bf16_t*)(ws + WS_KC) + ((size_t)((b * 2 + g) * 8 + (n >> 6)) << 13) + kimg_off(n & 63, 16 * wave + 4 * fq)) = pk4(n < NCMP ? o[nt] : z); }
    } else {
        f32x4 o[2] = {(f32x4){0.f, 0.f, 0.f, 0.f}, (f32x4){0.f, 0.f, 0.f, 0.f}};
#pragma unroll
        for (int kk = 0; kk < 4; ++kk) { const bf16x8 bfw = FRAG(W2L, PK, 16 * wave + fr, 32 * kk + 8 * fq);
#pragma unroll
            for (int nt = 0; nt < 2; ++nt) o[nt] = MFMA16(FRAG(HID, PK, 16 * nt + fr, 32 * kk + 8 * fq), bfw, o[nt]); }
#pragma unroll
        for (int nt = 0; nt < 2; ++nt) { f32x4 v = o[nt]; if (n0 + 16 * nt + 4 * fq + 3 >= NCMP) { if (n0 + 16 * nt + 4 * fq + 3 == NCMP) v[3] = 0.f; }
            { const int nb = n0 + 16 * nt; *(u32x2*)((bf16_t*)(ws + WS_VC) + ((size_t)((b * 2 + g) * 8 + (nb >> 6)) << 13) + vimg_off(16 * wave + fr, (nb & 63) + (fq & 1) * 8 + (fq >> 1) * 4)) = pk4(v); } }
    }
}

__device__ __forceinline__ void xattn_item(unsigned char* ws, LAS unsigned char* lds, int item, int tid, int lane, int wave) {
    const int b = item >> 7, h = (item >> 5) & 3, t0 = (item & 31) * 256;
    const int r32 = lane & 31, hi = lane >> 5, tok = b * T + t0 + 32 * wave + r32;
    LAS unsigned char* const qf = lds + NL_QF + wave * 8192 + hi * 512 + r32 * 16;
    __syncthreads();
#pragma unroll
    for (int ks = 0; ks < 8; ++ks) *(LAS bf16x8*)(qf + ks * 1024) = *(const bf16x8*)((const bf16_t*)(ws + WS_QX) + (size_t)tok * XD + h * 128 + 16 * ks + 8 * hi);
    f32x16 O[4]; float m = -3e38f, l = 0.f;
#pragma unroll
    for (int mt = 0; mt < 4; ++mt)
#pragma unroll
        for (int i = 0; i < 16; ++i) O[mt][i] = 0.f;
    const unsigned char* kb0 = ws + WS_XVT + 524288 + (size_t)(b * 4 + h) * 4 * 16384; const unsigned char* vb0 = ws + WS_XVT + (size_t)(b * 4 + h) * 4 * 16384;
    __syncthreads();
    nsa_stage(lds, 0, kb0, vb0, true, tid, wave);
    RING_LOOPB2(4, nsa_stage(lds, slot_, kb0 + (size_t)sb_ * 16384, vb0 + (size_t)sb_ * 16384, true, tid, wave),
              (nsa_block<0>(slotp, qf, O, m, l, true, 0, r32, hi)));
    const float il = 1.f / l;
    bf16_t* ox = (bf16_t*)(ws + WS_OX) + (size_t)tok * XD + h * 128 + 4 * hi;
#pragma unroll
    for (int mt = 0; mt < 4; ++mt)
#pragma unroll
        for (int q = 0; q < 4; ++q) { u32x2 w; w.x = pk2(O[mt][4 * q] * il, O[mt][4 * q + 1] * il); w.y = pk2(O[mt][4 * q + 2] * il, O[mt][4 * q + 3] * il); *(u32x2*)(ox + 32 * mt + 8 * q) = w; }
}


#define XB_TMO      128
#define XB_XCNT(j)  (256  + 64 * (j))
#define XB_XSUB(j)  (1280 + 64 * (j))
#define XB_XGEN(j)  (2304 + 64 * (j))
#define XB_TOP      3328
#define XB_TOPGEN   3392
#define XCD_BAR_WORDS 3456
#define XB_SPIN_CAP (1u << 18)
__device__ __forceinline__ unsigned xb_ld(unsigned* p)              { return __hip_atomic_load(p, __ATOMIC_RELAXED, __HIP_MEMORY_SCOPE_AGENT); }
__device__ __forceinline__ unsigned xb_add(unsigned* p, unsigned v) { return __hip_atomic_fetch_add(p, v, __ATOMIC_RELAXED, __HIP_MEMORY_SCOPE_AGENT); }
__device__ __forceinline__ unsigned xb_xcc_id() { return (unsigned)__builtin_amdgcn_s_getreg((3 << 11) | 20) & 0xFu; }
#define XB_SPIN(cond, bar) do { unsigned _sp = 0; while (cond) { __builtin_amdgcn_s_sleep(1); \
    if ((++_sp & 255u) == 0u) { if (xb_ld(&(bar)[XB_TMO])) break; if (_sp > XB_SPIN_CAP) { atomicAdd(&(bar)[XB_TMO], 1u); break; } } } } while (0)
struct XcdBarrier { unsigned* bar; unsigned x; volatile LAS unsigned* st; };
__device__ __forceinline__ XcdBarrier xcd_barrier_post(unsigned* bar, volatile LAS unsigned* st) {
    XcdBarrier b; b.bar = bar; b.x = xb_xcc_id(); b.st = st;
    if (threadIdx.x == 0) (void)xb_add(&bar[XB_XCNT(b.x)], 1u);
    return b;
}
__device__ __forceinline__ void xcd_barrier_complete(unsigned* bar, unsigned x, unsigned& nloc, unsigned& nx) {
    const unsigned G = gridDim.x * gridDim.y * gridDim.z;
    unsigned sum, cnt, mine, sp = 0u;
    for (;;) {
        sum = 0u; cnt = 0u; mine = 0u;
#pragma unroll
        for (unsigned j = 0; j < 16; ++j) { const unsigned c = xb_ld(&bar[XB_XCNT(j)]); sum += c; cnt += (c > 0u) ? 1u : 0u; mine = (j == x) ? c : mine; }
        if (sum == G) break;
        __builtin_amdgcn_s_sleep(1);
        if ((++sp & 255u) == 0u) { if (xb_ld(&bar[XB_TMO])) break; if (sp > XB_SPIN_CAP) { atomicAdd(&bar[XB_TMO], 1u); break; } }
    }
    nloc = mine > 0u ? mine : 1u; nx = cnt > 0u ? cnt : 1u;
}
__device__ __forceinline__ void xcd_barrier(const XcdBarrier& b) {
    asm volatile("s_waitcnt vmcnt(0)" ::: "memory");
    __syncthreads();
    if (threadIdx.x == 0) {
        unsigned* bar = b.bar;
        __builtin_amdgcn_s_waitcnt(0);
        unsigned nloc = b.st[0], nx = b.st[1];
        if (nloc == 0u) { xcd_barrier_complete(bar, b.x, nloc, nx); b.st[0] = nloc; b.st[1] = nx; }
        const unsigned old = xb_add(&bar[XB_XSUB(b.x)], 1u);
        const unsigned gen = old / nloc;
        if (old + 1u == (gen + 1u) * nloc) {
            __builtin_amdgcn_fence(__ATOMIC_RELEASE, "agent");
            asm volatile("s_waitcnt vmcnt(0)" ::: "memory");
            const unsigned og = xb_add(&bar[XB_TOP], 1u);
            const unsigned tg = og / nx;
            if (og + 1u == (tg + 1u) * nx) xb_add(&bar[XB_TOPGEN], 1u);
            else XB_SPIN(xb_ld(&bar[XB_TOPGEN]) == tg, bar);
            __builtin_amdgcn_fence(__ATOMIC_ACQUIRE, "agent");
            xb_add(&bar[XB_XGEN(b.x)], 1u);
            asm volatile("s_waitcnt vmcnt(0)" ::: "memory");
        } else {
            XB_SPIN(xb_ld(&bar[XB_XGEN(b.x)]) == gen, bar);
            __builtin_amdgcn_fence(__ATOMIC_ACQUIRE, "agent");
            asm volatile("s_waitcnt vmcnt(0)" ::: "memory");
        }
    }
    __syncthreads();
}

__global__ void __launch_bounds__(NTHREADS) mega(Params p) {
    extern __shared__ __attribute__((aligned(16))) unsigned char smem[];
    LAS unsigned char* lds = (LAS unsigned char*)smem;
    cg::grid_group grid = cg::this_grid();
    const int tid = threadIdx.x, lane = tid & 63, wave = __builtin_amdgcn_readfirstlane(tid >> 6);
    const int G = gridDim.x, bx = blockIdx.x;
    const int gw = bx * NWAVES + wave, NGW = G * NWAVES;
    unsigned char* ws = p.ws;
    const float* x = p.in[0];
    bf16_t* PROJ = (bf16_t*)(ws + WS_PROJ); bf16_t* Hb = (bf16_t*)(ws + WS_H);
    unsigned* ctl = (unsigned*)(ws + WS_CTL);
    const int lo = p.ph_lo, hi = p.ph_hi;
#define IN(k) (lo <= (k) && (k) < hi)
#ifndef PROBE_MASK
#define PROBE_MASK 0
#endif
#define PH(k) if (IN(k)) for (int rep_ = 0; rep_ < (((PROBE_MASK >> (k)) & 1) ? 2 : 1); ++rep_)
    volatile LAS unsigned* xst = (volatile LAS unsigned*)(lds + 131072 + 14336);
    if (tid < 2) xst[tid] = 0u;
    __syncthreads();
    const XcdBarrier xbar = xcd_barrier_post(ctl + CW_BAR, xst);
#define SEAM(k) do { if (IN(k) && IN((k) + 1)) { if ((k) == 0 && lo > hi) grid.sync(); xcd_barrier(xbar); } } while (0)

    PH(0) {
        LAS float* scr = (LAS float*)(lds + wave * 16384);
        LAS float* escale = (LAS float*)(lds + 131072 + 4096); LAS unsigned* eamax = (LAS unsigned*)(lds + 131072 + 4096 + 512);
        if (tid < 65) eamax[tid] = 0u;
        __syncthreads();
#pragma unroll 1
        for (int e0 = 0; e0 < 64; e0 += 8) { float av[8];
#pragma unroll
            for (int e = 0; e < 8; ++e) { const int ee = e0 + e; av[e] = fabsf(ee < 32 ? p.in[27][(size_t)ee * D * D + (size_t)tid * 2049] : p.in[25][(size_t)(ee - 32) * D * 2048 + (size_t)tid * 4097]); }
#pragma unroll
            for (int e = 0; e < 8; ++e) { float m = av[e];
#pragma unroll
                for (int o = 32; o > 0; o >>= 1) m = fmaxf(m, __shfl_xor(m, o));
                if (lane == 0) __hip_atomic_fetch_max(eamax + e0 + e, __builtin_bit_cast(unsigned, m), __ATOMIC_RELAXED, __HIP_MEMORY_SCOPE_WORKGROUP); } }
        __syncthreads();
        { float m = fabsf(p.in[3][(size_t)tid * 17489]);
#pragma unroll
            for (int o = 32; o > 0; o >>= 1) m = fmaxf(m, __shfl_xor(m, o));
            if (lane == 0) __hip_atomic_fetch_max(eamax + 64, __builtin_bit_cast(unsigned, m), __ATOMIC_RELAXED, __HIP_MEMORY_SCOPE_WORKGROUP); }
        __syncthreads();
        if (tid < 65) { const float am = fmaxf(__builtin_bit_cast(float, eamax[tid]), 1e-30f); const float sc8 = exp2f(floorf(log2f(56.f / am))); escale[tid] = sc8;
            if (bx == 0) ((float*)(ws + WS_DNINV))[tid] = 1.f / (sc8 * (tid == 64 ? 16.f : 4.f)); }
        __syncthreads();
        constexpr int I_IN = 16 * (DINP / 32), I_SQ = 16 * 32, I_XQ = 16 * 16, I_XKV = 16 * 32, I_XO = 8 * 32, I_GU = NE * 16 * 64, I_DN = NE * 16 * 32, I_W1 = 64 * 4, I_W2 = 2 * 4;
        constexpr int NITEMS = I_IN + 3 * I_SQ + I_XQ + I_XKV + I_XO + 2 * I_W1 + 2 * I_W2 + I_GU + I_DN;
        auto decode = [&](int it) -> TrItem {
            int r = it;
            if (r < I_IN) { const int nb = r % (DINP / 32), kb = r / (DINP / 32); return TrItem{p.in[3], (bf16_t*)(ws + WS_WIN_T), D, DIN, DIN, nb * 32, kb * 64, nb * 32, nullptr, escale[64]}; } r -= I_IN;
            if (r < I_SQ) { const int nb = r % 32, kb = r / 32; return TrItem{p.in[14], (bf16_t*)(ws + WS_WA_T), D, D, D, nb * 32, kb * 64, nb * 32}; } r -= I_SQ;
            if (r < I_SQ) { const int nb = r % 32, kb = r / 32; return TrItem{p.in[15], (bf16_t*)(ws + WS_WB_T), D, D, D, nb * 32, kb * 64, nb * 32}; } r -= I_SQ;
            if (r < I_SQ) { const int nb = r % 32, kb = r / 32; return TrItem{p.in[16], (bf16_t*)(ws + WS_WMIX_T), D, D, D, nb * 32, kb * 64, nb * 32}; } r -= I_SQ;
            if (r < I_XQ) { const int nb = r % 16, kb = r / 16; return TrItem{p.in[19], (bf16_t*)(ws + WS_WXQ_T), D, XD, XD, nb * 32, kb * 64, nb * 32, p.in[17]}; } r -= I_XQ;
            if (r < I_XKV) { const int nb = r % 32, kb = r / 32; return TrItem{p.in[20], (bf16_t*)(ws + WS_WXKV_T), D, 2 * XD, 2 * XD, nb * 32, kb * 64, nb * 32}; } r -= I_XKV;
            if (r < I_XO) { const int nb = r % 32, kb = r / 32; return TrItem{p.in[21], (bf16_t*)(ws + WS_WXO_T), XD, D, D, nb * 32, kb * 64, nb * 32}; } r -= I_XO;
            if (r < I_W1) { const int nb = r % 4, kb = r / 4; return TrItem{p.in[9], (bf16_t*)(ws + WS_W1T), 4096, 128, 128, nb * 32, kb * 64, nb * 32}; } r -= I_W1;
            if (r < I_W1) { const int nb = r % 4, kb = r / 4; return TrItem{p.in[12], (bf16_t*)(ws + WS_W1T) + 128 * 4096, 4096, 128, 128, nb * 32, kb * 64, nb * 32}; } r -= I_W1;
            if (r < I_W2) { const int nb = r % 4, kb = r / 4; return TrItem{p.in[10], (bf16_t*)(ws + WS_W2T), 128, 128, 128, nb * 32, kb * 64, nb * 32}; } r -= I_W2;
            if (r < I_W2) { const int nb = r % 4, kb = r / 4; return TrItem{p.in[13], (bf16_t*)(ws + WS_W2T) + 128 * 128, 128, 128, 128, nb * 32, kb * 64, nb * 32}; } r -= I_W2;
            if (r < I_GU) { const int e = r / (16 * 64), q = r % (16 * 64), nb = q % 64, kb = q / 64; const int c0 = nb * 32, bj = c0 / 1024, cc = c0 % 1024;
                return TrItem{p.in[25] + (size_t)e * D * 2048, (bf16_t*)(ws + WS_WGU_T + (size_t)e * 2048 * D), D, 2048, 2048, (cc / 128) * 256 + bj * 128 + (cc % 128), kb * 64, c0, p.in[22], escale[32 + e]}; } r -= I_GU;
            { const int e = r / (16 * 32), q = r % (16 * 32), nb = q % 32, kb = q / 32;
                return TrItem{p.in[27] + (size_t)e * D * D, (bf16_t*)(ws + WS_WDN_T + (size_t)e * D * D), D, D, D, nb * 32, kb * 64, nb * 32, nullptr, escale[e]}; }
        };
        if (2 * gw < NITEMS) {
            float v0[32], v1[32]; TrItem cur0 = decode(2 * gw), cur1 = cur0; tr_load(cur0, v0, lane);
            if (2 * gw + 1 < NITEMS) { cur1 = decode(2 * gw + 1); tr_load(cur1, v1, lane); }
            for (int it = 2 * gw; it < NITEMS; it += 2 * NGW) {
                {   tr_lds_write(v0, scr, lane);
                    TrItem nxt = cur0; if (it + 2 * NGW < NITEMS) { nxt = decode(it + 2 * NGW); tr_load(nxt, v0, lane); }
                    asm volatile("" ::: "memory");
                    if (cur0.s8 != 0.f) tr_store8(cur0, scr, lane); else tr_store(cur0, scr, lane); cur0 = nxt; }
                if (it + 1 < NITEMS) {
                    tr_lds_write(v1, scr, lane);
                    TrItem nxt = cur1; if (it + 2 * NGW + 1 < NITEMS) { nxt = decode(it + 2 * NGW + 1); tr_load(nxt, v1, lane); }
                    asm volatile("" ::: "memory");
                    if (cur1.s8 != 0.f) tr_store8(cur1, scr, lane); else tr_store(cur1, scr, lane); cur1 = nxt; }
            }
        }
        for (int m = gw; m < NT; m += 2 * NGW) { const int m2 = m + NGW; const bool hb = m2 < NT; const int mb = hb ? m2 : m;
            rms_rows2_to_fp8(x + (size_t)m * D, x + (size_t)mb * D, p.in[2], (unsigned char*)Hb + (size_t)m * D, (unsigned char*)Hb + (size_t)mb * D, hb, lane); }
        for (int m = gw; m < BATCH * MEM; m += NGW) rms_row_to_bf16(p.in[1] + (size_t)m * D, p.in[18], (bf16_t*)(ws + WS_MEMN) + (size_t)m * D, lane);
    }
    SEAM(0);

    PH(1) {
        { pg8::Gemm g{D / 2, D / 2, D / 2};
          pg8::DenseOrder S; S.init(NT, DINP, G, bx, Hb, D / 2, ws + WS_WIN_T, D / 2); EpiStoreScaled E{PROJ, DINP, (const float*)(ws + WS_DNINV) + 64}; pg8::gemm_phase<EpiStoreScaled, pg8::DenseOrder, false, true>(lds, g, S, E); }
        { pg8::Gemm g{D, D, D}; pg8::DenseOrder S; S.init(BATCH * MEM, 2 * XD, G, (bx + 8) % G, ws + WS_MEMN, D, ws + WS_WXKV_T, D); EpiStoreBf16 E{(bf16_t*)(ws + WS_KVM), 2 * XD}; pg8::gemm_phase(lds, g, S, E); }
    }
    SEAM(1);

    PH(2) {
        { LAS int* qslot = (LAS int*)(lds + 131072 + 12288); int cw_head = -1;
            for (;;) {
                __syncthreads();
                if (tid == 0) *qslot = (int)atomicAdd(ctl + CW_QUEUE + 8 + rep_, 1u);
                __syncthreads();
                const int it = *qslot;
                if (it >= 128 + BATCH * 8 * 128) break;
                if (it < 128) { cmp_item(p, ws, lds, it, tid, lane, wave); cw_head = -1; } else gdn_chunk_item(p, ws, lds, it - 128, tid, lane, wave, cw_head);
            }
        }
        __syncthreads();
        {
            bf16_t* QR = (bf16_t*)(ws + WS_QR); bf16_t* KSR = (bf16_t*)(ws + WS_KSR); bf16_t* KWR = (bf16_t*)(ws + WS_KWR);
            for (int tokb = gw; tokb < NT; tokb += 4 * NGW) {
                unsigned vin[4][12];
#pragma unroll
                for (int u = 0; u < 4; ++u) { const int tok = min(tokb + u * NGW, NT - 1);
#pragma unroll
                    for (int hh = 0; hh < 12; ++hh) vin[u][hh] = __builtin_nontemporal_load((const unsigned*)(PROJ + (size_t)tok * DINP + (hh < 8 ? C_NQ + hh * 128 : (hh < 10 ? C_NKS + (hh - 8) * 128 : C_NKW + (hh - 10) * 128)) + 2 * lane)); }
                asm volatile("" ::: "memory");
#pragma unroll
                for (int u = 0; u < 4; ++u) { const int tok = tokb + u * NGW; if (tok < NT) {
                    const int t = tok & (T - 1);
                    const int dd = 2 * lane; float c0 = 1.f, s0 = 0.f, c1 = 1.f, s1 = 0.f;
                    if (lane < 16) { const int i0 = dd & 15, i1 = i0 + 1;
                        const double f0 = exp2(-18.931568569324174 * (double)i0 / 16.0), f1 = exp2(-18.931568569324174 * (double)i1 / 16.0);
                        double r0 = (double)t * f0 * 0.15915494309189535, r1 = (double)t * f1 * 0.15915494309189535; r0 -= floor(r0); r1 -= floor(r1);
                        const float a0 = (float)(r0 * 6.283185307179586), a1 = (float)(r1 * 6.283185307179586);
                        c0 = __cosf(a0); s0 = __sinf(a0); c1 = __cosf(a1); s1 = __sinf(a1); }
#pragma unroll
                    for (int hh = 0; hh < 12; ++hh) {
                        bf16_t* dst = hh < 8 ? QR + (size_t)tok * D + hh * 128 + dd : ((hh < 10 ? KSR : KWR) + ((size_t)(((tok >> 13) * 2 + (hh & 1)) * 128 + (t >> 6)) << 13) + kimg_off(t & 63, dd));
                        const unsigned v = vin[u][hh]; float v0 = bflo(v), v1 = bfhi(v);
                        const float p0 = __shfl_xor(v0, 8), p1 = __shfl_xor(v1, 8);
                        if (lane < 8) { v0 = v0 * c0 - p0 * s0; v1 = v1 * c1 - p1 * s1; } else if (lane < 16) { v0 = v0 * c0 + p0 * s0; v1 = v1 * c1 + p1 * s1; }
                        *(unsigned*)dst = pk2(v0, v1);
                    }
                } }
            }
        }
        {
            LAS bf16_t* tt = (LAS bf16_t*)lds;
            u32x4 xin[4][2];
#pragma unroll
            for (int q = 0; q < 4; ++q) { const int it = min(bx + q * G, 2 * BATCH * 2 * 128 - 1); const int which = it >> 9, b = (it >> 8) & 1, g = (it >> 7) & 1, blk = it & 127;
                const int tk = tid >> 3, c = tid & 7; const bf16_t* src = PROJ + (size_t)(b * T + blk * 64 + tk) * DINP + (which ? C_NVW : C_NVS) + g * 128 + c * 16;
                xin[q][0] = __builtin_nontemporal_load((const u32x4*)src); xin[q][1] = __builtin_nontemporal_load((const u32x4*)(src + 8)); }
            asm volatile("" ::: "memory");
#pragma unroll
            for (int q = 0; q < 4; ++q) { const int it = bx + q * G; if (it < 2 * BATCH * 2 * 128) {
                const int which = it >> 9, b = (it >> 8) & 1, g = (it >> 7) & 1, blk = it & 127;
                __syncthreads();
                { const int tk = tid >> 3, c = tid & 7;
                    const u32x4 x0 = xin[q][0], x1 = xin[q][1]; const int pos = (tk & ~15) + vperm16(tk & 15);
                    const unsigned xs[8] = {x0.x, x0.y, x0.z, x0.w, x1.x, x1.y, x1.z, x1.w};
#pragma unroll
                    for (int e = 0; e < 8; ++e) { tt[(c * 16 + 2 * e) * 72 + pos] = (bf16_t)(xs[e] & 0xffffu); tt[(c * 16 + 2 * e + 1) * 72 + pos] = (bf16_t)(xs[e] >> 16); } }
                __syncthreads();
                { const int dv = tid >> 2, pc = tid & 3; const LAS u32x4* sp = (const LAS u32x4*)(tt + dv * 72 + pc * 16);
                    bf16_t* dst = (bf16_t*)(ws + (which ? WS_VWT : WS_VST)) + ((size_t)((b * 2 + g) * 128 + blk) << 13);
                    *(u32x4*)(dst + vimg_off(dv, pc * 16)) = sp[0]; *(u32x4*)(dst + vimg_off(dv, pc * 16 + 8)) = sp[1]; }
            } }
            for (int it = bx + 4 * G; it < 2 * BATCH * 2 * 128; it += G) {
                const int which = it >> 9, b = (it >> 8) & 1, g = (it >> 7) & 1, blk = it & 127;
                __syncthreads();
                { const int tk = tid >> 3, c = tid & 7; const bf16_t* src = PROJ + (size_t)(b * T + blk * 64 + tk) * DINP + (which ? C_NVW : C_NVS) + g * 128 + c * 16;
                    const u32x4 x0 = *(const u32x4*)src, x1 = *(const u32x4*)(src + 8); const int pos = (tk & ~15) + vperm16(tk & 15);
                    const unsigned xs[8] = {x0.x, x0.y, x0.z, x0.w, x1.x, x1.y, x1.z, x1.w};
#pragma unroll
                    for (int e = 0; e < 8; ++e) { tt[(c * 16 + 2 * e) * 72 + pos] = (bf16_t)(xs[e] & 0xffffu); tt[(c * 16 + 2 * e + 1) * 72 + pos] = (bf16_t)(xs[e] >> 16); } }
                __syncthreads();
                { const int dv = tid >> 2, pc = tid & 3; const LAS u32x4* sp = (const LAS u32x4*)(tt + dv * 72 + pc * 16);
                    bf16_t* dst = (bf16_t*)(ws + (which ? WS_VWT : WS_VST)) + ((size_t)((b * 2 + g) * 128 + blk) << 13);
                    *(u32x4*)(dst + vimg_off(dv, pc * 16)) = sp[0]; *(u32x4*)(dst + vimg_off(dv, pc * 16 + 8)) = sp[1]; }
            }
            __syncthreads();
        }
        {
            LAS bf16_t* tt = (LAS bf16_t*)lds;
            for (int it = bx; it < BATCH * 4 * 4; it += G) {
                const int b = it >> 4, h = (it >> 2) & 3, blk = it & 3;
                __syncthreads();
                { const int tk = tid >> 3, c = tid & 7; const bf16_t* src = (const bf16_t*)(ws + WS_KVM) + (size_t)(b * MEM + blk * 64 + tk) * 1024 + 512 + h * 128 + c * 16;
                    const u32x4 x0 = *(const u32x4*)src, x1 = *(const u32x4*)(src + 8); const int pos = (tk & ~15) + vperm16(tk & 15);
                    const unsigned xs[8] = {x0.x, x0.y, x0.z, x0.w, x1.x, x1.y, x1.z, x1.w};
#pragma unroll
                    for (int e = 0; e < 8; ++e) { tt[(c * 16 + 2 * e) * 72 + pos] = (bf16_t)(xs[e] & 0xffffu); tt[(c * 16 + 2 * e + 1) * 72 + pos] = (bf16_t)(xs[e] >> 16); } }
                __syncthreads();
                { const int dv = tid >> 2, pc = tid & 3; const LAS u32x4* sp = (const LAS u32x4*)(tt + dv * 72 + pc * 16);
                    bf16_t* dst = (bf16_t*)(ws + WS_XVT) + ((size_t)((b * 4 + h) * 4 + blk) << 13);
                    *(u32x4*)(dst + vimg_off(dv, pc * 16)) = sp[0]; *(u32x4*)(dst + vimg_off(dv, pc * 16 + 8)) = sp[1]; }
                { const int tk = tid >> 3, c = tid & 7; const bf16_t* src = (const bf16_t*)(ws + WS_KVM) + (size_t)(b * MEM + blk * 64 + tk) * 1024 + h * 128 + c * 16;
                    bf16_t* dst = (bf16_t*)(ws + WS_XVT + 524288) + ((size_t)((b * 4 + h) * 4 + blk) << 13);
                    *(u32x4*)(dst + kimg_off(tk, c * 16)) = *(const u32x4*)src; *(u32x4*)(dst + kimg_off(tk, c * 16 + 8)) = *(const u32x4*)(src + 8); }
            }
            __syncthreads();
        }
    }
    SEAM(2);

    if (IN(3)) {
        if (bx < 16) { gdn_scan(ws, lds, bx, tid, lane, wave);
            if (tid == 0) { __builtin_amdgcn_fence(__ATOMIC_RELEASE, "agent"); asm volatile("s_waitcnt vmcnt(0)" ::: "memory"); __hip_atomic_fetch_add(ctl + CW_SCANDONE, 1u, __ATOMIC_RELAXED, __HIP_MEMORY_SCOPE_AGENT); } }
        {
            LAS int* qslot = (LAS int*)(lds + 131072 + 12288);
            for (;;) {
                __syncthreads();
                if (tid == 0) *qslot = (int)atomicAdd(ctl + CW_QUEUE, 1u);
                __syncthreads();
                const int it = *qslot;
                if (it >= 512) break;
                nsa_item(p, ws, lds, it, tid, lane, wave);
            }
        }
        {
            LAS int* qslot = (LAS int*)(lds + 131072 + 12288);
            if (tid == 0) { unsigned sp = 0; while (__hip_atomic_load(ctl + CW_SCANDONE, __ATOMIC_RELAXED, __HIP_MEMORY_SCOPE_AGENT) < 16u) { __builtin_amdgcn_s_sleep(2); if (++sp > (1u << 22)) break; }
                __builtin_amdgcn_fence(__ATOMIC_ACQUIRE, "agent"); asm volatile("s_waitcnt vmcnt(0)" ::: "memory"); }
            __syncthreads();
            const float* GO = (const float*)(ws + WS_GO); bf16_t* OA = (bf16_t*)(ws + WS_OA);
            for (;;) {
                __syncthreads();
                if (tid == 0) *qslot = (int)atomicAdd(ctl + CW_P4Q, 1u);
                __syncthreads();
                const int it0 = *qslot; if (it0 >= NT / 64) break;
                const float gn0 = p.in[7][2 * lane], gn1 = p.in[7][2 * lane + 1];
#pragma unroll 1
                for (int q0 = wave * 8; q0 < 512; q0 += NWAVES * 8) {
                    float v0[8], v1[8]; unsigned z[8];
#pragma unroll
                    for (int i = 0; i < 8; ++i) { const int q = q0 + i, tok = it0 * 64 + (q >> 3), h = q & 7; const size_t o = (size_t)tok * D + h * 128 + 2 * lane;
                        const f32x2v g2 = __builtin_nontemporal_load((const f32x2v*)(GO + o)); v0[i] = g2.x; v1[i] = g2.y; z[i] = __builtin_nontemporal_load((const unsigned*)(PROJ + (size_t)tok * DINP + C_GZ + h * 128 + 2 * lane)); }
                    asm volatile("" ::: "memory");
#pragma unroll
                    for (int i = 0; i < 8; ++i) { const int q = q0 + i, tok = it0 * 64 + (q >> 3), h = q & 7; const size_t o = (size_t)tok * D + h * 128 + 2 * lane;
                        const float r = __builtin_amdgcn_rsqf(wave_sum(v0[i] * v0[i] + v1[i] * v1[i]) * (1.f / 128.f) + 1e-6f);
                        *(unsigned*)(OA + o) = pk2(v0[i] * r * gn0 * siluf_(bflo(z[i])), v1[i] * r * gn1 * siluf_(bfhi(z[i]))); }
                }
            }
        }
    }
    SEAM(3);


    PH(5) {
        bf16_t* MIXED = (bf16_t*)(ws + WS_MIXED);
        { pg8::Gemm g{D, D, D}; pg8::DenseOrder S; S.init(NT, D, G, bx, ws + WS_OA, D, ws + WS_WA_T, D); EpiGate E{MIXED, PROJ, C_MA, 0}; pg8::gemm_phase(lds, g, S, E); }
        { pg8::Gemm g{D, D, D}; pg8::DenseOrder S; S.init(NT, D, G, bx, ws + WS_OB, D, ws + WS_WB_T, D); EpiGate E{MIXED, PROJ, C_MB, 1}; pg8::gemm_phase(lds, g, S, E); }
    }
    SEAM(5);

    PH(6) { pg8::Gemm g{D, D, D}; pg8::DenseOrder S; S.init(NT, D, G, bx, ws + WS_MIXED, D, ws + WS_WMIX_T, D);
        EpiResidualNorm E{x, Hb, (float*)(ctl + CW_SS1)}; pg8::gemm_phase(lds, g, S, E); }
    SEAM(6);
    PH(8) { pg8::Gemm g{D, D, D}; pg8::DenseOrder S; S.init(NT, XD, G, bx, Hb, D, ws + WS_WXQ_T, D); EpiScaleRowsBf16 E{(bf16_t*)(ws + WS_QX), XD, (const float*)(ctl + CW_SS1)}; pg8::gemm_phase(lds, g, S, E); }
    SEAM(8);
    PH(9) { for (int it = bx; it < BATCH * 4 * 32; it += G) xattn_item(ws, lds, it, tid, lane, wave); __syncthreads(); }
    SEAM(9);
    if (IN(10)) { pg8::Gemm g{XD, XD, XD}; pg8::DenseOrder S; S.init(NT, D, G, bx, ws + WS_OX, XD, ws + WS_WXO_T, XD); EpiResidualSS E{Hb, (float*)(ctl + CW_SS2), ws + WS_X1}; pg8::gemm_phase(lds, g, S, E); }
    SEAM(10);
    PH(11) {
        LAS float* wl = (LAS float*)lds;
        LAS float* xch = (LAS float*)(lds + 131072);
        LAS int* lcnt = (LAS int*)(lds + 131072 + 8192);
        if (tid < 32) lcnt[tid] = 0;
        const int pr = wave >> 1, kh = wave & 1, tok0 = bx * 64 + pr * 16, li = lane & 15, kk = lane >> 4;
        const u32x4* xr = (const u32x4*)(Hb + (size_t)(tok0 + li) * D + kh * 512) + kk;
        u32x4 xv[16];
#pragma unroll
        for (int sc = 0; sc < 16; ++sc) xv[sc] = xr[4 * sc];
        const float rstd = __builtin_amdgcn_rsqf(((const float*)(ctl + CW_SS2))[tok0 + li] * (1.f / D) + 1e-6f);
        {
            const float* rwg = p.in[23];
#pragma unroll 1
            for (int b = 0; b < 16; b += 4) { float t[4][4];
#pragma unroll
                for (int q = 0; q < 4; ++q) { const int idx = (b + q) * 512 + tid, k4 = idx >> 5, e = idx & 31;
#pragma unroll
                    for (int s2 = 0; s2 < 4; ++s2) t[q][s2] = rwg[(4 * k4 + s2) * 32 + e]; }
#pragma unroll
                for (int q = 0; q < 4; ++q) { const int idx = (b + q) * 512 + tid; *(LAS f32x4*)(wl + idx * 4) = (f32x4){t[q][0], t[q][1], t[q][2], t[q][3]}; } }
        }
        __syncthreads();
        f32x4 acc0 = {0.f, 0.f, 0.f, 0.f}, acc1 = {0.f, 0.f, 0.f, 0.f};
        const f32x4* gr = (const f32x4*)(p.in[22] + kh * 512) + 2 * kk;
        LAS const f32x4* wb = (LAS const f32x4*)wl + (kh * 128 + 2 * kk) * 32 + li;
#pragma unroll
        for (int sc = 0; sc < 16; ++sc) {
            const f32x4 g0 = gr[8 * sc], g1 = gr[8 * sc + 1];
            const u32x4 xw = xv[sc];
            const f32x4 h0 = (f32x4){bflo(xw.x), bfhi(xw.x), bflo(xw.y), bfhi(xw.y)} * rstd * g0, h1 = (f32x4){bflo(xw.z), bfhi(xw.z), bflo(xw.w), bfhi(xw.w)} * rstd * g1;
            const f32x4 b00 = wb[(8 * sc) * 32], b01 = wb[(8 * sc) * 32 + 16], b10 = wb[(8 * sc + 1) * 32], b11 = wb[(8 * sc + 1) * 32 + 16];
#pragma unroll
            for (int s2 = 0; s2 < 4; ++s2) { acc0 = __builtin_amdgcn_mfma_f32_16x16x4f32(h0[s2], b00[s2], acc0, 0, 0, 0); acc1 = __builtin_amdgcn_mfma_f32_16x16x4f32(h0[s2], b01[s2], acc1, 0, 0, 0); }
#pragma unroll
            for (int s2 = 0; s2 < 4; ++s2) { acc0 = __builtin_amdgcn_mfma_f32_16x16x4f32(h1[s2], b10[s2], acc0, 0, 0, 0); acc1 = __builtin_amdgcn_mfma_f32_16x16x4f32(h1[s2], b11[s2], acc1, 0, 0, 0); }
        }
        if (kh == 1) {
#pragma unroll
            for (int r = 0; r < 4; ++r) { xch[pr * 512 + (4 * kk + r) * 32 + li] = acc0[r]; xch[pr * 512 + (4 * kk + r) * 32 + 16 + li] = acc1[r]; } }
        __syncthreads();
        int my_e[4] = {0, 0, 0, 0}, my_rk[4] = {0, 0, 0, 0}; float my_g[4] = {0.f, 0.f, 0.f, 0.f};
        if (kh == 0) {
            const float bias0 = p.in[24][li], bias1 = p.in[24][16 + li];
#pragma unroll
            for (int r = 0; r < 4; ++r) {
                float v0 = acc0[r] + xch[pr * 512 + (4 * kk + r) * 32 + li] + bias0, v1 = acc1[r] + xch[pr * 512 + (4 * kk + r) * 32 + 16 + li] + bias1;
                float tv[4]; int ti[4];
#pragma unroll
                for (int rk = 0; rk < 4; ++rk) { float bv; int bi; if (v0 >= v1) { bv = v0; bi = li; } else { bv = v1; bi = 16 + li; }
#pragma unroll
                    for (int o = 1; o < 16; o <<= 1) { const float ov = __shfl_xor(bv, o); const int oi = __shfl_xor(bi, o); if (ov > bv || (ov == bv && oi < bi)) { bv = ov; bi = oi; } }
                    tv[rk] = bv; ti[rk] = bi; if (bi == li) v0 = -3e38f; if (bi == 16 + li) v1 = -3e38f; }
                if (li == r) {
                    const float e1 = __expf(tv[1] - tv[0]), e2 = __expf(tv[2] - tv[0]), e3 = __expf(tv[3] - tv[0]), inv = 1.f / (1.f + e1 + e2 + e3);
                    my_g[0] = inv; my_g[1] = e1 * inv; my_g[2] = e2 * inv; my_g[3] = e3 * inv;
#pragma unroll
                    for (int rk = 0; rk < 4; ++rk) { my_e[rk] = ti[rk]; my_rk[rk] = __hip_atomic_fetch_add(lcnt + ti[rk], 1, __ATOMIC_RELAXED, __HIP_MEMORY_SCOPE_WORKGROUP); } }
            }
        }
        __syncthreads();
        if (tid < 32) lcnt[32 + tid] = (int)atomicAdd(ctl + CW_ECNT + tid, (unsigned)lcnt[tid]);
        __syncthreads();
        const float myrs = __shfl(rstd, 4 * kk + li);
        if (kh == 0 && li < 4) { const int tok = tok0 + 4 * kk + li; int* RT = (int*)(ws + WS_ROWTOK2); float* RG = (float*)(ws + WS_ROWGATE2); float* RS = (float*)(ws + WS_ROWRS2); i32x4 pos;
#pragma unroll
            for (int rk = 0; rk < 4; ++rk) { const int q = my_e[rk] * NT + lcnt[32 + my_e[rk]] + my_rk[rk]; RT[q] = tok; RG[q] = my_g[rk]; RS[q] = myrs; pos[rk] = q; }
            *(i32x4*)((int*)(ws + WS_POS) + tok * 4) = pos; }
    }
    SEAM(11);
    LAS int* moe_cum = (LAS int*)(lds + 131072);
    if (IN(13) || IN(14) || IN(15)) {
        LAS int* tmp = moe_cum + 128;
        __syncthreads();
        if (tid < 32) tmp[tid] = (int)ctl[CW_ECNT + tid];
        __syncthreads();
        if (tid == 0) { int cumb = 0; moe_cum[0] = 0; for (int e = 0; e < NE; ++e) { cumb += (tmp[e] + MOEB - 1) / MOEB; moe_cum[e + 1] = cumb; } }
        __syncthreads();
    }
    PH(13) { pg8::Gemm g{D / 2, D / 2, D / 2};
        MoeOrder S{G, bx, 8, moe_cum, (const char*)(ws + WS_X1), (const char*)(ws + WS_WGU_T), (size_t)2048 * D, (const int*)(ws + WS_ROWTOK2), 1, D, __builtin_amdgcn_readfirstlane(moe_cum[NE])};
        EpiSwiglu E{(bf16_t*)(ws + WS_ACT), p.in[26], (const float*)(ws + WS_DNINV) + 32}; pg8::gemm_phase<EpiSwiglu, MoeOrder, true, true>(lds, g, S, E); }
    SEAM(13);
    PH(14) { pg8::Gemm g{D / 2, D / 2, D / 2};
        MoeOrder S{G, bx, 4, moe_cum, (const char*)(ws + WS_ACT), (const char*)(ws + WS_WDN_T), (size_t)D * D, (const int*)(ws + WS_ROWGATE2), 0, D, __builtin_amdgcn_readfirstlane(moe_cum[NE])};
        EpiDown E{(bf16_t*)(ws + WS_Y), p.in[28], (const float*)(ws + WS_DNINV)}; pg8::gemm_phase<EpiDown, MoeOrder, false, true>(lds, g, S, E); }
    SEAM(14);
    PH(15) {
        const int lane = lane_id();
        const int* POS = (const int*)(ws + WS_POS); const bf16_t* Y = (const bf16_t*)(ws + WS_Y);
        for (int tok = gw; tok < NT; tok += NGW) {
            const u32x2* xr = (const u32x2*)(Hb + (size_t)tok * D) + lane; f32x4 v[4];
#pragma unroll
            for (int j = 0; j < 4; ++j) { const u32x2 w = xr[64 * j]; v[j] = (f32x4){bflo(w.x), bfhi(w.x), bflo(w.y), bfhi(w.y)}; }
#pragma unroll
            for (int k = 0; k < 4; ++k) { const int q = POS[tok * 4 + k]; const unsigned* yr = (const unsigned*)((const unsigned char*)Y + (size_t)(moe_cum[q >> 14] * 256 + (q & (NT - 1))) * D) + lane;
#pragma unroll
                for (int j = 0; j < 4; ++j) { const unsigned w = yr[64 * j]; const f32x2v lo = __builtin_amdgcn_cvt_pk_f32_fp8((int)w, false), hi = __builtin_amdgcn_cvt_pk_f32_fp8((int)w, true);
                    v[j].x += 0.125f * lo.x; v[j].y += 0.125f * lo.y; v[j].z += 0.125f * hi.x; v[j].w += 0.125f * hi.y; } }
            float s = 0.f;
#pragma unroll
            for (int j = 0; j < 4; ++j) s += (v[j].x * v[j].x + v[j].y * v[j].y) + (v[j].z * v[j].z + v[j].w * v[j].w);
            const float rstd = __builtin_amdgcn_rsqf(wave_sum(s) * (1.f / D) + 1e-6f);
            f32x4* orow = (f32x4*)(p.out + (size_t)tok * D) + lane; const f32x4* gr = (const f32x4*)p.in[29] + lane;
#pragma unroll
            for (int j = 0; j < 4; ++j) { const f32x4 gg = gr[64 * j]; orow[64 * j] = (f32x4){v[j].x * rstd * gg.x, v[j].y * rstd * gg.y, v[j].z * rstd * gg.z, v[j].w * rstd * gg.w}; }
        }
    }
}

constexpr int NPHASES = 16;
extern "C" void kernel_launch(void* const* d_in, const int* in_sizes, int n_in, void* d_out, int out_size, void* d_ws, size_t ws_size, hipStream_t stream) {
    static int grid = 0;
    if (grid == 0) {
        int dev = 0, cus = 0, per_cu = 0;
        (void)hipGetDevice(&dev); (void)hipDeviceGetAttribute(&cus, hipDeviceAttributeMultiprocessorCount, dev);
        (void)hipFuncSetAttribute((const void*)mega, hipFuncAttributeMaxDynamicSharedMemorySize, LDS_BYTES);
        (void)hipOccupancyMaxActiveBlocksPerMultiprocessor(&per_cu, (const void*)mega, NTHREADS, LDS_BYTES);
        if (per_cu < 1) { fprintf(stderr, "occupancy query says %d blocks/CU\n", per_cu); per_cu = 1; }
        grid = cus * 1;
        if (ws_size < WS_END) fprintf(stderr, "workspace too small: %zu < %zu\n", ws_size, (size_t)WS_END);
    }
    (void)hipMemsetAsync((char*)d_ws + WS_CTL, 0, CTL_ZERO, stream);
    Params p{};
    for (int i = 0; i < 30; ++i) p.in[i] = (const float*)d_in[i];
    p.out = (float*)d_out; p.ws = (unsigned char*)d_ws;
#if SINGLE_LAUNCH
    p.ph_lo = 0; p.ph_hi = NPHASES;
    void* args[] = {&p};
    hipError_t e = hipLaunchCooperativeKernel((const void*)mega, dim3(grid), dim3(NTHREADS), args, LDS_BYTES, stream);
    if (e != hipSuccess) fprintf(stderr, "cooperative launch failed: %s (grid %d)\n", hipGetErrorString(e), grid);
#else
    for (int ph = 0; ph < NPHASES; ++ph) { p.ph_lo = ph; p.ph_hi = ph + 1; hipLaunchKernelGGL(mega, dim3(grid), dim3(NTHREADS), LDS_BYTES, stream, p); }
#endif
}
```
